# Optimizing an MI355X kernel written in HIP

```python
import math
import jax, jax.numpy as jnp
from jax import lax
import numpy as np

D_MODEL = 1024
BATCH = 8
SEQ = 2048
DEPTH = 1

PL_DIM = 256
MIX_WIDTH = D_MODEL
DIFF_WIDTH = MIX_WIDTH // 2
RWKV_WIDTH = MIX_WIDTH - DIFF_WIDTH
DIFF_HEAD_DIM = 64
DIFF_HEADS = DIFF_WIDTH // (2 * DIFF_HEAD_DIM)
RWKV_HEAD = 64
RWKV_HEADS = RWKV_WIDTH // RWKV_HEAD
D_DECAY_LORA = 64
D_AAA_LORA = 64
D_GATE_LORA = 160
IN_COLS = 3 * DIFF_WIDTH + 3 * RWKV_WIDTH
ROPE_THETA = 10000.0
Q_BLOCK = 128
NORM_EPS = 1e-6
SUBLN_EPS = 1e-5
GN_EPS = 64e-5
N_GROUPS = 4
EXPERTS_PER_GROUP = 8
N_EXPERTS = N_GROUPS * EXPERTS_PER_GROUP
TOP_K = 2
D_EXPERT = 512
MOE_BLOCK = 128
MAX_POS_OFFSET = 1024

kernel_name = "hymba_diffattn_rwkv7_hmoe_block"


def rms_norm(x, g, eps=NORM_EPS):
    xf = x.astype(jnp.float32)
    y = xf * lax.rsqrt(jnp.mean(xf * xf, axis=-1, keepdims=True) + eps)
    return (y * g.astype(jnp.float32)).astype(x.dtype)


def token_shift(z):
    return jnp.pad(z, ((0, 0), (1, 0), (0, 0)))[:, :-1]


def rope_tables(positions):
    half = DIFF_HEAD_DIM // 2
    inv_freq = ROPE_THETA ** (-jnp.arange(half, dtype=jnp.float32) / half)
    ang = positions.astype(jnp.float32)[..., None] * inv_freq
    return jnp.cos(ang), jnp.sin(ang)


def apply_rope(t, cos, sin):
    c = cos[:, :, None, None, :]
    s = sin[:, :, None, None, :]
    t1, t2 = jnp.split(t.astype(jnp.float32), 2, axis=-1)
    return jnp.concatenate([t1 * c - t2 * s, t2 * c + t1 * s], axis=-1).astype(t.dtype)


def diff_attention(q, k, v, lam, out_g, lam_init):
    B, S = q.shape[0], q.shape[1]
    scale = DIFF_HEAD_DIM ** -0.5
    outs = []
    for start in range(0, S, Q_BLOCK):
        end = start + Q_BLOCK
        qb = q[:, start:end]
        kb = k[:, :end]
        vb = v[:, :end]
        s = jnp.einsum('bqhmd,bkhmd->bhmqk', qb, kb,
                       preferred_element_type=jnp.float32) * scale
        causal = jnp.arange(start, end)[:, None] >= jnp.arange(end)[None, :]
        s = jnp.where(causal, s, -jnp.inf)
        prob = jax.nn.softmax(s, axis=-1)
        attn = prob[:, :, 0] - lam * prob[:, :, 1]
        outs.append(jnp.einsum('bhqk,bkhe->bqhe', attn.astype(v.dtype), vb))
    o = jnp.concatenate(outs, axis=1)
    o = rms_norm(o, out_g, SUBLN_EPS) * (1.0 - lam_init)
    return o.reshape(B, S, DIFF_WIDTH)


def rwkv7_scan(r, w, k, v, a, b):
    B, S, H, N = r.shape

    def step(state, inp):
        r_t, w_t, k_t, v_t, a_t, b_t = inp
        sa = jnp.einsum('bhvk,bhk->bhv', state, a_t)
        state = (state * w_t[:, :, None, :] + sa[..., None] * b_t[:, :, None, :]
                 + v_t[..., None] * k_t[:, :, None, :])
        y = jnp.einsum('bhvk,bhk->bhv', state, r_t)
        return state, y

    xs = tuple(jnp.moveaxis(t, 1, 0) for t in (r, w, k, v, a, b))
    s0 = jnp.zeros((B, H, N, N), jnp.float32)
    _, y = lax.scan(step, s0, xs)
    return jnp.moveaxis(y, 0, 1)


def rwkv7_time_mix(h, zr, zk, zv, mu_rkv, mu_wag, w0, w1, w2, a0, a1, a2,
                   g1, g2, k_k, k_a, r_k, gn_w, gn_b):
    B, S, _ = h.shape
    H, N = RWKV_HEADS, RWKV_HEAD
    f32 = jnp.float32
    r = zr + (token_shift(zr) - zr) * mu_rkv[0]
    k = zk + (token_shift(zk) - zk) * mu_rkv[1]
    v = zv + (token_shift(zv) - zv) * mu_rkv[2]
    dh = token_shift(h) - h
    xw = h + dh * mu_wag[0]
    xa = h + dh * mu_wag[1]
    xg = h + dh * mu_wag[2]
    w_log = -jax.nn.softplus(-(w0 + jnp.tanh(xw @ w1) @ w2).astype(f32)) - 0.5
    decay = jnp.exp(-jnp.exp(w_log))
    a = jax.nn.sigmoid((a0 + (xa @ a1) @ a2).astype(f32))
    g = (jax.nn.sigmoid(xg @ g1) @ g2).astype(f32)

    def heads(t):
        return t.reshape(B, S, H, N).astype(f32)

    r, k, v, decay, a = heads(r), heads(k), heads(v), heads(decay), heads(a)
    kk = k * k_k.reshape(H, N).astype(f32)
    kk = kk * lax.rsqrt(jnp.maximum(jnp.sum(kk * kk, axis=-1, keepdims=True), 1e-24))
    k = k * (1.0 + (a - 1.0) * k_a.reshape(H, N).astype(f32))
    y = rwkv7_scan(r, decay, k, v, -kk, kk * a)
    mu = jnp.mean(y, axis=-1, keepdims=True)
    var = jnp.mean(jnp.square(y - mu), axis=-1, keepdims=True)
    y = ((y - mu) * lax.rsqrt(var + GN_EPS)).reshape(B, S, H * N)
    y = y * gn_w.astype(f32) + gn_b.astype(f32)
    bonus = jnp.sum(r * k * r_k.astype(f32), axis=-1, keepdims=True) * v
    y = y + bonus.reshape(B, S, H * N)
    return (y * g).astype(h.dtype)


def hier_moe(h, w_group, w_expert_router, w_gate, w_up, w_down):
    B, S, D = h.shape
    T = B * S
    xt = h.reshape(T, D)
    g_logits = (xt @ w_group).astype(jnp.float32)
    g_prob = jax.nn.softmax(g_logits, axis=-1)
    g_sel = jnp.argmax(g_logits, axis=-1)
    g_w = jnp.take_along_axis(g_prob, g_sel[:, None], axis=1)[:, 0]
    e_logits_all = jnp.einsum('td,gde->tge', xt, w_expert_router).astype(jnp.float32)
    e_logits = jnp.take_along_axis(e_logits_all, g_sel[:, None, None], axis=1)[:, 0]
    top_v, top_i = lax.top_k(e_logits, TOP_K)
    e_w = jax.nn.softmax(top_v, axis=-1) * g_w[:, None]
    expert_id = g_sel[:, None].astype(jnp.int32) * EXPERTS_PER_GROUP + top_i.astype(jnp.int32)

    A = T * TOP_K
    flat_e = expert_id.reshape(A)
    flat_tok = jnp.repeat(jnp.arange(T, dtype=jnp.int32), TOP_K)
    flat_w = e_w.reshape(A)
    order = jnp.argsort(flat_e)
    se = flat_e[order]
    counts = jnp.bincount(flat_e, length=N_EXPERTS)
    starts = jnp.cumsum(counts) - counts
    pcounts = (counts + MOE_BLOCK - 1) // MOE_BLOCK * MOE_BLOCK
    pends = jnp.cumsum(pcounts)
    pstarts = pends - pcounts
    dest = pstarts[se] + (jnp.arange(A) - starts[se])
    n_blocks = -(-A // MOE_BLOCK) + N_EXPERTS
    P = n_blocks * MOE_BLOCK
    buf_tok = jnp.full((P,), T, jnp.int32).at[dest].set(flat_tok[order])
    buf_w = jnp.zeros((P,), jnp.float32).at[dest].set(flat_w[order])
    block_e = jnp.minimum(
        jnp.searchsorted(pends, jnp.arange(n_blocks) * MOE_BLOCK, side='right'),
        N_EXPERTS - 1).astype(jnp.int32)
    x_pad = jnp.concatenate([xt, jnp.zeros((1, D), xt.dtype)], axis=0)
    xb = x_pad[buf_tok].reshape(n_blocks, MOE_BLOCK, D)

    def expert_block(args):
        xblk, e = args
        return (jax.nn.silu(xblk @ w_gate[e]) * (xblk @ w_up[e])) @ w_down[e]

    yb = lax.map(expert_block, (xb, block_e)).reshape(P, D)
    yb = yb.astype(jnp.float32) * buf_w[:, None]
    y = jax.ops.segment_sum(yb, buf_tok, num_segments=T + 1)[:T]
    return y.astype(h.dtype).reshape(B, S, D)


def setup_inputs(seed: int = 0) -> dict:
    key = jax.random.key(seed)
    ks = iter(jax.random.split(key, 48))
    L, D = DEPTH, D_MODEL

    def nrm(shape, scale):
        return jax.random.normal(next(ks), shape, jnp.float32) * scale

    def gain(shape):
        return 1.0 + nrm(shape, 0.02)

    def unif(shape):
        return jax.random.uniform(next(ks), shape, jnp.float32)

    x = nrm((BATCH, SEQ, D), 1.0)
    p = nrm((DEPTH, BATCH, SEQ, PL_DIM), 1.0)
    positions = (jnp.arange(SEQ, dtype=jnp.int32)[None, :]
                 + jax.random.randint(next(ks), (BATCH, 1), 0, MAX_POS_OFFSET, dtype=jnp.int32))
    return {
        "x": x,
        "p": p,
        "positions": positions,
        "attn_norm_g": gain((L, D)),
        "w_in": nrm((L, D, IN_COLS), D ** -0.5),
        "q_norm_g": gain((L, DIFF_HEAD_DIM)),
        "k_norm_g": gain((L, DIFF_HEAD_DIM)),
        "lambda_q1": nrm((L, DIFF_HEAD_DIM), 0.1),
        "lambda_k1": nrm((L, DIFF_HEAD_DIM), 0.1),
        "lambda_q2": nrm((L, DIFF_HEAD_DIM), 0.1),
        "lambda_k2": nrm((L, DIFF_HEAD_DIM), 0.1),
        "diff_out_g": gain((L, 2 * DIFF_HEAD_DIM)),
        "mu_rkv": unif((L, 3, RWKV_WIDTH)),
        "mu_wag": unif((L, 3, D)),
        "w0": jnp.linspace(-6.0, -1.0, RWKV_WIDTH, dtype=jnp.float32)[None, :] + nrm((L, RWKV_WIDTH), 0.1),
        "w_lora_a": nrm((L, D, D_DECAY_LORA), D ** -0.5),
        "w_lora_b": nrm((L, D_DECAY_LORA, RWKV_WIDTH), 0.1 * D_DECAY_LORA ** -0.5),
        "a0": nrm((L, RWKV_WIDTH), 0.1),
        "a_lora_a": nrm((L, D, D_AAA_LORA), D ** -0.5),
        "a_lora_b": nrm((L, D_AAA_LORA, RWKV_WIDTH), 0.5 * D_AAA_LORA ** -0.5),
        "g_lora_a": nrm((L, D, D_GATE_LORA), D ** -0.5),
        "g_lora_b": nrm((L, D_GATE_LORA, RWKV_WIDTH), D_GATE_LORA ** -0.5),
        "k_k": 0.85 + nrm((L, RWKV_WIDTH), 0.02),
        "k_a": 1.0 + nrm((L, RWKV_WIDTH), 0.02),
        "r_k": nrm((L, RWKV_HEADS, RWKV_HEAD), 0.1),
        "gn_w": gain((L, RWKV_WIDTH)),
        "gn_b": nrm((L, RWKV_WIDTH), 0.02),
        "w_out": nrm((L, MIX_WIDTH, D), MIX_WIDTH ** -0.5),
        "moe_norm_g": gain((L, D)),
        "w_group": nrm((L, D, N_GROUPS), D ** -0.5),
        "w_expert_router": nrm((L, N_GROUPS, D, EXPERTS_PER_GROUP), D ** -0.5),
        "w_gate": nrm((L, N_EXPERTS, D, D_EXPERT), D ** -0.5),
        "w_up": nrm((L, N_EXPERTS, D, D_EXPERT), D ** -0.5),
        "w_down": nrm((L, N_EXPERTS, D_EXPERT, D), D_EXPERT ** -0.5),
        "w_pl": nrm((L, PL_DIM, D), PL_DIM ** -0.5),
        "pl_norm_g": gain((L, D)),
        "pl_gate_norm_g": gain((L, D)),
        "w_pl_gate": nrm((L, D, D), D ** -0.5),
    }


def reference(x, p, positions, attn_norm_g, w_in, q_norm_g, k_norm_g, lambda_q1, lambda_k1,
              lambda_q2, lambda_k2, diff_out_g, mu_rkv, mu_wag, w0, w_lora_a, w_lora_b, a0,
              a_lora_a, a_lora_b, g_lora_a, g_lora_b, k_k, k_a, r_k, gn_w, gn_b, w_out,
              moe_norm_g, w_group, w_expert_router, w_gate, w_up, w_down, w_pl, pl_norm_g,
              pl_gate_norm_g, w_pl_gate):
    B, S, _ = x.shape
    cos, sin = rope_tables(positions)
    split_at = [DIFF_WIDTH, 2 * DIFF_WIDTH, 3 * DIFF_WIDTH,
                3 * DIFF_WIDTH + RWKV_WIDTH, 3 * DIFF_WIDTH + 2 * RWKV_WIDTH]
    for i in range(DEPTH):
        lam_init = 0.8 - 0.6 * math.exp(-0.3 * i)
        hn = rms_norm(x, attn_norm_g[i])
        z = hn @ w_in[i]
        dq, dk, dv, zr, zk, zv = jnp.split(z, split_at, axis=-1)
        q = apply_rope(rms_norm(dq.reshape(B, S, DIFF_HEADS, 2, DIFF_HEAD_DIM), q_norm_g[i]), cos, sin)
        k = apply_rope(rms_norm(dk.reshape(B, S, DIFF_HEADS, 2, DIFF_HEAD_DIM), k_norm_g[i]), cos, sin)
        v = dv.reshape(B, S, DIFF_HEADS, 2 * DIFF_HEAD_DIM)
        lam = (jnp.exp(jnp.sum(lambda_q1[i].astype(jnp.float32) * lambda_k1[i].astype(jnp.float32)))
               - jnp.exp(jnp.sum(lambda_q2[i].astype(jnp.float32) * lambda_k2[i].astype(jnp.float32)))
               + lam_init)
        o_diff = diff_attention(q, k, v, lam, diff_out_g[i], lam_init)
        o_rwkv = rwkv7_time_mix(hn, zr, zk, zv, mu_rkv[i], mu_wag[i], w0[i], w_lora_a[i],
                                w_lora_b[i], a0[i], a_lora_a[i], a_lora_b[i], g_lora_a[i],
                                g_lora_b[i], k_k[i], k_a[i], r_k[i], gn_w[i], gn_b[i])
        x = x + jnp.concatenate([o_diff, o_rwkv], axis=-1) @ w_out[i]
        x = x + hier_moe(rms_norm(x, moe_norm_g[i]), w_group[i], w_expert_router[i],
                         w_gate[i], w_up[i], w_down[i])
        gate = jax.nn.sigmoid(rms_norm(x, pl_gate_norm_g[i]) @ w_pl_gate[i])
        x = x + rms_norm(p[i] @ w_pl[i], pl_norm_g[i]) * gate
    return x
```

```cpp
#include <hip/hip_runtime.h>
#include <cstdint>
#include <cstdio>
#include <cmath>

namespace nv {
constexpr int S_ = 2048, D_ = 1024, NB = 8;
constexpr int MB = S_;

struct ALPlain { const float* A; int lda; __device__ __forceinline__ float operator()(int m, int k) const { return A[(size_t)m * lda + k]; } };
struct ALShiftMix { const float* H; const float* mu;
    __device__ __forceinline__ float operator()(int m, int k) const { float h = H[(size_t)m * 1024 + k]; float hp = (m % S_) ? H[(size_t)(m - 1) * 1024 + k] : 0.f; return h + (hp - h) * mu[k]; } };
struct ALGather { const float* A; int lda; const int* rows; int div;
    __device__ __forceinline__ float operator()(int m, int k) const { return A[(size_t)(rows[m] / div) * lda + k]; } };

template <class AL, int ACT>
__global__ void __launch_bounds__(256) sgemm(AL al, const float* __restrict__ B, int ldb, float* C, int ldc, const float* Cadd, int ldadd,
                                            int M, const int* Mptr, int N, int K) {
    __shared__ float As[16][68];
    __shared__ float Bs[16][68];
    if (Mptr) M = *Mptr;
    const int m0 = blockIdx.y * 64, n0 = blockIdx.x * 64;
    if (m0 >= M) return;
    const int tid = threadIdx.x, ty = tid / 16, tx = tid % 16;
    float acc[4][4];
#pragma unroll
    for (int i = 0; i < 4; ++i)
#pragma unroll
        for (int j = 0; j < 4; ++j) acc[i][j] = 0.f;
    for (int k0 = 0; k0 < K; k0 += 16) {
#pragma unroll
        for (int i = 0; i < 4; ++i) {
            int idx = tid + i * 256; int m = idx / 16, k = idx % 16;
            As[k][m] = (m0 + m < M) ? al(m0 + m, k0 + k) : 0.f;
            int kb = idx / 64, n = idx % 64;
            Bs[kb][n] = (n0 + n < N) ? B[(size_t)(k0 + kb) * ldb + n0 + n] : 0.f;
        }
        __syncthreads();
#pragma unroll
        for (int k = 0; k < 16; ++k) {
            float a[4], b[4];
#pragma unroll
            for (int i = 0; i < 4; ++i) { a[i] = As[k][ty * 4 + i]; b[i] = Bs[k][tx * 4 + i]; }
#pragma unroll
            for (int i = 0; i < 4; ++i)
#pragma unroll
                for (int j = 0; j < 4; ++j) acc[i][j] = fmaf(a[i], b[j], acc[i][j]);
        }
        __syncthreads();
    }
#pragma unroll
    for (int i = 0; i < 4; ++i)
#pragma unroll
        for (int j = 0; j < 4; ++j) {
            int m = m0 + ty * 4 + i, n = n0 + tx * 4 + j;
            if (m < M && n < N) {
                float v = acc[i][j];
                if (Cadd) v += Cadd[(size_t)m * ldadd + n];
                if (ACT == 1) v = tanhf(v);
                if (ACT == 2) v = 1.f / (1.f + expf(-v));
                C[(size_t)m * ldc + n] = v;
            }
        }
}

__device__ __forceinline__ float block_sum256(float v, float* red) {
    for (int o = 32; o > 0; o >>= 1) v += __shfl_xor(v, o);
    __syncthreads();
    if ((threadIdx.x & 63) == 0) red[threadIdx.x >> 6] = v;
    __syncthreads();
    return red[0] + red[1] + red[2] + red[3];
}

__global__ void __launch_bounds__(256) rmsnorm1024(const float* x, const float* g, float* out, float eps) {
    __shared__ float red[4];
    const size_t row = blockIdx.x; const int t = threadIdx.x;
    float4 v = *(const float4*)(x + row * 1024 + t * 4);
    float ss = block_sum256(v.x * v.x + v.y * v.y + v.z * v.z + v.w * v.w, red);
    float r = rsqrtf(ss * (1.f / 1024.f) + eps);
    float4 gg = *(const float4*)(g + t * 4);
    float4 o; o.x = v.x * r * gg.x; o.y = v.y * r * gg.y; o.z = v.z * r * gg.z; o.w = v.w * r * gg.w;
    *(float4*)(out + row * 1024 + t * 4) = o;
}

__global__ void __launch_bounds__(256) qk_prep(float* Z, const int* pos, const float* qg, const float* kg) {
    const int gw = blockIdx.x * 4 + (threadIdx.x >> 6), lane = threadIdx.x & 63;
    const int row = gw / 16, grp = gw % 16;
    float* p = Z + (size_t)row * 3072 + grp * 64;
    float v = p[lane];
    float ss = v * v;
    for (int o = 32; o > 0; o >>= 1) ss += __shfl_xor(ss, o);
    const float* g = grp < 8 ? qg : kg;
    float y = v * rsqrtf(ss * (1.f / 64.f) + 1e-6f) * g[lane];
    float other = __shfl_xor(y, 32);
    int i = lane & 31;
    float inv_freq = powf(10000.f, -(float)i / 32.f);
    float ang = (float)pos[row] * inv_freq;
    float c = cosf(ang), s = sinf(ang);
    float r = lane < 32 ? (y * c - other * s) : (y * c + other * s);
    p[lane] = r;
}

__global__ void __launch_bounds__(256) attn_naive(const float* Z, float* MIX, const float* lq1, const float* lk1, const float* lq2, const float* lk2, const float* og) {
    const int h = blockIdx.y, q = blockIdx.x * 32 + threadIdx.x / 8, sub = threadIdx.x % 8;
    float d1 = 0.f, d2 = 0.f;
    for (int i = 0; i < 64; ++i) { d1 += lq1[i] * lk1[i]; d2 += lq2[i] * lk2[i]; }
    const float lam = expf(d1) - expf(d2) + 0.2f;
    const float* qp = Z + (size_t)q * 3072 + h * 128;
    float m0 = -INFINITY, m1 = -INFINITY, l0 = 0.f, l1 = 0.f;
    const float scale = 0.125f;
    for (int j = sub; j <= q; j += 8) {
        const float* kp = Z + (size_t)j * 3072 + 512 + h * 128;
        float s0 = 0.f, s1 = 0.f;
        for (int d = 0; d < 64; d += 4) {
            float4 a = *(const float4*)(qp + d), b = *(const float4*)(kp + d);
            s0 += a.x * b.x + a.y * b.y + a.z * b.z + a.w * b.w;
            float4 a1 = *(const float4*)(qp + 64 + d), b1 = *(const float4*)(kp + 64 + d);
            s1 += a1.x * b1.x + a1.y * b1.y + a1.z * b1.z + a1.w * b1.w;
        }
        s0 *= scale; s1 *= scale;
        float n0 = fmaxf(m0, s0); l0 = l0 * expf(m0 - n0) + expf(s0 - n0); m0 = n0;
        float n1 = fmaxf(m1, s1); l1 = l1 * expf(m1 - n1) + expf(s1 - n1); m1 = n1;
    }
    for (int o = 1; o < 8; o <<= 1) {
        float om0 = __shfl_xor(m0, o), ol0 = __shfl_xor(l0, o), om1 = __shfl_xor(m1, o), ol1 = __shfl_xor(l1, o);
        float n0 = fmaxf(m0, om0); l0 = (m0 == -INFINITY ? 0.f : l0 * expf(m0 - n0)) + (om0 == -INFINITY ? 0.f : ol0 * expf(om0 - n0)); m0 = n0;
        float n1 = fmaxf(m1, om1); l1 = (m1 == -INFINITY ? 0.f : l1 * expf(m1 - n1)) + (om1 == -INFINITY ? 0.f : ol1 * expf(om1 - n1)); m1 = n1;
    }
    float o[16];
    for (int d = 0; d < 16; ++d) o[d] = 0.f;
    const int qmax = blockIdx.x * 32 + 31;
    for (int jb = 0; jb <= qmax; jb += 8) {
        const int j = jb + sub;
        float pj = 0.f;
        if (j <= q) {
            const float* kp = Z + (size_t)j * 3072 + 512 + h * 128;
            float s0 = 0.f, s1 = 0.f;
            for (int d = 0; d < 64; d += 4) {
                float4 a = *(const float4*)(qp + d), b = *(const float4*)(kp + d);
                s0 += a.x * b.x + a.y * b.y + a.z * b.z + a.w * b.w;
                float4 a1 = *(const float4*)(qp + 64 + d), b1 = *(const float4*)(kp + 64 + d);
                s1 += a1.x * b1.x + a1.y * b1.y + a1.z * b1.z + a1.w * b1.w;
            }
            pj = expf(s0 * scale - m0) / l0 - lam * expf(s1 * scale - m1) / l1;
        }
        for (int jj = 0; jj < 8; ++jj) {
            float pp = __shfl(pj, (threadIdx.x & 56) | jj);
            if (jb + jj <= qmax) {
                const float* vp = Z + (size_t)(jb + jj) * 3072 + 1024 + h * 128 + sub * 16;
                for (int d = 0; d < 16; ++d) o[d] += pp * vp[d];
            }
        }
    }
    float ss = 0.f;
    for (int d = 0; d < 16; ++d) ss += o[d] * o[d];
    for (int of = 1; of < 8; of <<= 1) ss += __shfl_xor(ss, of);
    float r = rsqrtf(ss * (1.f / 128.f) + 1e-5f) * 0.8f;
    for (int d = 0; d < 16; ++d) MIX[(size_t)q * 1024 + h * 128 + sub * 16 + d] = o[d] * r * og[sub * 16 + d];
}

__global__ void __launch_bounds__(256) rwkv_prep(const float* Z, const float* WL, const float* AL, const float* mu_rkv, const float* w0, const float* a0,
                                                const float* k_k, const float* k_a, float* R, float* W, float* K2, float* V, float* A2, float* B2) {
    const int gw = blockIdx.x * 4 + (threadIdx.x >> 6), lane = threadIdx.x & 63;
    const int row = gw / 8, hd = gw % 8, c = hd * 64 + lane;
    const float* z = Z + (size_t)row * 3072; const float* zp = z - 3072; const bool hp = (row % S_) != 0;
    float zr = z[1536 + c], zk = z[2048 + c], zv = z[2560 + c];
    float pr = hp ? zp[1536 + c] : 0.f, pk = hp ? zp[2048 + c] : 0.f, pv = hp ? zp[2560 + c] : 0.f;
    float r = zr + (pr - zr) * mu_rkv[c], k = zk + (pk - zk) * mu_rkv[512 + c], v = zv + (pv - zv) * mu_rkv[1024 + c];
    float wl = w0[c] + WL[(size_t)row * 512 + c];
    float nx = -wl; float sp = nx > 20.f ? nx : log1pf(expf(nx));
    float decay = expf(-expf(-sp - 0.5f));
    float a = 1.f / (1.f + expf(-(a0[c] + AL[(size_t)row * 512 + c])));
    float kk = k * k_k[c];
    float ss = kk * kk;
    for (int o = 32; o > 0; o >>= 1) ss += __shfl_xor(ss, o);
    kk = kk * rsqrtf(fmaxf(ss, 1e-24f));
    float k2 = k * (1.f + (a - 1.f) * k_a[c]);
    size_t o = (size_t)row * 512 + c;
    R[o] = r; W[o] = decay; K2[o] = k2; V[o] = v; A2[o] = -kk; B2[o] = kk * a;
}

__global__ void __launch_bounds__(64) rwkv_scan_naive(const float* R, const float* W, const float* K2, const float* V, const float* A2, const float* B2, float* Y) {
    __shared__ float sh[5][16][64];
    const int hd = blockIdx.x, lane = threadIdx.x;
    float st[64];
#pragma unroll
    for (int i = 0; i < 64; ++i) st[i] = 0.f;
    for (int t0 = 0; t0 < S_; t0 += 16) {
        __syncthreads();
        for (int i = 0; i < 16; ++i) {
            size_t o = (size_t)(t0 + i) * 512 + hd * 64 + lane;
            sh[0][i][lane] = R[o]; sh[1][i][lane] = W[o]; sh[2][i][lane] = K2[o]; sh[3][i][lane] = A2[o]; sh[4][i][lane] = B2[o];
        }
        __syncthreads();
        for (int i = 0; i < 16; ++i) {
            float v = V[(size_t)(t0 + i) * 512 + hd * 64 + lane];
            float sa = 0.f;
#pragma unroll
            for (int k = 0; k < 64; ++k) sa = fmaf(st[k], sh[3][i][k], sa);
            float y = 0.f;
#pragma unroll
            for (int k = 0; k < 64; ++k) { st[k] = st[k] * sh[1][i][k] + sa * sh[4][i][k] + v * sh[2][i][k]; y = fmaf(st[k], sh[0][i][k], y); }
            Y[(size_t)(t0 + i) * 512 + hd * 64 + lane] = y;
        }
    }
}

__global__ void __launch_bounds__(256) rwkv_post(const float* Y, const float* R, const float* K2, const float* V, const float* G, const float* r_k, const float* gn_w, const float* gn_b, float* MIX) {
    const int gw = blockIdx.x * 4 + (threadIdx.x >> 6), lane = threadIdx.x & 63;
    const int row = gw / 8, hd = gw % 8, c = hd * 64 + lane; const size_t o = (size_t)row * 512 + c;
    float y = Y[o];
    float s = y; for (int of = 32; of > 0; of >>= 1) s += __shfl_xor(s, of);
    float mu = s * (1.f / 64.f); float d = y - mu; float q = d * d; for (int of = 32; of > 0; of >>= 1) q += __shfl_xor(q, of);
    float yn = d * rsqrtf(q * (1.f / 64.f) + 64e-5f) * gn_w[c] + gn_b[c];
    float b = R[o] * K2[o] * r_k[c]; for (int of = 32; of > 0; of >>= 1) b += __shfl_xor(b, of);
    MIX[(size_t)row * 1024 + 512 + c] = (yn + b * V[o]) * G[o];
}

__global__ void __launch_bounds__(256) route(const float* LOG, int* cnt, int* list, float* wts, int M, int cap) {
    const int t = blockIdx.x * 256 + threadIdx.x; if (t >= M) return;
    const float* l = LOG + (size_t)t * 36;
    int gs = 0; float gm = l[0];
    for (int i = 1; i < 4; ++i) if (l[i] > gm) { gm = l[i]; gs = i; }
    float den = 0.f; for (int i = 0; i < 4; ++i) den += expf(l[i] - gm);
    float gw = 1.f / den;
    const float* e = l + 4 + 8 * gs;
    int i0 = 0; float v0 = e[0];
    for (int i = 1; i < 8; ++i) if (e[i] > v0) { v0 = e[i]; i0 = i; }
    int i1 = -1; float v1 = -INFINITY;
    for (int i = 0; i < 8; ++i) if (i != i0 && e[i] > v1) { v1 = e[i]; i1 = i; }
    float p1 = expf(v1 - v0); float w0 = gw / (1.f + p1), w1 = gw * p1 / (1.f + p1);
    wts[t * 2] = w0; wts[t * 2 + 1] = w1;
    int e0 = gs * 8 + i0, e1 = gs * 8 + i1;
    int p = atomicAdd(&cnt[e0], 1); list[e0 * cap + p] = t * 2;
    p = atomicAdd(&cnt[e1], 1); list[e1 * cap + p] = t * 2 + 1;
}

__global__ void __launch_bounds__(256) expert_up(const float* H2, const float* Wg, const float* Wu, const int* cnt, const int* list, float* HID, int cap) {
    __shared__ float As[16][68];
    __shared__ float Bg[16][68];
    __shared__ float Bu[16][68];
    const int e = blockIdx.z, M = cnt[e], m0 = blockIdx.y * 64, n0 = blockIdx.x * 64;
    if (m0 >= M) return;
    const int* rows = list + e * cap;
    const float* wg = Wg + (size_t)e * 1024 * 512; const float* wu = Wu + (size_t)e * 1024 * 512;
    const int tid = threadIdx.x, ty = tid / 16, tx = tid % 16;
    float ag[4][4], au[4][4];
    for (int i = 0; i < 4; ++i) for (int j = 0; j < 4; ++j) { ag[i][j] = 0.f; au[i][j] = 0.f; }
    for (int k0 = 0; k0 < 1024; k0 += 16) {
        for (int i = 0; i < 4; ++i) {
            int idx = tid + i * 256; int m = idx / 16, k = idx % 16;
            As[k][m] = (m0 + m < M) ? H2[(size_t)(rows[m0 + m] / 2) * 1024 + k0 + k] : 0.f;
            int kb = idx / 64, n = idx % 64;
            Bg[kb][n] = wg[(size_t)(k0 + kb) * 512 + n0 + n]; Bu[kb][n] = wu[(size_t)(k0 + kb) * 512 + n0 + n];
        }
        __syncthreads();
        for (int k = 0; k < 16; ++k) {
            float a[4], b[4], c[4];
            for (int i = 0; i < 4; ++i) { a[i] = As[k][ty * 4 + i]; b[i] = Bg[k][tx * 4 + i]; c[i] = Bu[k][tx * 4 + i]; }
            for (int i = 0; i < 4; ++i) for (int j = 0; j < 4; ++j) { ag[i][j] = fmaf(a[i], b[j], ag[i][j]); au[i][j] = fmaf(a[i], c[j], au[i][j]); }
        }
        __syncthreads();
    }
    for (int i = 0; i < 4; ++i) for (int j = 0; j < 4; ++j) {
        int m = m0 + ty * 4 + i, n = n0 + tx * 4 + j;
        if (m < M) { float g = ag[i][j]; HID[(size_t)rows[m] * 512 + n] = g / (1.f + expf(-g)) * au[i][j]; }
    }
}
__global__ void __launch_bounds__(256) expert_down(const float* HID, const float* Wd, const int* cnt, const int* list, float* YE, int cap) {
    __shared__ float As[16][68];
    __shared__ float Bs[16][68];
    const int e = blockIdx.z, M = cnt[e], m0 = blockIdx.y * 64, n0 = blockIdx.x * 64;
    if (m0 >= M) return;
    const int* rows = list + e * cap;
    const float* wd = Wd + (size_t)e * 512 * 1024;
    const int tid = threadIdx.x, ty = tid / 16, tx = tid % 16;
    float acc[4][4];
    for (int i = 0; i < 4; ++i) for (int j = 0; j < 4; ++j) acc[i][j] = 0.f;
    for (int k0 = 0; k0 < 512; k0 += 16) {
        for (int i = 0; i < 4; ++i) {
            int idx = tid + i * 256; int m = idx / 16, k = idx % 16;
            As[k][m] = (m0 + m < M) ? HID[(size_t)rows[m0 + m] * 512 + k0 + k] : 0.f;
            int kb = idx / 64, n = idx % 64;
            Bs[kb][n] = wd[(size_t)(k0 + kb) * 1024 + n0 + n];
        }
        __syncthreads();
        for (int k = 0; k < 16; ++k) {
            float a[4], b[4];
            for (int i = 0; i < 4; ++i) { a[i] = As[k][ty * 4 + i]; b[i] = Bs[k][tx * 4 + i]; }
            for (int i = 0; i < 4; ++i) for (int j = 0; j < 4; ++j) acc[i][j] = fmaf(a[i], b[j], acc[i][j]);
        }
        __syncthreads();
    }
    for (int i = 0; i < 4; ++i) for (int j = 0; j < 4; ++j) {
        int m = m0 + ty * 4 + i, n = n0 + tx * 4 + j;
        if (m < M) YE[(size_t)rows[m] * 1024 + n] = acc[i][j];
    }
}
__global__ void __launch_bounds__(256) moe_combine(const float* X1, const float* YE, const float* wts, float* X2) {
    const size_t t = blockIdx.x; const int c = threadIdx.x * 4;
    float4 x = *(const float4*)(X1 + t * 1024 + c), a = *(const float4*)(YE + (2 * t) * 1024 + c), b = *(const float4*)(YE + (2 * t + 1) * 1024 + c);
    float w0 = wts[2 * t], w1 = wts[2 * t + 1];
    float4 o; o.x = x.x + w0 * a.x + w1 * b.x; o.y = x.y + w0 * a.y + w1 * b.y; o.z = x.z + w0 * a.z + w1 * b.z; o.w = x.w + w0 * a.w + w1 * b.w;
    *(float4*)(X2 + t * 1024 + c) = o;
}
__global__ void __launch_bounds__(256) final_pl(const float* X2, const float* PE, const float* GATE, const float* g, float* out) {
    __shared__ float red[4];
    const size_t row = blockIdx.x; const int t = threadIdx.x;
    float4 v = *(const float4*)(PE + row * 1024 + t * 4);
    float ss = block_sum256(v.x * v.x + v.y * v.y + v.z * v.z + v.w * v.w, red);
    float r = rsqrtf(ss * (1.f / 1024.f) + 1e-6f);
    float4 gg = *(const float4*)(g + t * 4), x = *(const float4*)(X2 + row * 1024 + t * 4), ga = *(const float4*)(GATE + row * 1024 + t * 4);
    float4 o;
    o.x = x.x + v.x * r * gg.x / (1.f + expf(-ga.x)); o.y = x.y + v.y * r * gg.y / (1.f + expf(-ga.y));
    o.z = x.z + v.z * r * gg.z / (1.f + expf(-ga.z)); o.w = x.w + v.w * r * gg.w / (1.f + expf(-ga.w));
    *(float4*)(out + row * 1024 + t * 4) = o;
}

template <class AL, int ACT>
static void gemm(hipStream_t st, AL al, const float* B, int ldb, float* C, int ldc, const float* Cadd, int ldadd, int M, int N, int K) {
    dim3 grid((N + 63) / 64, (M + 63) / 64);
    sgemm<AL, ACT><<<grid, 256, 0, st>>>(al, B, ldb, C, ldc, Cadd, ldadd, M, nullptr, N, K);
}

static void forward_batch(void* const* d_in, int b, float* out, float* ws, hipStream_t st) {
    auto F = [&](int i) { return (const float*)d_in[i]; };
    const float* x = F(0) + (size_t)b * S_ * D_; const float* p = F(1) + (size_t)b * S_ * 256; const int* pos = (const int*)d_in[2] + b * S_;
    size_t o = 0; auto take = [&](size_t n) { float* r = ws + o; o += (n + 63) / 64 * 64; return r; };
    float* HN = take((size_t)MB * 1024); float* Z = take((size_t)MB * 3072); float* MIX = take((size_t)MB * 1024);
    float* L1 = take((size_t)MB * 64); float* L2 = take((size_t)MB * 64); float* L3 = take((size_t)MB * 160);
    float* WL = take((size_t)MB * 512); float* AL = take((size_t)MB * 512); float* G = take((size_t)MB * 512);
    float* R = take((size_t)MB * 512); float* W = take((size_t)MB * 512); float* K2 = take((size_t)MB * 512); float* V = take((size_t)MB * 512);
    float* A2 = take((size_t)MB * 512); float* B2 = take((size_t)MB * 512); float* Y = take((size_t)MB * 512);
    float* X1 = take((size_t)MB * 1024); float* H2 = take((size_t)MB * 1024); float* LOG = take((size_t)MB * 36);
    float* wts = take((size_t)MB * 2); int* cnt = (int*)take(64); int* list = (int*)take((size_t)32 * MB);
    float* HID = take((size_t)MB * 2 * 512); float* YE = take((size_t)MB * 2 * 1024); float* X2 = take((size_t)MB * 1024);
    float* PE = take((size_t)MB * 1024); float* GATE = take((size_t)MB * 1024);

    rmsnorm1024<<<MB, 256, 0, st>>>(x, F(3), HN, 1e-6f);
    gemm<ALPlain, 0>(st, ALPlain{HN, 1024}, F(4), 3072, Z, 3072, nullptr, 0, MB, 3072, 1024);
    gemm<ALShiftMix, 1>(st, ALShiftMix{HN, F(13)}, F(15), 64, L1, 64, nullptr, 0, MB, 64, 1024);
    gemm<ALShiftMix, 0>(st, ALShiftMix{HN, F(13) + 1024}, F(18), 64, L2, 64, nullptr, 0, MB, 64, 1024);
    gemm<ALShiftMix, 2>(st, ALShiftMix{HN, F(13) + 2048}, F(20), 160, L3, 160, nullptr, 0, MB, 160, 1024);
    gemm<ALPlain, 0>(st, ALPlain{L1, 64}, F(16), 512, WL, 512, nullptr, 0, MB, 512, 64);
    gemm<ALPlain, 0>(st, ALPlain{L2, 64}, F(19), 512, AL, 512, nullptr, 0, MB, 512, 64);
    gemm<ALPlain, 0>(st, ALPlain{L3, 160}, F(21), 512, G, 512, nullptr, 0, MB, 512, 160);
    rwkv_prep<<<MB * 8 / 4, 256, 0, st>>>(Z, WL, AL, F(12), F(14), F(17), F(22), F(23), R, W, K2, V, A2, B2);
    rwkv_scan_naive<<<8, 64, 0, st>>>(R, W, K2, V, A2, B2, Y);
    rwkv_post<<<MB * 8 / 4, 256, 0, st>>>(Y, R, K2, V, G, F(24), F(25), F(26), MIX);
    qk_prep<<<MB * 16 / 4, 256, 0, st>>>(Z, pos, F(5), F(6));
    attn_naive<<<dim3(S_ / 32, 4), 256, 0, st>>>(Z, MIX, F(7), F(8), F(9), F(10), F(11));
    gemm<ALPlain, 0>(st, ALPlain{MIX, 1024}, F(27), 1024, X1, 1024, x, 1024, MB, 1024, 1024);
    rmsnorm1024<<<MB, 256, 0, st>>>(X1, F(28), H2, 1e-6f);
    gemm<ALPlain, 0>(st, ALPlain{H2, 1024}, F(29), 4, LOG, 36, nullptr, 0, MB, 4, 1024);
    for (int g = 0; g < 4; ++g) gemm<ALPlain, 0>(st, ALPlain{H2, 1024}, F(30) + (size_t)g * 1024 * 8, 8, LOG + 4 + 8 * g, 36, nullptr, 0, MB, 8, 1024);
    hipMemsetAsync(cnt, 0, 64 * sizeof(int), st);
    route<<<MB / 256, 256, 0, st>>>(LOG, cnt, list, wts, MB, MB);
    expert_up<<<dim3(512 / 64, MB / 64, 32), 256, 0, st>>>(H2, F(31), F(32), cnt, list, HID, MB);
    expert_down<<<dim3(1024 / 64, MB / 64, 32), 256, 0, st>>>(HID, F(33), cnt, list, YE, MB);
    moe_combine<<<MB, 256, 0, st>>>(X1, YE, wts, X2);
    rmsnorm1024<<<MB, 256, 0, st>>>(X2, F(36), H2, 1e-6f);
    gemm<ALPlain, 0>(st, ALPlain{H2, 1024}, F(37), 1024, GATE, 1024, nullptr, 0, MB, 1024, 1024);
    gemm<ALPlain, 0>(st, ALPlain{p, 256}, F(34), 1024, PE, 1024, nullptr, 0, MB, 1024, 256);
    final_pl<<<MB, 256, 0, st>>>(X2, PE, GATE, F(35), out);
}
}

extern "C" void kernel_launch(void* const* d_in, const int* in_sizes, int n_in, void* d_out, int out_size, void* d_ws, size_t ws_size, hipStream_t stream) {
    for (int b = 0; b < nv::NB; ++b) nv::forward_batch(d_in, b, (float*)d_out + (size_t)b * nv::S_ * nv::D_, (float*)d_ws, stream);
}
```

```cpp
#define MK_NB 8
#include <hip/hip_runtime.h>
#include <cstdint>
#include <cstdio>
#include <cmath>

namespace nv {
constexpr int S_ = 2048, D_ = 1024, NB = 8;
constexpr int MB = S_;

struct ALPlain { const float* A; int lda; int pad; __device__ __forceinline__ float operator()(int m, int k) const { return A[(size_t)m * lda + k]; } };
struct ALShiftMix { const float* H; const float* mu;
    __device__ __forceinline__ float operator()(int m, int k) const { float h = H[(size_t)m * 1024 + k]; float hp = (m % S_) ? H[(size_t)(m - 1) * 1024 + k] : 0.f; return h + (hp - h) * mu[k]; } };
struct ALGather { const float* A; int lda; const int* rows; int div;
    __device__ __forceinline__ float operator()(int m, int k) const { return A[(size_t)(rows[m] / div) * lda + k]; } };

template <class AL, int ACT>
__global__ void __launch_bounds__(256) sgemm(AL al, const float* __restrict__ B, int ldb, float* C, int ldc, const float* Cadd, int ldadd,
                                            int M, const int* Mptr, int N, int K) {
    __shared__ float As[16][68];
    __shared__ float Bs[16][68];
    if (Mptr) M = *Mptr;
    const int m0 = blockIdx.y * 64, n0 = blockIdx.x * 64;
    if (m0 >= M) return;
    const int tid = threadIdx.x, ty = tid / 16, tx = tid % 16;
    float acc[4][4];
#pragma unroll
    for (int i = 0; i < 4; ++i)
#pragma unroll
        for (int j = 0; j < 4; ++j) acc[i][j] = 0.f;
    for (int k0 = 0; k0 < K; k0 += 16) {
#pragma unroll
        for (int i = 0; i < 4; ++i) {
            int idx = tid + i * 256; int m = idx / 16, k = idx % 16;
            As[k][m] = (m0 + m < M) ? al(m0 + m, k0 + k) : 0.f;
            int kb = idx / 64, n = idx % 64;
            Bs[kb][n] = (n0 + n < N) ? B[(size_t)(k0 + kb) * ldb + n0 + n] : 0.f;
        }
        __syncthreads();
#pragma unroll
        for (int k = 0; k < 16; ++k) {
            float a[4], b[4];
#pragma unroll
            for (int i = 0; i < 4; ++i) { a[i] = As[k][ty * 4 + i]; b[i] = Bs[k][tx * 4 + i]; }
#pragma unroll
            for (int i = 0; i < 4; ++i)
#pragma unroll
                for (int j = 0; j < 4; ++j) acc[i][j] = fmaf(a[i], b[j], acc[i][j]);
        }
        __syncthreads();
    }
#pragma unroll
    for (int i = 0; i < 4; ++i)
#pragma unroll
        for (int j = 0; j < 4; ++j) {
            int m = m0 + ty * 4 + i, n = n0 + tx * 4 + j;
            if (m < M && n < N) {
                float v = acc[i][j];
                if (Cadd) v += Cadd[(size_t)m * ldadd + n];
                if (ACT == 1) v = tanhf(v);
                if (ACT == 2) v = 1.f / (1.f + expf(-v));
                C[(size_t)m * ldc + n] = v;
            }
        }
}

__device__ __forceinline__ float block_sum256(float v, float* red) {
    for (int o = 32; o > 0; o >>= 1) v += __shfl_xor(v, o);
    __syncthreads();
    if ((threadIdx.x & 63) == 0) red[threadIdx.x >> 6] = v;
    __syncthreads();
    return red[0] + red[1] + red[2] + red[3];
}

__global__ void __launch_bounds__(256) rmsnorm1024(const float* x, const float* g, float* out, float eps) {
    __shared__ float red[4];
    const size_t row = blockIdx.x; const int t = threadIdx.x;
    float4 v = *(const float4*)(x + row * 1024 + t * 4);
    float ss = block_sum256(v.x * v.x + v.y * v.y + v.z * v.z + v.w * v.w, red);
    float r = rsqrtf(ss * (1.f / 1024.f) + eps);
    float4 gg = *(const float4*)(g + t * 4);
    float4 o; o.x = v.x * r * gg.x; o.y = v.y * r * gg.y; o.z = v.z * r * gg.z; o.w = v.w * r * gg.w;
    *(float4*)(out + row * 1024 + t * 4) = o;
}

__global__ void __launch_bounds__(256) qk_prep(float* Z, const int* pos, const float* qg, const float* kg) {
    const int gw = blockIdx.x * 4 + (threadIdx.x >> 6), lane = threadIdx.x & 63;
    const int row = gw / 16, grp = gw % 16;
    float* p = Z + (size_t)row * 3072 + grp * 64;
    float v = p[lane];
    float ss = v * v;
    for (int o = 32; o > 0; o >>= 1) ss += __shfl_xor(ss, o);
    const float* g = grp < 8 ? qg : kg;
    float y = v * rsqrtf(ss * (1.f / 64.f) + 1e-6f) * g[lane];
    float other = __shfl_xor(y, 32);
    int i = lane & 31;
    float inv_freq = powf(10000.f, -(float)i / 32.f);
    float ang = (float)pos[row] * inv_freq;
    float c = cosf(ang), s = sinf(ang);
    float r = lane < 32 ? (y * c - other * s) : (y * c + other * s);
    p[lane] = r;
}

__global__ void __launch_bounds__(256) attn_naive(const float* Z, float* MIX, const float* lq1, const float* lk1, const float* lq2, const float* lk2, const float* og) {
    const int h = blockIdx.y, q = blockIdx.x * 32 + threadIdx.x / 8, sub = threadIdx.x % 8;
    float d1 = 0.f, d2 = 0.f;
    for (int i = 0; i < 64; ++i) { d1 += lq1[i] * lk1[i]; d2 += lq2[i] * lk2[i]; }
    const float lam = expf(d1) - expf(d2) + 0.2f;
    const float* qp = Z + (size_t)q * 3072 + h * 128;
    float m0 = -INFINITY, m1 = -INFINITY, l0 = 0.f, l1 = 0.f;
    const float scale = 0.125f;
    for (int j = sub; j <= q; j += 8) {
        const float* kp = Z + (size_t)j * 3072 + 512 + h * 128;
        float s0 = 0.f, s1 = 0.f;
        for (int d = 0; d < 64; d += 4) {
            float4 a = *(const float4*)(qp + d), b = *(const float4*)(kp + d);
            s0 += a.x * b.x + a.y * b.y + a.z * b.z + a.w * b.w;
            float4 a1 = *(const float4*)(qp + 64 + d), b1 = *(const float4*)(kp + 64 + d);
            s1 += a1.x * b1.x + a1.y * b1.y + a1.z * b1.z + a1.w * b1.w;
        }
        s0 *= scale; s1 *= scale;
        float n0 = fmaxf(m0, s0); l0 = l0 * expf(m0 - n0) + expf(s0 - n0); m0 = n0;
        float n1 = fmaxf(m1, s1); l1 = l1 * expf(m1 - n1) + expf(s1 - n1); m1 = n1;
    }
    for (int o = 1; o < 8; o <<= 1) {
        float om0 = __shfl_xor(m0, o), ol0 = __shfl_xor(l0, o), om1 = __shfl_xor(m1, o), ol1 = __shfl_xor(l1, o);
        float n0 = fmaxf(m0, om0); l0 = (m0 == -INFINITY ? 0.f : l0 * expf(m0 - n0)) + (om0 == -INFINITY ? 0.f : ol0 * expf(om0 - n0)); m0 = n0;
        float n1 = fmaxf(m1, om1); l1 = (m1 == -INFINITY ? 0.f : l1 * expf(m1 - n1)) + (om1 == -INFINITY ? 0.f : ol1 * expf(om1 - n1)); m1 = n1;
    }
    float o[16];
    for (int d = 0; d < 16; ++d) o[d] = 0.f;
    const int qmax = blockIdx.x * 32 + 31;
    for (int jb = 0; jb <= qmax; jb += 8) {
        const int j = jb + sub;
        float pj = 0.f;
        if (j <= q) {
            const float* kp = Z + (size_t)j * 3072 + 512 + h * 128;
            float s0 = 0.f, s1 = 0.f;
            for (int d = 0; d < 64; d += 4) {
                float4 a = *(const float4*)(qp + d), b = *(const float4*)(kp + d);
                s0 += a.x * b.x + a.y * b.y + a.z * b.z + a.w * b.w;
                float4 a1 = *(const float4*)(qp + 64 + d), b1 = *(const float4*)(kp + 64 + d);
                s1 += a1.x * b1.x + a1.y * b1.y + a1.z * b1.z + a1.w * b1.w;
            }
            pj = expf(s0 * scale - m0) / l0 - lam * expf(s1 * scale - m1) / l1;
        }
        for (int jj = 0; jj < 8; ++jj) {
            float pp = __shfl(pj, (threadIdx.x & 56) | jj);
            if (jb + jj <= qmax) {
                const float* vp = Z + (size_t)(jb + jj) * 3072 + 1024 + h * 128 + sub * 16;
                for (int d = 0; d < 16; ++d) o[d] += pp * vp[d];
            }
        }
    }
    float ss = 0.f;
    for (int d = 0; d < 16; ++d) ss += o[d] * o[d];
    for (int of = 1; of < 8; of <<= 1) ss += __shfl_xor(ss, of);
    float r = rsqrtf(ss * (1.f / 128.f) + 1e-5f) * 0.8f;
    for (int d = 0; d < 16; ++d) MIX[(size_t)q * 1024 + h * 128 + sub * 16 + d] = o[d] * r * og[sub * 16 + d];
}

__global__ void __launch_bounds__(256) rwkv_prep(const float* Z, const float* WL, const float* AL, const float* mu_rkv, const float* w0, const float* a0,
                                                const float* k_k, const float* k_a, float* R, float* W, float* K2, float* V, float* A2, float* B2) {
    const int gw = blockIdx.x * 4 + (threadIdx.x >> 6), lane = threadIdx.x & 63;
    const int row = gw / 8, hd = gw % 8, c = hd * 64 + lane;
    const float* z = Z + (size_t)row * 3072; const float* zp = z - 3072; const bool hp = (row % S_) != 0;
    float zr = z[1536 + c], zk = z[2048 + c], zv = z[2560 + c];
    float pr = hp ? zp[1536 + c] : 0.f, pk = hp ? zp[2048 + c] : 0.f, pv = hp ? zp[2560 + c] : 0.f;
    float r = zr + (pr - zr) * mu_rkv[c], k = zk + (pk - zk) * mu_rkv[512 + c], v = zv + (pv - zv) * mu_rkv[1024 + c];
    float wl = w0[c] + WL[(size_t)row * 512 + c];
    float nx = -wl; float sp = nx > 20.f ? nx : log1pf(expf(nx));
    float decay = expf(-expf(-sp - 0.5f));
    float a = 1.f / (1.f + expf(-(a0[c] + AL[(size_t)row * 512 + c])));
    float kk = k * k_k[c];
    float ss = kk * kk;
    for (int o = 32; o > 0; o >>= 1) ss += __shfl_xor(ss, o);
    kk = kk * rsqrtf(fmaxf(ss, 1e-24f));
    float k2 = k * (1.f + (a - 1.f) * k_a[c]);
    size_t o = (size_t)row * 512 + c;
    R[o] = r; W[o] = decay; K2[o] = k2; V[o] = v; A2[o] = -kk; B2[o] = kk * a;
}

__global__ void __launch_bounds__(64) rwkv_scan_naive(const float* R, const float* W, const float* K2, const float* V, const float* A2, const float* B2, float* Y) {
    __shared__ float sh[5][16][64];
    const int hd = blockIdx.x, lane = threadIdx.x;
    float st[64];
#pragma unroll
    for (int i = 0; i < 64; ++i) st[i] = 0.f;
    for (int t0 = 0; t0 < S_; t0 += 16) {
        __syncthreads();
        for (int i = 0; i < 16; ++i) {
            size_t o = (size_t)(t0 + i) * 512 + hd * 64 + lane;
            sh[0][i][lane] = R[o]; sh[1][i][lane] = W[o]; sh[2][i][lane] = K2[o]; sh[3][i][lane] = A2[o]; sh[4][i][lane] = B2[o];
        }
        __syncthreads();
        for (int i = 0; i < 16; ++i) {
            float v = V[(size_t)(t0 + i) * 512 + hd * 64 + lane];
            float sa = 0.f;
#pragma unroll
            for (int k = 0; k < 64; ++k) sa = fmaf(st[k], sh[3][i][k], sa);
            float y = 0.f;
#pragma unroll
            for (int k = 0; k < 64; ++k) { st[k] = st[k] * sh[1][i][k] + sa * sh[4][i][k] + v * sh[2][i][k]; y = fmaf(st[k], sh[0][i][k], y); }
            Y[(size_t)(t0 + i) * 512 + hd * 64 + lane] = y;
        }
    }
}

__global__ void __launch_bounds__(256) rwkv_post(const float* Y, const float* R, const float* K2, const float* V, const float* G, const float* r_k, const float* gn_w, const float* gn_b, float* MIX) {
    const int gw = blockIdx.x * 4 + (threadIdx.x >> 6), lane = threadIdx.x & 63;
    const int row = gw / 8, hd = gw % 8, c = hd * 64 + lane; const size_t o = (size_t)row * 512 + c;
    float y = Y[o];
    float s = y; for (int of = 32; of > 0; of >>= 1) s += __shfl_xor(s, of);
    float mu = s * (1.f / 64.f); float d = y - mu; float q = d * d; for (int of = 32; of > 0; of >>= 1) q += __shfl_xor(q, of);
    float yn = d * rsqrtf(q * (1.f / 64.f) + 64e-5f) * gn_w[c] + gn_b[c];
    float b = R[o] * K2[o] * r_k[c]; for (int of = 32; of > 0; of >>= 1) b += __shfl_xor(b, of);
    MIX[(size_t)row * 1024 + 512 + c] = (yn + b * V[o]) * G[o];
}

__global__ void __launch_bounds__(256) route(const float* LOG, int* cnt, int* list, float* wts, int M, int cap) {
    const int t = blockIdx.x * 256 + threadIdx.x; if (t >= M) return;
    const float* l = LOG + (size_t)t * 36;
    int gs = 0; float gm = l[0];
    for (int i = 1; i < 4; ++i) if (l[i] > gm) { gm = l[i]; gs = i; }
    float den = 0.f; for (int i = 0; i < 4; ++i) den += expf(l[i] - gm);
    float gw = 1.f / den;
    const float* e = l + 4 + 8 * gs;
    int i0 = 0; float v0 = e[0];
    for (int i = 1; i < 8; ++i) if (e[i] > v0) { v0 = e[i]; i0 = i; }
    int i1 = -1; float v1 = -INFINITY;
    for (int i = 0; i < 8; ++i) if (i != i0 && e[i] > v1) { v1 = e[i]; i1 = i; }
    float p1 = expf(v1 - v0); float w0 = gw / (1.f + p1), w1 = gw * p1 / (1.f + p1);
    wts[t * 2] = w0; wts[t * 2 + 1] = w1;
    int e0 = gs * 8 + i0, e1 = gs * 8 + i1;
    int p = atomicAdd(&cnt[e0], 1); list[e0 * cap + p] = t * 2;
    p = atomicAdd(&cnt[e1], 1); list[e1 * cap + p] = t * 2 + 1;
}

__global__ void __launch_bounds__(256) expert_up(const float* H2, const float* Wg, const float* Wu, const int* cnt, const int* list, float* HID, int cap) {
    __shared__ float As[16][68];
    __shared__ float Bg[16][68];
    __shared__ float Bu[16][68];
    const int e = blockIdx.z, M = cnt[e], m0 = blockIdx.y * 64, n0 = blockIdx.x * 64;
    if (m0 >= M) return;
    const int* rows = list + e * cap;
    const float* wg = Wg + (size_t)e * 1024 * 512; const float* wu = Wu + (size_t)e * 1024 * 512;
    const int tid = threadIdx.x, ty = tid / 16, tx = tid % 16;
    float ag[4][4], au[4][4];
    for (int i = 0; i < 4; ++i) for (int j = 0; j < 4; ++j) { ag[i][j] = 0.f; au[i][j] = 0.f; }
    for (int k0 = 0; k0 < 1024; k0 += 16) {
        for (int i = 0; i < 4; ++i) {
            int idx = tid + i * 256; int m = idx / 16, k = idx % 16;
            As[k][m] = (m0 + m < M) ? H2[(size_t)(rows[m0 + m] / 2) * 1024 + k0 + k] : 0.f;
            int kb = idx / 64, n = idx % 64;
            Bg[kb][n] = wg[(size_t)(k0 + kb) * 512 + n0 + n]; Bu[kb][n] = wu[(size_t)(k0 + kb) * 512 + n0 + n];
        }
        __syncthreads();
        for (int k = 0; k < 16; ++k) {
            float a[4], b[4], c[4];
            for (int i = 0; i < 4; ++i) { a[i] = As[k][ty * 4 + i]; b[i] = Bg[k][tx * 4 + i]; c[i] = Bu[k][tx * 4 + i]; }
            for (int i = 0; i < 4; ++i) for (int j = 0; j < 4; ++j) { ag[i][j] = fmaf(a[i], b[j], ag[i][j]); au[i][j] = fmaf(a[i], c[j], au[i][j]); }
        }
        __syncthreads();
    }
    for (int i = 0; i < 4; ++i) for (int j = 0; j < 4; ++j) {
        int m = m0 + ty * 4 + i, n = n0 + tx * 4 + j;
        if (m < M) { float g = ag[i][j]; HID[(size_t)rows[m] * 512 + n] = g / (1.f + expf(-g)) * au[i][j]; }
    }
}
__global__ void __launch_bounds__(256) expert_down(const float* HID, const float* Wd, const int* cnt, const int* list, float* YE, int cap) {
    __shared__ float As[16][68];
    __shared__ float Bs[16][68];
    const int e = blockIdx.z, M = cnt[e], m0 = blockIdx.y * 64, n0 = blockIdx.x * 64;
    if (m0 >= M) return;
    const int* rows = list + e * cap;
    const float* wd = Wd + (size_t)e * 512 * 1024;
    const int tid = threadIdx.x, ty = tid / 16, tx = tid % 16;
    float acc[4][4];
    for (int i = 0; i < 4; ++i) for (int j = 0; j < 4; ++j) acc[i][j] = 0.f;
    for (int k0 = 0; k0 < 512; k0 += 16) {
        for (int i = 0; i < 4; ++i) {
            int idx = tid + i * 256; int m = idx / 16, k = idx % 16;
            As[k][m] = (m0 + m < M) ? HID[(size_t)rows[m0 + m] * 512 + k0 + k] : 0.f;
            int kb = idx / 64, n = idx % 64;
            Bs[kb][n] = wd[(size_t)(k0 + kb) * 1024 + n0 + n];
        }
        __syncthreads();
        for (int k = 0; k < 16; ++k) {
            float a[4], b[4];
            for (int i = 0; i < 4; ++i) { a[i] = As[k][ty * 4 + i]; b[i] = Bs[k][tx * 4 + i]; }
            for (int i = 0; i < 4; ++i) for (int j = 0; j < 4; ++j) acc[i][j] = fmaf(a[i], b[j], acc[i][j]);
        }
        __syncthreads();
    }
    for (int i = 0; i < 4; ++i) for (int j = 0; j < 4; ++j) {
        int m = m0 + ty * 4 + i, n = n0 + tx * 4 + j;
        if (m < M) YE[(size_t)rows[m] * 1024 + n] = acc[i][j];
    }
}
__global__ void __launch_bounds__(256) moe_combine(const float* X1, const float* YE, const float* wts, float* X2) {
    const size_t t = blockIdx.x; const int c = threadIdx.x * 4;
    float4 x = *(const float4*)(X1 + t * 1024 + c), a = *(const float4*)(YE + (2 * t) * 1024 + c), b = *(const float4*)(YE + (2 * t + 1) * 1024 + c);
    float w0 = wts[2 * t], w1 = wts[2 * t + 1];
    float4 o; o.x = x.x + w0 * a.x + w1 * b.x; o.y = x.y + w0 * a.y + w1 * b.y; o.z = x.z + w0 * a.z + w1 * b.z; o.w = x.w + w0 * a.w + w1 * b.w;
    *(float4*)(X2 + t * 1024 + c) = o;
}
__global__ void __launch_bounds__(256) final_pl(const float* X2, const float* PE, const float* GATE, const float* g, float* out) {
    __shared__ float red[4];
    const size_t row = blockIdx.x; const int t = threadIdx.x;
    float4 v = *(const float4*)(PE + row * 1024 + t * 4);
    float ss = block_sum256(v.x * v.x + v.y * v.y + v.z * v.z + v.w * v.w, red);
    float r = rsqrtf(ss * (1.f / 1024.f) + 1e-6f);
    float4 gg = *(const float4*)(g + t * 4), x = *(const float4*)(X2 + row * 1024 + t * 4), ga = *(const float4*)(GATE + row * 1024 + t * 4);
    float4 o;
    o.x = x.x + v.x * r * gg.x / (1.f + expf(-ga.x)); o.y = x.y + v.y * r * gg.y / (1.f + expf(-ga.y));
    o.z = x.z + v.z * r * gg.z / (1.f + expf(-ga.z)); o.w = x.w + v.w * r * gg.w / (1.f + expf(-ga.w));
    *(float4*)(out + row * 1024 + t * 4) = o;
}

template <class AL, int ACT>
static void gemm(hipStream_t st, AL al, const float* B, int ldb, float* C, int ldc, const float* Cadd, int ldadd, int M, int N, int K) {
    dim3 grid((N + 63) / 64, (M + 63) / 64);
    sgemm<AL, ACT><<<grid, 256, 0, st>>>(al, B, ldb, C, ldc, Cadd, ldadd, M, nullptr, N, K);
}

struct NBufs { float *Z, *L1, *L2, *L3, *PE, *MIX, *Y, *X1; };
static NBufs forward_batch(void* const* d_in, int b, float* out, float* ws, hipStream_t st, int mode, int part) {
    auto F = [&](int i) { return (const float*)d_in[i]; };
    const float* x = F(0) + (size_t)b * S_ * D_; const float* p = F(1) + (size_t)b * S_ * 256; const int* pos = (const int*)d_in[2] + b * S_;
    size_t o = 0; auto take = [&](size_t n) { float* r = ws + o; o += (n + 63) / 64 * 64; return r; };
    float* HN = take((size_t)MB * 1024); float* Z = take((size_t)MB * 3072); float* MIX = take((size_t)MB * 1024);
    float* L1 = take((size_t)MB * 64); float* L2 = take((size_t)MB * 64); float* L3 = take((size_t)MB * 160);
    float* WL = take((size_t)MB * 512); float* AL = take((size_t)MB * 512); float* G = take((size_t)MB * 512);
    float* R = take((size_t)MB * 512); float* W = take((size_t)MB * 512); float* K2 = take((size_t)MB * 512); float* V = take((size_t)MB * 512);
    float* A2 = take((size_t)MB * 512); float* B2 = take((size_t)MB * 512); float* Y = take((size_t)MB * 512);
    float* X1 = take((size_t)MB * 1024); float* H2 = take((size_t)MB * 1024); float* LOG = take((size_t)MB * 36);
    float* wts = take((size_t)MB * 2); int* cnt = (int*)take(64); int* list = (int*)take((size_t)32 * MB);
    float* HID = take((size_t)MB * 2 * 512); float* YE = take((size_t)MB * 2 * 1024); float* X2 = take((size_t)MB * 1024);
    float* PE = take((size_t)MB * 1024); float* GATE = take((size_t)MB * 1024);

    NBufs nb{Z, L1, L2, L3, PE, MIX, Y, X1};
    if (part == 0) return nb;
    if (mode == 0) {
    rmsnorm1024<<<MB, 256, 0, st>>>(x, F(3), HN, 1e-6f);
    gemm<ALPlain, 0>(st, ALPlain{HN, 1024, 0}, F(4), 3072, Z, 3072, nullptr, 0, MB, 3072, 1024);
    gemm<ALShiftMix, 1>(st, ALShiftMix{HN, F(13)}, F(15), 64, L1, 64, nullptr, 0, MB, 64, 1024);
    gemm<ALShiftMix, 0>(st, ALShiftMix{HN, F(13) + 1024}, F(18), 64, L2, 64, nullptr, 0, MB, 64, 1024);
    gemm<ALShiftMix, 2>(st, ALShiftMix{HN, F(13) + 2048}, F(20), 160, L3, 160, nullptr, 0, MB, 160, 1024);
    }
    if (mode < 3) {
    gemm<ALPlain, 0>(st, ALPlain{L1, 64, 0}, F(16), 512, WL, 512, nullptr, 0, MB, 512, 64);
    gemm<ALPlain, 0>(st, ALPlain{L2, 64, 0}, F(19), 512, AL, 512, nullptr, 0, MB, 512, 64);
    gemm<ALPlain, 0>(st, ALPlain{L3, 160, 0}, F(21), 512, G, 512, nullptr, 0, MB, 512, 160);
    rwkv_prep<<<MB * 8 / 4, 256, 0, st>>>(Z, WL, AL, F(12), F(14), F(17), F(22), F(23), R, W, K2, V, A2, B2);
    rwkv_scan_naive<<<8, 64, 0, st>>>(R, W, K2, V, A2, B2, Y);
    rwkv_post<<<MB * 8 / 4, 256, 0, st>>>(Y, R, K2, V, G, F(24), F(25), F(26), MIX);
    }
    if (mode == 0) qk_prep<<<MB * 16 / 4, 256, 0, st>>>(Z, pos, F(5), F(6));
    if (mode < 2) attn_naive<<<dim3(S_ / 32, 4), 256, 0, st>>>(Z, MIX, F(7), F(8), F(9), F(10), F(11));
    gemm<ALPlain, 0>(st, ALPlain{MIX, 1024, 0}, F(27), 1024, X1, 1024, x, 1024, MB, 1024, 1024);
    rmsnorm1024<<<MB, 256, 0, st>>>(X1, F(28), H2, 1e-6f);
    gemm<ALPlain, 0>(st, ALPlain{H2, 1024, 0}, F(29), 4, LOG, 36, nullptr, 0, MB, 4, 1024);
    for (int g = 0; g < 4; ++g) gemm<ALPlain, 0>(st, ALPlain{H2, 1024, 0}, F(30) + (size_t)g * 1024 * 8, 8, LOG + 4 + 8 * g, 36, nullptr, 0, MB, 8, 1024);
    hipMemsetAsync(cnt, 0, 64 * sizeof(int), st);
    route<<<MB / 256, 256, 0, st>>>(LOG, cnt, list, wts, MB, MB);
    expert_up<<<dim3(512 / 64, MB / 64, 32), 256, 0, st>>>(H2, F(31), F(32), cnt, list, HID, MB);
    expert_down<<<dim3(1024 / 64, MB / 64, 32), 256, 0, st>>>(HID, F(33), cnt, list, YE, MB);
    moe_combine<<<MB, 256, 0, st>>>(X1, YE, wts, X2);
    rmsnorm1024<<<MB, 256, 0, st>>>(X2, F(36), H2, 1e-6f);
    gemm<ALPlain, 0>(st, ALPlain{H2, 1024, 0}, F(37), 1024, GATE, 1024, nullptr, 0, MB, 1024, 1024);
    if (mode == 0) gemm<ALPlain, 0>(st, ALPlain{p, 256, 0}, F(34), 1024, PE, 1024, nullptr, 0, MB, 1024, 256);
    final_pl<<<MB, 256, 0, st>>>(X2, PE, GATE, F(35), out);
    return nb;
}
}

namespace mk {
#define LAS __attribute__((address_space(3)))
#define GAS __attribute__((address_space(1)))
typedef _Float16 f16;
typedef _Float16 h8 __attribute__((ext_vector_type(8)));
typedef _Float16 h4 __attribute__((ext_vector_type(4)));
typedef _Float16 h2 __attribute__((ext_vector_type(2)));
typedef float f32x4 __attribute__((ext_vector_type(4)));
typedef float f32x2 __attribute__((ext_vector_type(2)));
typedef float f32x16 __attribute__((ext_vector_type(16)));
typedef unsigned u32x4 __attribute__((ext_vector_type(4)));
typedef unsigned u32x2 __attribute__((ext_vector_type(2)));

constexpr int NB = MK_NB;
constexpr int SEQ = 2048, DM = 1024;
constexpr int M = NB * SEQ;
constexpr int BM = 256, BK = 64, HALF = 128, HTB = HALF * BK * 2, STAGE_BYTES = 8 * HTB, NXCD = 8, WGM = 8;
constexpr int NWAVES = 8, NTHR = 512;
constexpr float C2 = 0.125f * 1.4426950408889634f;

__device__ __forceinline__ unsigned pkh(float lo, float hi) { h2 v = {(f16)lo, (f16)hi}; return __builtin_bit_cast(unsigned, v); }

__host__ __device__ __forceinline__ int lds_byte(int r, int c) { const int st = (r >> 4) * 2 + (c >> 5), rr = r & 15, cc = c & 31, ob = rr * 64 + cc * 2; return st * 1024 + (ob ^ (((ob >> 9) & 1) << 5)); }
__host__ __device__ __forceinline__ void stage_rc(int b, int& R, int& C) { const int st = b / 1024, sb = b % 1024, swz = sb ^ (((sb >> 9) & 1) << 5); R = (st >> 1) * 16 + swz / 64; C = (st & 1) * 32 + (swz % 64) / 2; }
__host__ __device__ __forceinline__ int perm32(int rho) { const int n = rho >> 4, i = rho & 15; return 8 * (i >> 2) + 4 * n + (i & 3); }

struct GU { const char* a; const char* b; char* o; const int* glist; const int* elist; int nt, lda2, ldb2, hsa, hsb, bmode, epi, pm, pn, aux, ldc, oc0, gcnt; };

template <class Sched, class Epi>
__device__ __forceinline__ void gemm_phase(LAS unsigned char* lds, const Sched& S, const Epi& E, const int tid) {
    const int wid = __builtin_amdgcn_readfirstlane(tid >> 6), lane = tid & 63, wr = wid >> 2, wc = wid & 3, fr = lane & 15, fq = lane >> 4;
    unsigned voffA[2], voffAh[2], voffB[2]; int hsB;
#define MK_SETV(u) do { int ln_; asm volatile("v_mbcnt_lo_u32_b32 %0, -1, 0\n\tv_mbcnt_hi_u32_b32 %0, -1, %0" : "=v"(ln_)); const int t16_ = (wid * 64 + ln_) * 16; \
        int R0, C0, R1, C1; stage_rc(t16_, R0, C0); stage_rc(t16_ + 8192, R1, C1); \
        if ((u).glist) { \
            const int g00 = R0 < (u).gcnt ? (u).glist[R0] >> 1 : 0, g01 = R1 < (u).gcnt ? (u).glist[R1] >> 1 : 0, g10 = R0 + 128 < (u).gcnt ? (u).glist[R0 + 128] >> 1 : 0, g11 = R1 + 128 < (u).gcnt ? (u).glist[R1 + 128] >> 1 : 0; \
            voffA[0] = (unsigned)(g00 * (u).lda2 + C0 * 2); voffA[1] = (unsigned)(g01 * (u).lda2 + C1 * 2); voffAh[0] = (unsigned)(g10 * (u).lda2 + C0 * 2); voffAh[1] = (unsigned)(g11 * (u).lda2 + C1 * 2); \
        } else { voffA[0] = (unsigned)(R0 * (u).lda2 + C0 * 2); voffA[1] = (unsigned)(R1 * (u).lda2 + C1 * 2); voffAh[0] = voffA[0] + (unsigned)(u).hsa; voffAh[1] = voffA[1] + (unsigned)(u).hsa; } \
        const int rb0 = (u).bmode == 0 ? R0 : (u).bmode == 1 ? ((R0 & ~31) + perm32(R0 & 31)) : (64 * ((R0 >> 5) & 3) + perm32(R0 & 31)); \
        const int rb1 = (u).bmode == 0 ? R1 : (u).bmode == 1 ? ((R1 & ~31) + perm32(R1 & 31)) : (64 * ((R1 >> 5) & 3) + perm32(R1 & 31)); \
        voffB[0] = (unsigned)(rb0 * (u).ldb2 + C0 * 2); voffB[1] = (unsigned)(rb1 * (u).ldb2 + C1 * 2); hsB = (u).hsb; } while (0)
    const size_t kstep = (size_t)(BK * 2);
    const unsigned ldsw = (unsigned)wid * 1024u;
    const int aoff = lds_byte(wr * 64 + fr, fq * 8), boff = lds_byte(wc * 32 + fr, fq * 8);
#define MK_SA(b, h) (((b) * 2 + (h)) * HTB)
#define MK_SB(b, h) ((4 + (b) * 2 + (h)) * HTB)
#define MK_STAGE(bufoff, gbase, voff) do { _Pragma("unroll") for (int _i = 0; _i < 2; ++_i) \
        __builtin_amdgcn_global_load_lds((const unsigned*)((const char*)(gbase) + (voff)[_i]), (LAS unsigned*)(lds + (bufoff) + ldsw + _i * 8192), 16, 0, 0); } while (0)
#define MK_LDA(dst, b, h) do { _Pragma("unroll") for (int m = 0; m < 4; ++m) _Pragma("unroll") for (int k = 0; k < 2; ++k) dst[m][k] = *(const LAS h8*)(lds + MK_SA(b, h) + aoff + m * 2048 + k * 1024); } while (0)
#define MK_LDB(dst, b, h) do { _Pragma("unroll") for (int n = 0; n < 2; ++n) _Pragma("unroll") for (int k = 0; k < 2; ++k) dst[n][k] = *(const LAS h8*)(lds + MK_SB(b, h) + boff + n * 2048 + k * 1024); } while (0)
#define MK_MMA(ai, bj, At, Bt) do { __builtin_amdgcn_s_setprio(1); _Pragma("unroll") for (int m = 0; m < 4; ++m) _Pragma("unroll") for (int n = 0; n < 2; ++n) _Pragma("unroll") for (int k = 0; k < 2; ++k) \
        acc[ai][bj][m][n] = __builtin_amdgcn_mfma_f32_16x16x32_f16(Bt[n][k], At[m][k], acc[ai][bj][m][n], 0, 0, 0); __builtin_amdgcn_s_setprio(0); } while (0)
#define MK_WAIT_V(n) asm volatile("s_waitcnt vmcnt(" #n ")" ::: "memory")
#define MK_WAIT_L(n) asm volatile("s_waitcnt lgkmcnt(" #n ")" ::: "memory")
#define MK_BAR __builtin_amdgcn_s_barrier()
#define MK_SCHED __builtin_amdgcn_sched_barrier(0)
    GU cur, nxt; int ui = 0;
    if (!S.next(0, cur)) return;
    f32x4 acc[2][2][4][2];
#pragma unroll
    for (int a = 0; a < 2; ++a)
#pragma unroll
        for (int b = 0; b < 2; ++b)
#pragma unroll
            for (int m = 0; m < 4; ++m)
#pragma unroll
                for (int n = 0; n < 2; ++n) acc[a][b][m][n] = (f32x4){0.f, 0.f, 0.f, 0.f};
    h8 At[4][2], B0[2][2], B1[2][2];
    const char* cA = cur.a; const char* cB = cur.b;
    MK_SETV(cur);
    MK_STAGE(MK_SB(0, 0), cB, voffB); MK_STAGE(MK_SB(0, 1), cB + hsB, voffB); MK_STAGE(MK_SA(0, 0), cA, voffA); MK_STAGE(MK_SA(0, 1), cA, voffAh);
    if (wr == 1) MK_BAR;
    MK_WAIT_V(2); MK_BAR;
    MK_STAGE(MK_SB(1, 0), cB + kstep, voffB); MK_STAGE(MK_SA(1, 0), cA + kstep, voffA); MK_STAGE(MK_SB(1, 1), cB + hsB + kstep, voffB);
    MK_WAIT_V(6); MK_BAR;
    for (;;) {
        bool has_next = false; const char* nA = cA; const char* nB = cB;
        const int nt = cur.nt;
        for (int t = 0; t < nt; t += 2) {
            const bool last = (t == nt - 2);
            if (last) { has_next = S.next(ui + 1, nxt); if (has_next) { nA = nxt.a; nB = nxt.b; } }
            const char* a1 = cA + (size_t)(t + 1) * kstep;
            const char* a2 = last ? nA : cA + (size_t)(t + 2) * kstep; const char* b2 = last ? nB : cB + (size_t)(t + 2) * kstep;
            const char* a3 = a2 + kstep; const char* b3 = b2 + kstep;
            MK_LDB(B0, 0, 0); MK_LDB(B1, 0, 1); MK_SCHED; MK_LDA(At, 0, 0); MK_STAGE(MK_SA(1, 1), a1, voffAh);
            if (last && has_next) { MK_SETV(nxt); }
            MK_WAIT_V(8); MK_WAIT_L(0); MK_BAR; MK_MMA(0, 0, At, B0); MK_MMA(0, 1, At, B1); MK_BAR; MK_SCHED;
            MK_LDA(At, 0, 1); MK_STAGE(MK_SB(0, 0), b2, voffB); MK_STAGE(MK_SB(0, 1), b2 + hsB, voffB); MK_STAGE(MK_SA(0, 0), a2, voffA);
            MK_WAIT_V(8); MK_WAIT_L(0); MK_BAR; MK_MMA(1, 0, At, B0); MK_MMA(1, 1, At, B1); MK_BAR; MK_SCHED;
            MK_LDB(B0, 1, 0); MK_LDB(B1, 1, 1); MK_SCHED; MK_LDA(At, 1, 0); MK_STAGE(MK_SA(0, 1), a2, voffAh);
            MK_WAIT_V(8); MK_WAIT_L(0); MK_BAR; MK_MMA(0, 0, At, B0); MK_MMA(0, 1, At, B1); MK_BAR; MK_SCHED;
            MK_LDA(At, 1, 1); MK_STAGE(MK_SB(1, 0), b3, voffB); MK_STAGE(MK_SB(1, 1), b3 + hsB, voffB); MK_STAGE(MK_SA(1, 0), a3, voffA);
            MK_WAIT_V(8); MK_WAIT_L(0); MK_BAR; MK_MMA(1, 0, At, B0); MK_MMA(1, 1, At, B1); MK_BAR; MK_SCHED;
        }
        if (wr == 0) MK_BAR;
        E(acc, cur, wr, wc, fr, fq);
        if (!has_next) break;
#pragma unroll
        for (int a = 0; a < 2; ++a)
#pragma unroll
            for (int b = 0; b < 2; ++b)
#pragma unroll
                for (int m = 0; m < 4; ++m)
#pragma unroll
                    for (int n = 0; n < 2; ++n) acc[a][b][m][n] = (f32x4){0.f, 0.f, 0.f, 0.f};
        cur = nxt; cA = nA; cB = nB; ++ui;
        if (wr == 1) MK_BAR;
    }
    MK_WAIT_V(0);
    MK_BAR;
#undef MK_SETV
#undef MK_SA
#undef MK_SB
#undef MK_STAGE
#undef MK_LDA
#undef MK_LDB
#undef MK_MMA
#undef MK_WAIT_V
#undef MK_WAIT_L
#undef MK_BAR
#undef MK_SCHED
}
}
namespace attn_body {
using mk::h8; using mk::f16;
using bf16=_Float16;
using bf16x8=mk::h8;
using s16x4=__attribute__((ext_vector_type(4)))short; using s16x8=__attribute__((ext_vector_type(8)))short;
using f32x16=__attribute__((ext_vector_type(16)))float;
using u32x4=__attribute__((ext_vector_type(4)))unsigned;
constexpr int BATCH=MK_NB,NHEAD=16,SEQ=2048,D=64,DM=1024; constexpr int QKP=512,VP=512,OP=1024;
constexpr int NW=8,QBLK=32,QB=QBLK*NW,KVBLK=64,NQB=SEQ/QB;
constexpr int ATTN_PITCH=DM, ATTN_UNIT_ROWS=QB;
__device__ __forceinline__ int crow(int r,int hi){return (r&3)+8*(r>>2)+4*hi;}
#define SBAR() __builtin_amdgcn_sched_barrier(0)
__device__ __forceinline__ void cmask(f32x16&p0,f32x16&p1,int jb,int qrel,int hi){
  const float NEG=-INFINITY; int kb=64*jb+4*hi;
  #pragma unroll
  for(int r=0;r<16;++r){int kv=kb+(r&3)+8*(r>>2); if(kv>qrel)p0[r]=NEG; if(kv+32>qrel)p1[r]=NEG;}
}

constexpr int NSLOT=3, SLOTB=8192;
constexpr int LDS_K=0, LDS_V=NSLOT*SLOTB, LDS_WS=2*NSLOT*SLOTB, LDS_OST=LDS_WS+NW*64*4, LDS_BYTES=LDS_OST+NW*4096;
constexpr float C2=0.125f*1.4426950408889634f;
__device__ __forceinline__ void glds16(const void*gsrc,unsigned lds_dst){unsigned keep;
  asm volatile("s_mov_b32 %0, m0\n\ts_mov_b32 m0, %2\n\ts_nop 0\n\tglobal_load_lds_dwordx4 %1, off\n\ts_mov_b32 m0, %0":"=&s"(keep):"v"(gsrc),"s"(lds_dst):"memory");}
__device__ __forceinline__ float max3f(float a,float b,float c){float r;asm("v_max3_f32 %0, %1, %2, %3":"=v"(r):"v"(a),"v"(b),"v"(c));return r;}
__device__ __forceinline__ float max2f(float a,float b){float r;asm("v_max_f32_e32 %0, %1, %2":"=v"(r):"v"(a),"v"(b));return r;}
__device__ __forceinline__ float fadd_s(float a,float b){float r;asm("v_add_f32_e32 %0, %1, %2":"=v"(r):"v"(a),"v"(b));return r;}
__device__ __forceinline__ float fsub_s(float a,float b){float r;asm("v_sub_f32_e32 %0, %1, %2":"=v"(r):"v"(a),"v"(b));return r;}
typedef float f32x2_t __attribute__((ext_vector_type(2))); typedef _Float16 bf16x2_t __attribute__((ext_vector_type(2)));
__device__ __forceinline__ unsigned cvtpk_s(float lo,float hi){f32x2_t v={lo,hi};bf16x2_t b=__builtin_convertvector(v,bf16x2_t);return __builtin_bit_cast(unsigned,b);}
#define WAIT_BAR(N) asm volatile("s_waitcnt vmcnt(" #N ") lgkmcnt(0)\n\ts_barrier":::"memory")

__device__ __forceinline__ void qkt(f32x16&p0,f32x16&p1,const char*Kslot,const bf16x8*qr,const f32x16&negm,int r32,int hi){
  const char*kb=Kslot+hi*1024+r32*16;
  #pragma unroll
  for(int d0=0;d0<4;++d0){
    const bf16x8 b0=*reinterpret_cast<const bf16x8*>(kb+d0*2048);
    const bf16x8 b1=*reinterpret_cast<const bf16x8*>(kb+d0*2048+512);
    if(d0==0){p0=__builtin_amdgcn_mfma_f32_32x32x16_f16(b0,qr[0],negm,0,0,0);p1=__builtin_amdgcn_mfma_f32_32x32x16_f16(b1,qr[0],negm,0,0,0);}
    else{p0=__builtin_amdgcn_mfma_f32_32x32x16_f16(b0,qr[d0],p0,0,0,0);p1=__builtin_amdgcn_mfma_f32_32x32x16_f16(b1,qr[d0],p1,0,0,0);}}
}
typedef __attribute__((address_space(3))) const char* lds_cptr;
typedef short v4i16_t __attribute__((ext_vector_type(4)));
__device__ __forceinline__ void kload8(bf16x8*kf,lds_cptr kp){
  kf[0]=*(const __attribute__((address_space(3))) bf16x8*)(kp);      kf[1]=*(const __attribute__((address_space(3))) bf16x8*)(kp+512);
  kf[2]=*(const __attribute__((address_space(3))) bf16x8*)(kp+2048); kf[3]=*(const __attribute__((address_space(3))) bf16x8*)(kp+2560);
  kf[4]=*(const __attribute__((address_space(3))) bf16x8*)(kp+4096); kf[5]=*(const __attribute__((address_space(3))) bf16x8*)(kp+4608);
  kf[6]=*(const __attribute__((address_space(3))) bf16x8*)(kp+6144); kf[7]=*(const __attribute__((address_space(3))) bf16x8*)(kp+6656);
}
__device__ __forceinline__ void kload2(bf16x8*kf,lds_cptr kp,int j){ kf[2*j]=*(const __attribute__((address_space(3))) bf16x8*)(kp+j*2048); kf[2*j+1]=*(const __attribute__((address_space(3))) bf16x8*)(kp+j*2048+512); }
__device__ __forceinline__ s16x4 vtr(lds_cptr p){ return __builtin_bit_cast(s16x4,__builtin_amdgcn_ds_read_tr16_b64_v4i16((__attribute__((address_space(3))) v4i16_t*)p)); }
__device__ __forceinline__ float rowmax(const f32x16&p0,const f32x16&p1){
  float a=max3f(p0[0],p0[1],p1[0]),b=max3f(p0[2],p0[3],p1[1]);a=max3f(a,p1[2],p1[3]);
  #pragma unroll
  for(int r=4;r<16;r+=4){a=max3f(a,p0[r],p0[r+1]);b=max3f(b,p0[r+2],p0[r+3]);a=max3f(a,p1[r],p1[r+1]);b=max3f(b,p1[r+2],p1[r+3]);}
  const float m=max2f(a,b);
  auto rr=__builtin_amdgcn_permlane32_swap(__float_as_uint(m),__float_as_uint(m),false,false);
  return max2f(__uint_as_float(rr[0]),__uint_as_float(rr[1]));
}
__device__ __forceinline__ void pv(f32x16*o,int vb,bf16x8 pa0,bf16x8 pa1,bf16x8 pa2,bf16x8 pa3){
  #pragma unroll
  for(int d0=0;d0<2;++d0){s16x4 lo[4],hi[4];
    #pragma unroll
    for(int ks=0;ks<4;++ks){
      asm volatile("ds_read_b64_tr_b16 %0,%1 offset:%c2":"=&v"(lo[ks]):"v"(vb),"i"(d0*4096+ks*1024):"memory");
      asm volatile("ds_read_b64_tr_b16 %0,%1 offset:%c2":"=&v"(hi[ks]):"v"(vb),"i"(d0*4096+ks*1024+512):"memory");}
    asm volatile("s_waitcnt lgkmcnt(0)":::"memory");SBAR();
    #define PK(k) __builtin_bit_cast(bf16x8,(s16x8){lo[k][0],lo[k][1],lo[k][2],lo[k][3],hi[k][0],hi[k][1],hi[k][2],hi[k][3]})
    o[d0]=__builtin_amdgcn_mfma_f32_32x32x16_f16(pa0,PK(0),o[d0],0,0,0);
    o[d0]=__builtin_amdgcn_mfma_f32_32x32x16_f16(pa1,PK(1),o[d0],0,0,0);
    o[d0]=__builtin_amdgcn_mfma_f32_32x32x16_f16(pa2,PK(2),o[d0],0,0,0);
    o[d0]=__builtin_amdgcn_mfma_f32_32x32x16_f16(pa3,PK(3),o[d0],0,0,0);
    #undef PK
  }
}

#ifndef ATTN_STORE16
#define ATTN_STORE16(p,v) (*(u32x4*)(p)=(v))
#endif
template<int THRL> __device__ __forceinline__ void attn_unit(int b,int vh,int qb,const bf16*Q,const bf16*__restrict__ K,const bf16*__restrict__ V,bf16*O,char*shm,const int wave_s){
  int tid; asm volatile("v_mbcnt_lo_u32_b32 %0, -1, 0\n\tv_mbcnt_hi_u32_b32 %0, -1, %0" : "=v"(tid)); tid+=wave_s*64;
  const int hh=vh>>2,mp=(vh>>1)&1,vhf=vh&1; const int qcol=hh*128+mp*64, vcol=hh*128+vhf*64, ocol=mp*512+hh*128+vhf*64;
  const int lane=tid&63,r32=lane&31,hi=lane>>5; const int wid=__builtin_amdgcn_readfirstlane(tid>>6);
  const long rowbase=(long)b*SEQ; const int q0=qb*QB;
  const bf16*Qw=Q+(rowbase+q0+wid*QBLK)*QKP+qcol;
  const bf16*Kh=K+rowbase*QKP+qcol,*Vh=V+rowbase*VP+vcol;
  const unsigned lds0=(unsigned)(uintptr_t)shm;
  float*wsf=(float*)(shm+LDS_WS)+wid*64;
  const bf16*ksrc=Kh+(long)lane*QKP+wid*8;
  const bf16*vsrc=Vh+(long)(16*(wid&3)+(lane>>2))*VP+(wid>>2)*32+(lane&3)*8;
  const unsigned kdst=lds0+LDS_K+wid*1024, vdst=lds0+LDS_V+wid*1024;
  #define DMA_K(t,slot) glds16(ksrc+(long)(t)*KVBLK*QKP,(unsigned)__builtin_amdgcn_readfirstlane(kdst+(slot)))
  #define DMA_V(t,slot) glds16(vsrc+(long)(t)*KVBLK*VP,(unsigned)__builtin_amdgcn_readfirstlane(vdst+(slot)))
  const int vb0=(int)(lds0+LDS_V)+((lane>>4)&1)*32+(lane&3)*8+(4*hi+((lane&15)>>2))*64;
  const char*Kbase=shm+LDS_K; bf16x8 kf[8];
  const lds_cptr shm3=(lds_cptr)shm; const lds_cptr kp0=shm3+LDS_K+hi*1024+r32*16; const lds_cptr vp0=shm3+LDS_V+((lane>>4)&1)*32+(lane&3)*8+(4*hi+((lane&15)>>2))*64;
  const int NT=(q0+QB)/KVBLK;
  DMA_K(0,0);DMA_V(0,0);DMA_K(1,SLOTB);
  bf16x8 qr[4];
  #pragma unroll
  for(int d0=0;d0<4;++d0)qr[d0]=*reinterpret_cast<const bf16x8*>(&Qw[(long)r32*QKP+d0*16+hi*8]);
  float mhat=0.f,l_reg=0.f;f32x16 o[2];o[0]=f32x16{};o[1]=f32x16{};f32x16 negm=f32x16{};asm volatile("":"+v"(negm));
  const int qrel=wid*QBLK+r32;
  #define CMASK(P0,P1,t) do{int jb_=(t)-(NT-4); if(jb_>=0)cmask(P0,P1,jb_,qrel,hi);}while(0)
  bool resc=false;
  #define START(P0,P1) do{ const float rm=rowmax(P0,P1); resc=false; \
    { const float dl=rm; mhat=fadd_s(mhat,dl); \
      _Pragma("unroll") for(int r=0;r<16;++r){P0[r]=fsub_s(P0[r],dl);P1[r]=fsub_s(P1[r],dl);} \
      _Pragma("unroll") for(int r=0;r<16;++r)negm[r]=-mhat; asm volatile("":"+v"(negm)); } \
    _Pragma("unroll") for(int r=0;r<16;++r)P0[r]=__builtin_amdgcn_exp2f(P0[r]); }while(0)
  #define RESC() do{ if(resc){ asm volatile("s_waitcnt lgkmcnt(0)":::"memory"); \
      _Pragma("unroll") for(int d_=0;d_<2;++d_) _Pragma("unroll") for(int r=0;r<16;++r)o[d_][r]*=wsf[crow(r,hi)]; } }while(0)
  f32x16 pA0,pA1,pB0,pB1;
  int sl_prev=0,sl_cur=0,sl_next=SLOTB;
  #define ROT() do{sl_prev=sl_cur;sl_cur=sl_next;sl_next=(sl_next==(NSLOT-1)*SLOTB)?0:sl_next+SLOTB;}while(0)
  DMA_K(2,2*SLOTB);
  WAIT_BAR(3);
  qkt(pA0,pA1,Kbase,qr,negm,r32,hi);asm volatile("s_nop 15\n\ts_nop 7":"+v"(pA0),"+v"(pA1));CMASK(pA0,pA1,0);
  START(pA0,pA1);
  _Pragma("unroll") for(int r=0;r<16;++r)pA1[r]=__builtin_amdgcn_exp2f(pA1[r]);
  WAIT_BAR(0);
  DMA_K(3,0);DMA_V(1,SLOTB);
  ROT();
  kload8(kf,kp0+sl_cur);
  WAIT_BAR(2);
  s16x4 vlo[8],vhi[8]; u32x4 pw0,pw1,pw2,pw3;
  #define PKW(P,B) cvtpk_s(P[B],P[B+1])
  #define PAF(k) __builtin_bit_cast(bf16x8,pw##k)
  #define VFR(i) __builtin_bit_cast(bf16x8,(s16x8){vlo[i][0],vlo[i][1],vlo[i][2],vlo[i][3],vhi[i][0],vhi[i][1],vhi[i][2],vhi[i][3]})
  #define PIN(x) asm volatile("":"+v"(x))
  #define MX3(a,b,c) __builtin_fmaxf(__builtin_fmaxf((a),(b)),(c))
  #define GAPA(MF,A0,A1,A2,A3,W0,W1,PW) do{ MF; sacc+=A0; sacc+=A1; sacc+=A2; sacc+=A3; PIN(sacc); W0; W1; PIN(PW); SBAR(); }while(0)
  #define EX(v) __builtin_amdgcn_exp2f(v)
  #define GAPB(MF,X,B) do{ MF; X[B]=EX(X[B]); X[B+1]=EX(X[B+1]); X[B+2]=EX(X[B+2]); X[B+3]=EX(X[B+3]); PIN(X); SBAR(); }while(0)
  #define VRD(i) do{ vlo[i]=vtr(vp_+(((i)>>2)*4096+((i)&3)*1024)); vhi[i]=vtr(vp_+(((i)>>2)*4096+((i)&3)*1024+512)); }while(0)
  #define KRD(G,j) do{ if(G){ kload2(kf,kp0+sl_next,j); SBAR(); } }while(0)
  #define STEP(C0,C1,P0,P1,t,GK,GV,GL) do{ SBAR(); \
    const lds_cptr vp_=vp0+sl_prev; \
    VRD(0); SBAR(); float sacc=(P0[0]+P0[1]); \
    GAPA(C0=__builtin_amdgcn_mfma_f32_32x32x16_f16(kf[0],qr[0],negm,0,0,0), P0[2],P0[3],P0[4],P0[5],     pw0[0]=PKW(P0,0), pw0[1]=PKW(P0,2), pw0); \
    VRD(4); SBAR(); GAPA(C1=__builtin_amdgcn_mfma_f32_32x32x16_f16(kf[1],qr[0],negm,0,0,0), P0[6],P0[7],P0[8],P0[9],     pw0[2]=PKW(P0,4), pw0[3]=PKW(P0,6), pw0); \
    VRD(1); SBAR(); GAPA(C0=__builtin_amdgcn_mfma_f32_32x32x16_f16(kf[2],qr[1],C0,0,0,0),   P0[10],P0[11],P0[12],P0[13], pw1[0]=PKW(P0,8), pw1[1]=PKW(P0,10), pw1); \
    VRD(5); SBAR(); GAPA(C1=__builtin_amdgcn_mfma_f32_32x32x16_f16(kf[3],qr[1],C1,0,0,0),   P0[14],P0[15],P1[0],P1[1],   pw1[2]=PKW(P0,12),pw1[3]=PKW(P0,14), pw1); \
    VRD(2); SBAR(); GAPA(C0=__builtin_amdgcn_mfma_f32_32x32x16_f16(kf[4],qr[2],C0,0,0,0),   P1[2],P1[3],P1[4],P1[5],     pw2[0]=PKW(P1,0), pw2[1]=PKW(P1,2), pw2); \
    VRD(6); SBAR(); GAPA(C1=__builtin_amdgcn_mfma_f32_32x32x16_f16(kf[5],qr[2],C1,0,0,0),   P1[6],P1[7],P1[8],P1[9],     pw2[2]=PKW(P1,4), pw2[3]=PKW(P1,6), pw2); \
    VRD(3); SBAR(); GAPA(C0=__builtin_amdgcn_mfma_f32_32x32x16_f16(kf[6],qr[3],C0,0,0,0),   P1[10],P1[11],P1[12],P1[13], pw3[0]=PKW(P1,8), pw3[1]=PKW(P1,10), pw3); \
    VRD(7); SBAR(); GAPA(C1=__builtin_amdgcn_mfma_f32_32x32x16_f16(kf[7],qr[3],C1,0,0,0),   P1[14],P1[15],0.f,0.f,       pw3[2]=PKW(P1,12),pw3[3]=PKW(P1,14), pw3); \
    l_reg+=sacc; \
    if(GK){DMA_K((t)+3,sl_cur);} if(GV){DMA_V((t)+1,sl_next);} \
    CMASK(C0,C1,t); \
    { float a=MX3(C0[0],C0[1],C1[0]),b=MX3(C0[2],C0[3],C1[1]); a=MX3(a,C1[2],C1[3]); \
      _Pragma("unroll") for(int r=4;r<16;r+=4){a=MX3(a,C0[r],C0[r+1]);b=MX3(b,C0[r+2],C0[r+3]);a=MX3(a,C1[r],C1[r+1]);b=MX3(b,C1[r+2],C1[r+3]);} \
      float rm=__builtin_fmaxf(a,b); { auto rr=__builtin_amdgcn_permlane32_swap(__float_as_uint(rm),__float_as_uint(rm),false,false); rm=__builtin_fmaxf(__uint_as_float(rr[0]),__uint_as_float(rr[1])); } \
      resc=false; \
      if(__builtin_expect(__any(rm>(float)THRL),0)){ const float dl=__builtin_fmaxf(rm,0.f); mhat+=dl; \
        _Pragma("unroll") for(int r=0;r<16;++r){C0[r]-=dl;C1[r]-=dl;} \
        _Pragma("unroll") for(int r=0;r<16;++r)negm[r]=-mhat; asm volatile("":"+v"(negm)); \
        const float f=__builtin_amdgcn_exp2f(-dl); l_reg*=f; if(hi==0)wsf[r32]=f; resc=true; } } \
    SBAR(); \
    GAPB(o[0]=__builtin_amdgcn_mfma_f32_32x32x16_f16(PAF(0),VFR(0),o[0],0,0,0), C0,0); \
    GAPB(o[1]=__builtin_amdgcn_mfma_f32_32x32x16_f16(PAF(0),VFR(4),o[1],0,0,0), C0,4); \
    KRD(GL,0); GAPB(o[0]=__builtin_amdgcn_mfma_f32_32x32x16_f16(PAF(1),VFR(1),o[0],0,0,0), C0,8); \
    KRD(GL,1); GAPB(o[1]=__builtin_amdgcn_mfma_f32_32x32x16_f16(PAF(1),VFR(5),o[1],0,0,0), C0,12); \
    KRD(GL,2); GAPB(o[0]=__builtin_amdgcn_mfma_f32_32x32x16_f16(PAF(2),VFR(2),o[0],0,0,0), C1,0); \
    KRD(GL,3); GAPB(o[1]=__builtin_amdgcn_mfma_f32_32x32x16_f16(PAF(2),VFR(6),o[1],0,0,0), C1,4); \
    GAPB(o[0]=__builtin_amdgcn_mfma_f32_32x32x16_f16(PAF(3),VFR(3),o[0],0,0,0), C1,8); \
    GAPB(o[1]=__builtin_amdgcn_mfma_f32_32x32x16_f16(PAF(3),VFR(7),o[1],0,0,0), C1,12); \
    }while(0)
  int t=1;
  #undef CMASK
  #define CMASK(P0,P1,t) do{}while(0)
  for(;t+5<NT;t+=2){
    STEP(pB0,pB1,pA0,pA1,t,true,true,true);     WAIT_BAR(2); RESC(); ROT();
    STEP(pA0,pA1,pB0,pB1,t+1,true,true,true);   WAIT_BAR(2); RESC(); ROT();
  }
  #undef CMASK
  #define CMASK(P0,P1,t) do{int jb_=(t)-(NT-4); if(jb_>=0)cmask(P0,P1,jb_,qrel,hi);}while(0)
  #define ENDW(tt) do{ if((tt)+3<NT){WAIT_BAR(2);} else if((tt)+2<NT){WAIT_BAR(1);} else {WAIT_BAR(0);} }while(0)
  for(;t+1<NT;t+=2){
    STEP(pB0,pB1,pA0,pA1,t,(t+3<NT),(t+1<NT),(t+1<NT));       ENDW(t);   RESC(); ROT();
    STEP(pA0,pA1,pB0,pB1,t+1,(t+4<NT),(t+2<NT),(t+2<NT));     ENDW(t+1); RESC(); ROT();
  }
  STEP(pB0,pB1,pA0,pA1,NT-1,false,false,false); RESC();
  { float sacc=pB0[0]+pB0[1]; _Pragma("unroll") for(int r=2;r<16;++r)sacc+=pB0[r]; _Pragma("unroll") for(int r=0;r<16;++r)sacc+=pB1[r]; l_reg+=sacc;
    pw0=(u32x4){PKW(pB0,0),PKW(pB0,2),PKW(pB0,4),PKW(pB0,6)};pw1=(u32x4){PKW(pB0,8),PKW(pB0,10),PKW(pB0,12),PKW(pB0,14)};pw2=(u32x4){PKW(pB1,0),PKW(pB1,2),PKW(pB1,4),PKW(pB1,6)};pw3=(u32x4){PKW(pB1,8),PKW(pB1,10),PKW(pB1,12),PKW(pB1,14)};
    SBAR(); pv(o,vb0+sl_cur,PAF(0),PAF(1),PAF(2),PAF(3)); }
  #undef PKW
  #undef PAF
  #undef VFR
  #undef PIN
  #undef MX3
  #undef GAPA
  #undef GAPB
  #undef EX
  #undef VRD
  #undef KRD
  #undef STEP
  #undef ENDW
  {auto rr=__builtin_amdgcn_permlane32_swap(__float_as_uint(l_reg),__float_as_uint(l_reg),false,false);l_reg=__uint_as_float(rr[0])+__uint_as_float(rr[1]);}
  if(hi==0)wsf[32+r32]=l_reg;asm volatile("s_waitcnt lgkmcnt(0)":::"memory");
  float rli[16];
  #pragma unroll
  for(int r=0;r<16;++r)rli[r]=__builtin_amdgcn_rcpf(wsf[32+crow(r,hi)]);
  bf16*Ow=O+(rowbase+q0+wid*QBLK)*OP+ocol;
  { bf16*stg=(bf16*)(shm+LDS_OST)+wid*2048;
    #pragma unroll
    for(int r=0;r<16;++r){const int orow=crow(r,hi);
      #pragma unroll
      for(int d0=0;d0<2;++d0)stg[orow*64+d0*32+r32]=(bf16)(o[d0][r]*rli[r]);}
    asm volatile("s_waitcnt lgkmcnt(0)":::"memory");
    #pragma unroll
    for(int i=0;i<4;++i){const int row=i*8+(lane>>3),ch=lane&7; const u32x4 v=*(const u32x4*)(stg+row*64+ch*8); ATTN_STORE16(Ow+(long)row*OP+ch*8,v);} }
  asm volatile("s_waitcnt lgkmcnt(0)\n\ts_barrier":::"memory");
  #undef DMA_K
  #undef DMA_V
  #undef CMASK
  #undef START
  #undef RESC
  #undef ROT
}
constexpr int ATTN_LDS_BYTES=LDS_BYTES;
struct AttnTensors { const bf16* Q; const bf16* K; const bf16* V; bf16* O; };
struct AttnUnit { int bh; int qb; };
struct StaticOrder {
  int vcu, G;
  __device__ __forceinline__ explicit StaticOrder(int grid,int block):vcu((grid%8==0)?(block%8)*(grid/8)+block/8:block),G(grid){}
  __device__ __forceinline__ bool next(int i,AttnUnit&u)const{ constexpr int NP=BATCH*64; const int ppc=(NP+G-1)/G; const int pj=i>>1; if(pj>=ppc)return false; const int pi=vcu*ppc+pj; if(pi>=NP)return false;
    const int s=pi&3; u.bh=pi>>2; u.qb=(i&1)?7-s:s; return true; }
  __device__ __forceinline__ void a_ready(const AttnUnit&)const{}
  __device__ __forceinline__ void done(const AttnUnit&)const{}
};
template<class Sched,int THRL=8> __device__ __forceinline__ void attn_phase(char*lds,const AttnTensors&T,const Sched&S,const int wave_s){
  AttnUnit u;
  for(int i=0;S.next(i,u);++i){ S.a_ready(u); attn_unit<THRL>(u.bh/NHEAD,u.bh%NHEAD,u.qb,T.Q,T.K,T.V,T.O,lds,wave_s); S.done(u); }
}
#undef SBAR
#undef WAIT_BAR
}
namespace mk {
constexpr size_t al256(size_t x) { return (x + 255) / 256 * 256; }
constexpr size_t MiB = (size_t)1 << 20;
constexpr size_t WS_CTL = 0, CTL_BYTES = 1u << 20;
constexpr int NIN = 3840;
constexpr size_t WS_WIN  = 1 * MiB;
constexpr size_t WS_WOUT = WS_WIN + (size_t)NIN * 2048;
constexpr size_t WS_WPLG = WS_WOUT + 2 * MiB;
constexpr size_t WS_WPL  = WS_WPLG + 2 * MiB;
constexpr size_t WS_WB   = WS_WPL + MiB / 2;
constexpr size_t WS_RW   = WS_WB + al256((size_t)1536 * 384 * 2);
constexpr size_t WS_SSQPE = WS_RW + (size_t)48 * 4096;
constexpr size_t WS_ROPC = WS_SSQPE + (size_t)16384 * 4;
constexpr size_t WS_ROPS = WS_ROPC + 2 * MiB;
constexpr size_t WS_BON  = WS_ROPS + 2 * MiB;
constexpr size_t WS_LIST = WS_BON + MiB / 2;
constexpr size_t WS_ASGW = WS_LIST + 2 * MiB;
constexpr size_t WS_SST  = WS_ASGW + MiB / 8;
static_assert(WS_SST + MiB <= 23 * MiB, "small region");
constexpr size_t WS_PE   = 23 * MiB;
constexpr size_t WS_HN   = 55 * MiB;
constexpr size_t WS_PH   = 87 * MiB;
constexpr size_t WS_Q    = 95 * MiB, WS_K = 111 * MiB, WS_V = 127 * MiB;
constexpr size_t WS_P    = 143 * MiB;
constexpr size_t WS_O    = 215 * MiB;
constexpr size_t WS_ZR   = 247 * MiB;
constexpr size_t WS_LA   = 55 * MiB;
constexpr size_t WS_WL   = 67 * MiB, WS_AL = 83 * MiB, WS_G = 99 * MiB;
constexpr size_t WS_RJ   = 115 * MiB;
constexpr size_t WS_VS   = 174 * MiB;
constexpr size_t WS_Y    = 190 * MiB;
constexpr size_t WS_MIX  = 55 * MiB;
constexpr size_t WS_X1   = 95 * MiB;
constexpr size_t WS_H2   = 159 * MiB;
constexpr size_t WS_WDN  = 191 * MiB;
constexpr size_t WS_WUP  = 223 * MiB;
constexpr size_t WS_HID  = 55 * MiB;
constexpr size_t WS_YE   = 223 * MiB;
constexpr size_t WS_X2H  = 159 * MiB;
constexpr size_t WS_END1 = 295 * MiB - 65536;
static_assert(WS_ZR + (size_t)16384 * 1536 * 2 <= 295 * MiB && WS_WUP + 64 * MiB <= 287 * MiB && WS_X1 + 64 * MiB <= WS_H2 && WS_H2 + 32 * MiB <= WS_WDN && WS_WDN + 32 * MiB <= WS_WUP && WS_RJ + (size_t)8 * 8 * 64 * 15104 <= WS_VS && WS_HID + (size_t)(32768 + 8192) * 1024 <= WS_X1, "ws map");

constexpr int CW_BAR = 4096, CW_CNT = 8192;

constexpr int RING_BYTES = 131072, SCR_BYTES = 8 * 19456  , MISC_OFF = SCR_BYTES + 320, LDS_BYTES = 160 * 1024;

struct TJob { const float* src; f16* dst; const float* s1; const float* s2; int K, N, ldd, mode, nb, item0; long sstride, dstride; };
constexpr int MAXJOBS = 20;
struct Params {
    const float* in[38]; float* out; unsigned char* ws;
    TJob jobs[MAXJOBS]; int njobs, nitems, ph_lo, ph_hi, njobs0, nitems0;
};

#define XB_TMO      128
#define XB_XCNT(j)  (256  + 64 * (j))
#define XB_XSUB(j)  (1280 + 64 * (j))
#define XB_XGEN(j)  (2304 + 64 * (j))
#define XB_TOP      3328
#define XB_TOPGEN   3392
#define XCD_BAR_WORDS 3456
#define XB_SPIN_CAP (1u << 18)
__device__ __forceinline__ unsigned xb_ld(unsigned* p)              { return __hip_atomic_load(p, __ATOMIC_RELAXED, __HIP_MEMORY_SCOPE_AGENT); }
__device__ __forceinline__ unsigned xb_add(unsigned* p, unsigned v) { return __hip_atomic_fetch_add(p, v, __ATOMIC_RELAXED, __HIP_MEMORY_SCOPE_AGENT); }
__device__ __forceinline__ unsigned xb_xcc_id() { return (unsigned)__builtin_amdgcn_s_getreg((3 << 11) | 20) & 0xFu; }
#define XB_SPIN(cond, bar) do { unsigned _sp = 0; while (cond) { __builtin_amdgcn_s_sleep(1); \
    if ((++_sp & 255u) == 0u) { if (xb_ld(&(bar)[XB_TMO])) break; if (_sp > XB_SPIN_CAP) { atomicAdd(&(bar)[XB_TMO], 1u); break; } } } } while (0)
struct XcdBarrier { unsigned* bar; unsigned x; volatile LAS unsigned* st; };
__device__ __forceinline__ XcdBarrier xcd_barrier_post(unsigned* bar, volatile LAS unsigned* st) {
    XcdBarrier b; b.bar = bar; b.x = xb_xcc_id(); b.st = st;
    if (threadIdx.x == 0) (void)xb_add(&bar[XB_XCNT(b.x)], 1u);
    return b;
}
__device__ __forceinline__ void xcd_barrier_complete(unsigned* bar, unsigned x, unsigned& nloc, unsigned& nx) {
    const unsigned G = gridDim.x * gridDim.y * gridDim.z;
    unsigned sum, cnt, mine, sp = 0u;
    for (;;) {
        sum = 0u; cnt = 0u; mine = 0u;
#pragma unroll
        for (unsigned j = 0; j < 16; ++j) { const unsigned c = xb_ld(&bar[XB_XCNT(j)]); sum += c; cnt += (c > 0u) ? 1u : 0u; mine = (j == x) ? c : mine; }
        if (sum == G) break;
        __builtin_amdgcn_s_sleep(1);
        if ((++sp & 255u) == 0u) { if (xb_ld(&bar[XB_TMO])) break; if (sp > XB_SPIN_CAP) { atomicAdd(&bar[XB_TMO], 1u); break; } }
    }
    nloc = mine > 0u ? mine : 1u; nx = cnt > 0u ? cnt : 1u;
}
__device__ __forceinline__ void xcd_barrier(const XcdBarrier& b, int wave_s) {
    int ln_; asm volatile("v_mbcnt_lo_u32_b32 %0, -1, 0\n\tv_mbcnt_hi_u32_b32 %0, -1, %0" : "=v"(ln_));
    const bool leader = wave_s == 0 && ln_ == 0;
    asm volatile("s_waitcnt vmcnt(0)" ::: "memory");
    __syncthreads();
    if (leader) {
        unsigned* bar = b.bar;
        __builtin_amdgcn_s_waitcnt(0);
        unsigned nloc = b.st[0], nx = b.st[1];
        if (nloc == 0u) { xcd_barrier_complete(bar, b.x, nloc, nx); b.st[0] = nloc; b.st[1] = nx; }
        const unsigned old = xb_add(&bar[XB_XSUB(b.x)], 1u);
        const unsigned gen = old / nloc;
        if (old + 1u == (gen + 1u) * nloc) {
            __builtin_amdgcn_fence(__ATOMIC_RELEASE, "agent");
            asm volatile("s_waitcnt vmcnt(0)" ::: "memory");
            const unsigned og = xb_add(&bar[XB_TOP], 1u);
            const unsigned tg = og / nx;
            if (og + 1u == (tg + 1u) * nx) xb_add(&bar[XB_TOPGEN], 1u);
            else XB_SPIN(xb_ld(&bar[XB_TOPGEN]) == tg, bar);
            __builtin_amdgcn_fence(__ATOMIC_ACQUIRE, "agent");
            xb_add(&bar[XB_XGEN(b.x)], 1u);
            asm volatile("s_waitcnt vmcnt(0)" ::: "memory");
        } else {
            XB_SPIN(xb_ld(&bar[XB_XGEN(b.x)]) == gen, bar);
            __builtin_amdgcn_fence(__ATOMIC_ACQUIRE, "agent");
            asm volatile("s_waitcnt vmcnt(0)" ::: "memory");
        }
    }
    __syncthreads();
}

__device__ __forceinline__ float shx(float v, int mask, int lane) { return __builtin_bit_cast(float, __builtin_amdgcn_ds_bpermute((lane ^ mask) << 2, __builtin_bit_cast(int, v))); }
__device__ __forceinline__ float wave_sum(float v, int lane) {
#pragma unroll
    for (int o = 1; o < 64; o <<= 1) v += shx(v, o, lane);
    return v;
}

__device__ __forceinline__ void p0_transpose_item(const TJob& J, int item, LAS float* scr, int lane) {
    const int kblks = (J.K + 63) / 64, nblk = J.N / 32, per = kblks * nblk;
    const int bi = item / per, r = item % per, kb = r / nblk, nbk = r % nblk, k0 = 64 * kb, n0 = 32 * nbk;
    const float* W = J.src + (size_t)bi * J.sstride; f16* WT = J.dst + (size_t)bi * J.dstride;
#pragma unroll 8
    for (int i = 0; i < 32; ++i) {
        const int kk = 2 * i + (lane >> 5), k = k0 + kk; float v = 0.f;
        if (k < J.K) { v = W[(size_t)k * J.N + n0 + (lane & 31)]; float s = J.s1 ? J.s1[k] : 1.f; if (J.mode == 1) s *= 1.f - J.s2[k]; else if (J.mode == 2) s *= J.s2[k]; v *= s; }
        scr[kk * 33 + (lane & 31)] = v;
    }
    asm volatile("s_waitcnt lgkmcnt(0)" ::: "memory");
    const int c = lane & 7;
    if (k0 + 8 * c < J.K) {
#pragma unroll
        for (int j = 0; j < 4; ++j) { const int n = (lane >> 3) + 8 * j; const LAS float* s = scr + (8 * c) * 33 + n;
            u32x4 o; o.x = pkh(s[0 * 33], s[1 * 33]); o.y = pkh(s[2 * 33], s[3 * 33]); o.z = pkh(s[4 * 33], s[5 * 33]); o.w = pkh(s[6 * 33], s[7 * 33]);
            *(u32x4*)(WT + (size_t)(n0 + n) * J.ldd + k0 + 8 * c) = o; }
    }
    asm volatile("s_waitcnt lgkmcnt(0)" ::: "memory");
}

__device__ __forceinline__ void p0_prologue(const Params& p, unsigned char* ws, LAS unsigned char* lds, int bid, int wave, int lane) {
    LAS float* scr = (LAS float*)(lds + wave * 16384);
    const int G = gridDim.x, gw = bid * NWAVES + wave, NGW = G * NWAVES;
    for (int it = gw; it < p.nitems0; it += NGW) {
        int j = 0;
        while (j + 1 < p.njobs0 && it >= p.jobs[j + 1].item0) ++j;
        p0_transpose_item(p.jobs[j], it - p.jobs[j].item0, scr, lane);
    }
    const float* x = p.in[0]; f16* HN = (f16*)(ws + WS_HN);
    for (int m = gw; m < M; m += NGW) {
        const f32x4* xr = (const f32x4*)(x + (size_t)m * 1024) + lane;
        f32x4 v[4]; float s = 0.f;
#pragma unroll
        for (int j = 0; j < 4; ++j) { v[j] = xr[64 * j]; s += (v[j].x * v[j].x + v[j].y * v[j].y) + (v[j].z * v[j].z + v[j].w * v[j].w); }
        const float r = rsqrtf(wave_sum(s, lane) * (1.f / 1024.f) + 1e-6f);
        u32x2* o8 = (u32x2*)(HN + (size_t)m * 1024) + lane;
#pragma unroll
        for (int j = 0; j < 4; ++j) o8[64 * j] = (u32x2){pkh(v[j].x * r, v[j].y * r), pkh(v[j].z * r, v[j].w * r)};
    }
    const float* pp = p.in[1]; f16* PH = (f16*)(ws + WS_PH);
    const int gt = bid * NTHR + wave * 64 + lane, NGT = G * NTHR;
    for (int i = gt; i < M * 256 / 8; i += NGT) {
        const f32x4 a = *((const f32x4*)pp + 2 * (size_t)i), b = *((const f32x4*)pp + 2 * (size_t)i + 1);
        *((u32x4*)PH + i) = (u32x4){pkh(a.x, a.y), pkh(a.z, a.w), pkh(b.x, b.y), pkh(b.z, b.w)};
    }
    const int* pos = (const int*)p.in[2]; float* rc = (float*)(ws + WS_ROPC); float* rs = (float*)(ws + WS_ROPS);
    for (int i = gt; i < M * 32; i += NGT) {
        const int t = i >> 5, f = i & 31; const float inv = powf(10000.f, -(float)f / 32.f); const float ang = (float)pos[t] * inv;
        rc[i] = cosf(ang); rs[i] = sinf(ang);
    }
    float* ssq = (float*)(ws + WS_SSQPE);
    for (int i = gt; i < M; i += NGT) ssq[i] = 0.f;
    float* RW = (float*)(ws + WS_RW); const float* gm = p.in[28]; const float* wg = p.in[29]; const float* we = p.in[30];
    for (int i = gt; i < 48 * 1024; i += NGT) {
        const int c = i >> 10, k = i & 1023;
        const float w = c < 4 ? wg[k * 4 + c] : (c < 36 ? we[(size_t)((c - 4) >> 3) * 8192 + k * 8 + ((c - 4) & 7)] : 0.f);
        RW[i] = w * gm[k];
    }
}

enum { EPI_QK = 0, EPI_ST16 = 1, EPI_PE = 2, EPI_X1 = 3, EPI_UP = 4, EPI_DOWN = 5, EPI_FINAL = 6 };
enum { PH_P0 = 0, PH_P1, PH_ATTN, PH_P2A, PH_P2B, PH_P2C0, PH_SCAN0, PH_P2C1, PH_SCAN1, PH_MIX, PH_OUT, PH_ROUTE, PH_UP, PH_DOWN, PH_COMB, PH_GATE, PH_END };
struct UniSched {
    const unsigned char* ws; int ph, G, c;
    __device__ __forceinline__ bool next(int i, GU& u) const {
        unsigned char* w = const_cast<unsigned char*>(ws);
        u.aux = 0; u.glist = nullptr; u.elist = nullptr; u.gcnt = 0;
        if (ph == PH_P1) {
            constexpr int nM = M / BM, nN = NIN / BM, nwg = nM * nN, nPE = nM * 4;
            const int rounds = (nwg + G - 1) / G, rem = nwg % G;
            const long L = (long)i * G + c;
            if (L < nwg) {
                int wgid = (int)L; { const int q = nwg / NXCD, r = nwg % NXCD, xcd = wgid % NXCD, off = wgid / NXCD; wgid = (xcd < r ? xcd * (q + 1) : r * (q + 1) + (xcd - r) * q) + off; }
                const int nig = WGM * nN, gid = wgid / nig, fm = gid * WGM, gsz = (nM - fm) < WGM ? (nM - fm) : WGM;
                const int pm = fm + ((wgid % nig) % gsz), pn = (wgid % nig) / gsz;
                u.pm = pm; u.pn = pn; u.nt = 16; u.lda2 = 2048; u.ldb2 = 2048; u.hsa = 128 * 2048;
                u.a = (const char*)(ws + WS_HN) + (size_t)pm * 256 * 2048;
                u.b = (const char*)(ws + WS_WIN) + (size_t)pn * 256 * 2048;
                if (pn < 4) { u.bmode = 2; u.hsb = 32 * 2048; u.epi = EPI_QK; u.o = (char*)(w + (pn < 2 ? WS_Q : WS_K)); u.ldc = 512; u.oc0 = 256 * (pn & 1); u.aux = pn < 2; }
                else { u.bmode = 1; u.hsb = 128 * 2048; u.epi = EPI_ST16;
                    if (pn < 6) { u.o = (char*)(w + WS_V); u.ldc = 512; u.oc0 = 256 * (pn - 4); }
                    else if (pn < 12) { u.o = (char*)(w + WS_ZR); u.ldc = 1536; u.oc0 = 256 * (pn - 6); }
                    else { u.o = (char*)(w + WS_P); u.ldc = 768; u.oc0 = 256 * (pn - 12); } }
                return true;
            }
            int Lp;
            if (rem == 0) Lp = (int)(L - nwg);
            else { if (c < rem) return false; Lp = (i - (rounds - 1)) * (G - rem) + (c - rem); }
            if (Lp >= nPE) return false;
            const int pm = Lp >> 2, pn = Lp & 3;
            u.pm = pm; u.pn = pn; u.nt = 4; u.lda2 = 512; u.ldb2 = 512; u.hsa = 128 * 512; u.hsb = 128 * 512; u.bmode = 1; u.epi = EPI_PE;
            u.a = (const char*)(ws + WS_PH) + (size_t)pm * 256 * 512;
            u.b = (const char*)(ws + WS_WPL) + (size_t)pn * 256 * 512;
            u.o = (char*)(w + WS_PE); u.ldc = 1024; u.oc0 = 256 * pn;
            return true;
        }
        if (ph == PH_P2B) {
            constexpr int nM = M / BM, nwg = nM * 6;
            const int L = i * G + c; if (L >= nwg) return false;
            const int pm = L / 6, pn = L % 6;
            u.pm = pm; u.pn = pn; u.nt = 6; u.lda2 = 768; u.ldb2 = 768; u.hsa = 128 * 768; u.hsb = 128 * 768; u.bmode = 1; u.epi = EPI_ST16;
            u.a = (const char*)(ws + WS_LA) + (size_t)pm * 256 * 768; u.b = (const char*)(ws + WS_WB) + (size_t)pn * 256 * 768;
            u.o = (char*)(w + (pn < 2 ? WS_WL : pn < 4 ? WS_AL : WS_G)); u.ldc = 512; u.oc0 = 256 * (pn & 1);
            return true;
        }
        if (ph == PH_OUT || ph == PH_GATE) {
            constexpr int nM = M / BM, nN = 4, nwg = nM * nN;
            const long L = (long)i * G + c; if (L >= nwg) return false;
            int wgid = (int)L; { const int q = nwg / NXCD, r = nwg % NXCD, xcd = wgid % NXCD, off = wgid / NXCD; wgid = (xcd < r ? xcd * (q + 1) : r * (q + 1) + (xcd - r) * q) + off; }
            const int nig = WGM * nN, gid = wgid / nig, fm = gid * WGM, gsz = (nM - fm) < WGM ? (nM - fm) : WGM;
            const int pm = fm + ((wgid % nig) % gsz), pn = (wgid % nig) / gsz;
            u.pm = pm; u.pn = pn; u.nt = 16; u.lda2 = 2048; u.ldb2 = 2048; u.hsa = 128 * 2048; u.hsb = 128 * 2048; u.bmode = 0;
            u.a = (const char*)(ws + (ph == PH_OUT ? WS_MIX : WS_X2H)) + (size_t)pm * 256 * 2048;
            u.b = (const char*)(ws + (ph == PH_OUT ? WS_WOUT : WS_WPLG)) + (size_t)pn * 256 * 2048;
            u.epi = ph == PH_OUT ? EPI_X1 : EPI_FINAL; u.o = nullptr; u.ldc = 1024; u.oc0 = 256 * pn;
            return true;
        }
        if (ph == PH_UP || ph == PH_DOWN) {
            const int vc = (G % 8 == 0) ? (c % 8) * (G / 8) + c / 8 : c;
            const int L = i * G + vc, T = L >> 2, pn = L & 3;
            const int* cnt = (const int*)(ws + WS_CTL) + CW_CNT;
            int e = 0, t0 = 0, cn = 0;
            for (; e < 32; ++e) { cn = __builtin_amdgcn_readfirstlane(cnt[e]); const int nte = (cn + 255) >> 8; if (T < t0 + nte) break; t0 += nte; }
            if (e >= 32) return false;
            const int rt = T - t0;
            u.pm = T; u.pn = pn; u.aux = e; u.gcnt = cn - rt * 256;
            const int* lst = (const int*)(ws + WS_LIST) + (size_t)e * M + rt * 256;
            if (ph == PH_UP) {
                u.glist = lst; u.a = (const char*)(ws + WS_H2); u.lda2 = 2048; u.hsa = 0; u.nt = 16;
                u.b = (const char*)(ws + WS_WUP) + (size_t)e * 1024 * 2048 + (size_t)pn * 128 * 2048; u.ldb2 = 2048; u.hsb = 512 * 2048; u.bmode = 1;
                u.epi = EPI_UP; u.o = (char*)(w + WS_HID); u.ldc = 512; u.oc0 = 128 * pn;
            } else {
                u.elist = lst; u.a = (const char*)(ws + WS_HID) + (size_t)T * 256 * 1024; u.lda2 = 1024; u.hsa = 128 * 1024; u.nt = 8;
                u.b = (const char*)(ws + WS_WDN) + (size_t)e * 1024 * 1024 + (size_t)pn * 256 * 1024; u.ldb2 = 1024; u.hsb = 128 * 1024; u.bmode = 1;
                u.epi = EPI_DOWN; u.o = (char*)(w + WS_YE); u.ldc = 1024; u.oc0 = 256 * pn;
            }
            return true;
        }
        return false;
    }
};
struct UniEpi {
    unsigned char* ws; const Params& P;
    __device__ __forceinline__ const float* pin(int i) const { asm volatile("" : "+s"(i)); return P.in[i]; }
    __device__ __forceinline__ void operator()(const f32x4 (&acc)[2][2][4][2], const GU& u, int wr, int wc, int fr, int fq) const {
        const int row0 = u.pm * BM + wr * 64 + fr, ln = fq * 16 + fr;
        if (u.epi == EPI_ST16 || u.epi == EPI_PE) {
            f16* O = (f16*)u.o; const int ldc = u.ldc, col0 = u.oc0;
            float* ssq = (float*)(ws + WS_SSQPE);
#pragma unroll
            for (int ai = 0; ai < 2; ++ai)
#pragma unroll
                for (int m = 0; m < 4; ++m) {
                    const int row = row0 + ai * HALF + m * 16; f16* rp = O + (size_t)row * ldc + col0 + wc * 32 + 8 * fq; float s = 0.f;
#pragma unroll
                    for (int bj = 0; bj < 2; ++bj) { const f32x4 v0 = acc[ai][bj][m][0], v1 = acc[ai][bj][m][1];
                        s += (v0[0] * v0[0] + v0[1] * v0[1]) + (v0[2] * v0[2] + v0[3] * v0[3]) + (v1[0] * v1[0] + v1[1] * v1[1]) + (v1[2] * v1[2] + v1[3] * v1[3]);
                        *(u32x4*)(rp + bj * HALF) = (u32x4){pkh(v0[0], v0[1]), pkh(v0[2], v0[3]), pkh(v1[0], v1[1]), pkh(v1[2], v1[3])}; }
                    if (u.epi == EPI_PE) { s += shx(s, 16, ln); s += shx(s, 32, ln); if (fq == 0) atomicAdd(ssq + row, s); }
                }
            return;
        }
        if (u.epi == EPI_X1 || u.epi == EPI_FINAL) {
            const float* xin = u.epi == EPI_X1 ? pin(0) : (const float*)(ws + WS_X1); const float* gpl = pin(35); float* outp = P.out;
            float* O = u.epi == EPI_X1 ? (float*)(ws + WS_X1) : outp;
            const f16* PE = (const f16*)(ws + WS_PE); const float* ssq = (const float*)(ws + WS_SSQPE);
#pragma unroll
            for (int ai = 0; ai < 2; ++ai)
#pragma unroll
                for (int m = 0; m < 4; ++m) {
                    const int row = row0 + ai * HALF + m * 16; const size_t ro = (size_t)row * 1024 + u.oc0 + wc * 32 + 4 * fq;
                    float rpe = 0.f; if (u.epi == EPI_FINAL) rpe = rsqrtf(ssq[row] * (1.f / 1024.f) + 1e-6f);
#pragma unroll
                    for (int bj = 0; bj < 2; ++bj)
#pragma unroll
                        for (int n = 0; n < 2; ++n) { const size_t o = ro + bj * HALF + n * 16; const f32x4 xr = *(const f32x4*)(xin + o); f32x4 v = acc[ai][bj][m][n];
                            if (u.epi == EPI_FINAL) { const h4 pe = *(const h4*)(PE + o); const f32x4 gp = *(const f32x4*)(gpl + (o - (size_t)row * 1024));
#pragma unroll
                                for (int j = 0; j < 4; ++j) v[j] = (float)pe[j] * rpe * gp[j] / (1.f + __expf(-v[j])); }
                            *(f32x4*)(O + o) = xr + v; }
                    asm volatile("" ::: "memory");
                }
            return;
        }
        if (u.epi == EPI_UP) {
            f16* O = (f16*)u.o;
#pragma unroll
            for (int ai = 0; ai < 2; ++ai)
#pragma unroll
                for (int m = 0; m < 4; ++m) {
                    const int row = row0 + ai * HALF + m * 16; unsigned w4[4];
#pragma unroll
                    for (int n = 0; n < 2; ++n) { const f32x4 gt = acc[ai][0][m][n], up = acc[ai][1][m][n]; float h[4];
#pragma unroll
                        for (int j = 0; j < 4; ++j) h[j] = gt[j] / (1.f + __expf(-gt[j])) * up[j];
                        w4[2 * n] = pkh(h[0], h[1]); w4[2 * n + 1] = pkh(h[2], h[3]); }
                    *(u32x4*)(O + (size_t)row * 512 + u.oc0 + wc * 32 + 8 * fq) = (u32x4){w4[0], w4[1], w4[2], w4[3]};
                    asm volatile("" ::: "memory");
                }
            return;
        }
        if (u.epi == EPI_DOWN) {
            f16* O = (f16*)u.o; const float* aw = (const float*)(ws + WS_ASGW);
#pragma unroll
            for (int ai = 0; ai < 2; ++ai)
#pragma unroll
                for (int m = 0; m < 4; ++m) {
                    const int r = wr * 64 + fr + ai * HALF + m * 16;
                    if (r < u.gcnt) { const int slot = u.elist[r]; const float wgt = aw[slot]; f16* rp = O + (size_t)slot * 1024 + u.oc0 + wc * 32 + 8 * fq;
#pragma unroll
                        for (int bj = 0; bj < 2; ++bj) { const f32x4 v0 = acc[ai][bj][m][0] * wgt, v1 = acc[ai][bj][m][1] * wgt;
                            *(u32x4*)(rp + bj * HALF) = (u32x4){pkh(v0[0], v0[1]), pkh(v0[2], v0[3]), pkh(v1[0], v1[1]), pkh(v1[2], v1[3])}; } }
                    asm volatile("" ::: "memory");
                }
            return;
        }
        const bool isq = u.aux != 0; const float* g = isq ? pin(5) : pin(6); const float osc = isq ? C2 : 1.f;
        f16* O = (f16*)u.o; const int colb = u.oc0 + 64 * wc + 8 * fq;
        const float* rc = (const float*)(ws + WS_ROPC); const float* rs = (const float*)(ws + WS_ROPS);
        f32x4 gl[2][2];
#pragma unroll
        for (int bj = 0; bj < 2; ++bj)
#pragma unroll
            for (int n = 0; n < 2; ++n) gl[bj][n] = *(const f32x4*)(g + 32 * bj + 8 * fq + 4 * n);
#pragma unroll
        for (int ai = 0; ai < 2; ++ai)
#pragma unroll
            for (int m = 0; m < 4; ++m) {
                const int row = row0 + ai * HALF + m * 16; float s = 0.f;
#pragma unroll
                for (int bj = 0; bj < 2; ++bj)
#pragma unroll
                    for (int n = 0; n < 2; ++n) { const f32x4 v = acc[ai][bj][m][n]; s += (v[0] * v[0] + v[1] * v[1]) + (v[2] * v[2] + v[3] * v[3]); }
                s += shx(s, 16, ln); s += shx(s, 32, ln);
                const float ri = rsqrtf(s * (1.f / 64.f) + 1e-6f);
                unsigned lo[4], hi[4];
#pragma unroll
                for (int n = 0; n < 2; ++n) {
                    const f32x4 c = *(const f32x4*)(rc + (size_t)row * 32 + 8 * fq + 4 * n), sn = *(const f32x4*)(rs + (size_t)row * 32 + 8 * fq + 4 * n);
                    const f32x4 y0 = acc[ai][0][m][n] * gl[0][n] * ri, y1 = acc[ai][1][m][n] * gl[1][n] * ri;
                    const f32x4 l = (y0 * c - y1 * sn) * osc, h = (y1 * c + y0 * sn) * osc;
                    lo[2 * n] = pkh(l[0], l[1]); lo[2 * n + 1] = pkh(l[2], l[3]); hi[2 * n] = pkh(h[0], h[1]); hi[2 * n + 1] = pkh(h[2], h[3]);
                }
                f16* rp = O + (size_t)row * 512 + colb;
                *(u32x4*)rp = (u32x4){lo[0], lo[1], lo[2], lo[3]};
                *(u32x4*)(rp + 32) = (u32x4){hi[0], hi[1], hi[2], hi[3]};
            }
    }
};

__device__ __forceinline__ void p4_mix(unsigned char* ws, const float* lq1, const float* lk1, const float* lq2, const float* lk2, const float* ogp, int bid, int wave, int lane) {
    const int gw = bid * NWAVES + wave, NGW = gridDim.x * NWAVES;
    const float d1 = wave_sum(lq1[lane] * lk1[lane], lane), d2 = wave_sum(lq2[lane] * lk2[lane], lane);
    const float lam = expf(d1) - expf(d2) + 0.2f;
    const f16* O = (const f16*)(ws + WS_O); f16* MIX = (f16*)(ws + WS_MIX);
    const float* og = ogp + (lane & 15) * 8; float g[8];
#pragma unroll
    for (int j = 0; j < 8; ++j) g[j] = og[j] * 0.8f;
    for (int m = gw; m < M; m += NGW) {
        const h8 a = *(const h8*)(O + (size_t)m * 1024 + lane * 8), b = *(const h8*)(O + (size_t)m * 1024 + 512 + lane * 8);
        float o[8]; float s = 0.f;
#pragma unroll
        for (int j = 0; j < 8; ++j) { o[j] = (float)a[j] - lam * (float)b[j]; s += o[j] * o[j]; }
        s += shx(s, 1, lane); s += shx(s, 2, lane); s += shx(s, 4, lane); s += shx(s, 8, lane);
        const float r = rsqrtf(s * (1.f / 128.f) + 1e-5f);
        *(u32x4*)(MIX + (size_t)m * 1024 + lane * 8) = (u32x4){pkh(o[0] * r * g[0], o[1] * r * g[1]), pkh(o[2] * r * g[2], o[3] * r * g[3]), pkh(o[4] * r * g[4], o[5] * r * g[5]), pkh(o[6] * r * g[6], o[7] * r * g[7])};
    }
}
__device__ __forceinline__ void p4_mix_rwkv(unsigned char* ws, const float* mu_rkv, const float* gn_w, const float* gn_b, int bid, int wave, int lane) {
    const int gw = bid * NWAVES + wave, NGW = gridDim.x * NWAVES;
    const f16* Y = (const f16*)(ws + WS_Y); const float* BON = (const float*)(ws + WS_BON);
    const f16* VS = (const f16*)(ws + WS_VS); const f16* Gg = (const f16*)(ws + WS_G); f16* MIX = (f16*)(ws + WS_MIX);
    (void)mu_rkv;
    for (int it = gw; it < M * 8; it += NGW) {
        const int m = it >> 3, hd = it & 7, c = hd * 64 + lane;
        const float y = (float)Y[(size_t)m * 512 + c];
        const float mu = wave_sum(y, lane) * (1.f / 64.f), d = y - mu, var = wave_sum(d * d, lane) * (1.f / 64.f);
        const float yn = d * rsqrtf(var + 64e-5f) * gn_w[c] + gn_b[c];
        const float v = (float)VS[(size_t)m * 512 + c];
        const float gg = (float)Gg[(size_t)m * 512 + c];
        MIX[(size_t)m * 1024 + 512 + c] = (f16)((yn + BON[(size_t)m * 8 + hd] * v) * gg);
    }
}


__device__ __forceinline__ void p6_expert_weights(const Params& p, LAS unsigned char* lds, int bid, int wave, int lane) {
    LAS float* scr = (LAS float*)(lds + 32768 + wave * 8704);
    const int gw = bid * NWAVES + wave, NGW = gridDim.x * NWAVES;
    for (int it = p.nitems0 + gw; it < p.nitems; it += NGW) {
        int j = p.njobs0;
        while (j + 1 < p.njobs && it >= p.jobs[j + 1].item0) ++j;
        p0_transpose_item(p.jobs[j], it - p.jobs[j].item0, scr, lane);
    }
}
__device__ __forceinline__ void p6_router(unsigned char* ws, LAS unsigned char* lds, int bid, int wave, int lane) {
    const float* X1 = (const float*)(ws + WS_X1); const float* RW = (const float*)(ws + WS_RW); f16* H2 = (f16*)(ws + WS_H2);
    int* cnt = (int*)(ws + WS_CTL) + CW_CNT; int* LIST = (int*)(ws + WS_LIST); float* ASGW = (float*)(ws + WS_ASGW);
    LAS float* lg = (LAS float*)(lds + wave * 4096);
    const int gw = bid * NWAVES + wave, NGW = gridDim.x * NWAVES, r = lane & 15, kq = lane >> 4;
    for (int task = gw; task < M / 16; task += NGW) {
        const int row0 = task * 16;
        const float* xr = X1 + (size_t)(row0 + r) * 1024 + 4 * kq;
        f32x4 acc[3] = {{0.f, 0.f, 0.f, 0.f}, {0.f, 0.f, 0.f, 0.f}, {0.f, 0.f, 0.f, 0.f}}; float ssq = 0.f;
#pragma unroll 2
        for (int j = 0; j < 64; ++j) {
            const f32x4 xa = *(const f32x4*)(xr + 16 * j);
            ssq += (xa[0] * xa[0] + xa[1] * xa[1]) + (xa[2] * xa[2] + xa[3] * xa[3]);
#pragma unroll
            for (int t = 0; t < 3; ++t) { const f32x4 wb = *(const f32x4*)(RW + (size_t)(16 * t + r) * 1024 + 16 * j + 4 * kq);
#pragma unroll
                for (int e = 0; e < 4; ++e) acc[t] = __builtin_amdgcn_mfma_f32_16x16x4f32(xa[e], wb[e], acc[t], 0, 0, 0); }
        }
        ssq += shx(ssq, 16, lane); ssq += shx(ssq, 32, lane);
        const float rstd = rsqrtf(ssq * (1.f / 1024.f) + 1e-6f);
        if (kq == 0) lg[768 + r] = rstd;
#pragma unroll
        for (int t = 0; t < 3; ++t)
#pragma unroll
            for (int q = 0; q < 4; ++q) lg[(4 * kq + q) * 48 + 16 * t + r] = acc[t][q];
        asm volatile("s_waitcnt lgkmcnt(0)" ::: "memory");
#pragma unroll 4
        for (int j = 0; j < 64; ++j) { const f32x4 xa = *(const f32x4*)(xr + 16 * j);
            *(u32x2*)(H2 + (size_t)(row0 + r) * 1024 + 16 * j + 4 * kq) = (u32x2){pkh(xa[0] * rstd, xa[1] * rstd), pkh(xa[2] * rstd, xa[3] * rstd)}; }
        if (lane < 16) {
            const int t = row0 + lane; const float rs = lg[768 + lane]; const LAS float* l = lg + lane * 48;
            int gs = 0; float gm = l[0] * rs;
#pragma unroll
            for (int i = 1; i < 4; ++i) { const float v = l[i] * rs; if (v > gm) { gm = v; gs = i; } }
            float den = 0.f;
#pragma unroll
            for (int i = 0; i < 4; ++i) den += expf(l[i] * rs - gm);
            const float gwt = 1.f / den;
            float ev[8];
#pragma unroll
            for (int i = 0; i < 8; ++i) { float v = 0.f;
#pragma unroll
                for (int gq = 0; gq < 4; ++gq) if (gq == gs) v = l[4 + 8 * gq + i];
                ev[i] = v * rs; }
            int i0 = 0; float v0 = ev[0];
#pragma unroll
            for (int i = 1; i < 8; ++i) if (ev[i] > v0) { v0 = ev[i]; i0 = i; }
            int i1 = 0; float v1 = -INFINITY;
#pragma unroll
            for (int i = 0; i < 8; ++i) if (i != i0 && ev[i] > v1) { v1 = ev[i]; i1 = i; }
            const float p1 = expf(v1 - v0), w0 = gwt / (1.f + p1), w1 = gwt * p1 / (1.f + p1);
            const int e0 = gs * 8 + i0, e1 = gs * 8 + i1;
            ASGW[2 * t] = w0; ASGW[2 * t + 1] = w1;
            int pos = atomicAdd(cnt + e0, 1); LIST[(size_t)e0 * M + pos] = 2 * t;
            pos = atomicAdd(cnt + e1, 1); LIST[(size_t)e1 * M + pos] = 2 * t + 1;
        }
        asm volatile("s_waitcnt lgkmcnt(0)" ::: "memory");
    }
}
__device__ __forceinline__ void p9_combine(unsigned char* ws, int bid, int wave, int lane) {
    float* X1 = (float*)(ws + WS_X1); const f16* YE = (const f16*)(ws + WS_YE); f16* X2H = (f16*)(ws + WS_X2H);
    const int gw = bid * NWAVES + wave, NGW = gridDim.x * NWAVES;
    for (int m = gw; m < M; m += NGW) {
        f32x4 v[4]; float s = 0.f;
#pragma unroll
        for (int j = 0; j < 4; ++j) {
            const size_t c = (size_t)lane * 4 + 256 * j;
            v[j] = *(const f32x4*)(X1 + (size_t)m * 1024 + c);
            const h4 a = *(const h4*)(YE + (size_t)(2 * m) * 1024 + c), b = *(const h4*)(YE + (size_t)(2 * m + 1) * 1024 + c);
#pragma unroll
            for (int q = 0; q < 4; ++q) { v[j][q] += (float)a[q] + (float)b[q]; s += v[j][q] * v[j][q]; }
        }
        const float r = rsqrtf(wave_sum(s, lane) * (1.f / 1024.f) + 1e-6f);
#pragma unroll
        for (int j = 0; j < 4; ++j) {
            const size_t c = (size_t)lane * 4 + 256 * j;
            *(f32x4*)(X1 + (size_t)m * 1024 + c) = v[j];
            *(u32x2*)(X2H + (size_t)m * 1024 + c) = (u32x2){pkh(v[j][0] * r, v[j][1] * r), pkh(v[j][2] * r, v[j][3] * r)};
        }
    }
}
}
namespace mk {
constexpr int CH = 16, NCH = SEQ / CH;
constexpr int NCHH = NCH / 2, NJOBH = NB * 8 * NCHH;
constexpr int P2C_WAVE_LDS = 19456;
constexpr int RJ_PHI = 0, RJ_RH = 8192, RJ_PSI = 10240, RJ_C2 = 12288, RJ_VB = 12800, RJ_DG = 14848, RJ_BYTES = 15104;

struct RwkvW { const float *mu_rkv, *w0, *a0, *k_k, *k_a, *r_k, *gn_w, *gn_b; };

struct TokVals { float r, k2, v, a, b, lw; };
__device__ __forceinline__ TokVals rwkv_tok(const f16* ZR, const f16* WL, const f16* AL, const RwkvW& W, size_t row, bool hasprev, int c, int lane) {
    const f16* z = ZR + row * 1536; const f16* zp = z - 1536;
    const float zr = (float)z[c], zk = (float)z[512 + c], zv = (float)z[1024 + c];
    const float pr = hasprev ? (float)zp[c] : 0.f, pk = hasprev ? (float)zp[512 + c] : 0.f, pv = hasprev ? (float)zp[1024 + c] : 0.f;
    TokVals o;
    o.r = zr + (pr - zr) * W.mu_rkv[c]; const float k = zk + (pk - zk) * W.mu_rkv[512 + c]; o.v = zv + (pv - zv) * W.mu_rkv[1024 + c];
    const float wl = W.w0[c] + (float)WL[row * 512 + c];
    const float nx = -wl; const float sp = nx > 20.f ? nx : log1pf(expf(nx));
    o.lw = -expf(-sp - 0.5f);
    const float ag = 1.f / (1.f + expf(-(W.a0[c] + (float)AL[row * 512 + c])));
    float kk = k * W.k_k[c];
    const float ss = wave_sum(kk * kk, lane);
    kk *= rsqrtf(fmaxf(ss, 1e-24f));
    o.k2 = k * (1.f + (ag - 1.f) * W.k_a[c]); o.a = -kk; o.b = kk * ag;
    return o;
}

__device__ __forceinline__ void p2a_la(unsigned char* ws, int bid, int tid) {
    const f16* P = (const f16*)(ws + WS_P); f16* LA = (f16*)(ws + WS_LA);
    const int gt = bid * NTHR + tid, NGT = gridDim.x * NTHR;
    for (int i = gt; i < M * 48; i += NGT) {
        const int t = i / 48, c8 = (i % 48) * 8; u32x4 o = (u32x4){0u, 0u, 0u, 0u};
        if (c8 < 288) {
            const h8 a = *(const h8*)(P + (size_t)t * 768 + c8); h8 b = (h8){0, 0, 0, 0, 0, 0, 0, 0};
            if (t % SEQ) b = *(const h8*)(P + (size_t)(t - 1) * 768 + 288 + c8);
            float v[8];
#pragma unroll
            for (int j = 0; j < 8; ++j) { float x = (float)a[j] + (float)b[j]; v[j] = c8 < 64 ? tanhf(x) : (c8 < 128 ? x : 1.f / (1.f + expf(-x))); }
            o = (u32x4){pkh(v[0], v[1]), pkh(v[2], v[3]), pkh(v[4], v[5]), pkh(v[6], v[7])};
        }
        *(u32x4*)(LA + (size_t)t * 384 + c8) = o;
    }
}

__device__ __forceinline__ h8 lds_h8(LAS const unsigned char* p) { return *(LAS const h8*)p; }
__device__ __forceinline__ void p2c_chunks(unsigned char* ws, const RwkvW& W, LAS unsigned char* lds, int half, int bid, int wave, int lane) {
    LAS unsigned char* L = lds + wave * P2C_WAVE_LDS;
    const f16* ZR = (const f16*)(ws + WS_ZR); const f16* WL = (const f16*)(ws + WS_WL); const f16* AL = (const f16*)(ws + WS_AL); f16* VS = (f16*)(ws + WS_VS);
    unsigned char* RJ = ws + WS_RJ; float* BON = (float*)(ws + WS_BON);
    const int gw = bid * NWAVES + wave, NGW = gridDim.x * NWAVES;
    const int r16 = lane & 15, g = lane >> 4;
    const h8 zero8 = (h8){0, 0, 0, 0, 0, 0, 0, 0};
    for (int job = gw; job < NJOBH; job += NGW) {
        const int bh = job / NCHH, ch = half * NCHH + job % NCHH, b = bh >> 3, hd = bh & 7, c = hd * 64 + lane;
        const size_t row0 = (size_t)b * SEQ + ch * CH;
        unsigned char* rj0 = RJ + (size_t)job * RJ_BYTES;
        {
            float lwv[16]; float GL = 0.f;
#pragma unroll
            for (int i = 0; i < 16; ++i) {
                const float wl = W.w0[c] + (float)WL[(row0 + i) * 512 + c];
                const float nx = -wl; const float sp = nx > 20.f ? nx : log1pf(expf(nx));
                lwv[i] = -expf(-sp - 0.5f); GL += lwv[i];
            }
            float G = 0.f, eprev = 1.f; float vq[4];
#pragma unroll
            for (int i = 0; i < 16; ++i) {
                const TokVals tv = rwkv_tok(ZR, WL, AL, W, row0 + i, (ch * CH + i) != 0, c, lane);
                G += lwv[i]; const float ei = expf(G), einv = 1.f / ei, f = expf(GL - G);
                *(LAS f16*)(L + 0 + i * 144 + lane * 2) = (f16)(tv.a * eprev); *(LAS f16*)(L + 2304 + i * 144 + lane * 2) = (f16)(tv.b * einv);
                *(LAS f16*)(L + 4608 + i * 144 + lane * 2) = (f16)(tv.k2 * einv); *(LAS f16*)(L + 6912 + i * 144 + lane * 2) = (f16)(tv.r * ei);
                *(LAS f16*)(L + 13888 + lane * 80 + i * 2) = (f16)(tv.b * f); *(LAS f16*)(L + 13888 + lane * 80 + 32 + i * 2) = (f16)(tv.k2 * f);
                eprev = ei; vq[i & 3] = tv.v; VS[(row0 + i) * 512 + c] = (f16)tv.v;
                if ((i & 3) == 3) *(u32x2*)(rj0 + RJ_VB + ((lane >> 4) * 64 + (lane & 15) + 16 * (i >> 2)) * 8) = (u32x2){pkh(vq[0], vq[1]), pkh(vq[2], vq[3])};
                const float bon = wave_sum(tv.r * tv.k2 * W.r_k[c], lane);
                if (lane == 0) BON[(row0 + i) * 8 + hd] = bon;
            }
            *(float*)(rj0 + RJ_DG + lane * 4) = expf(GL);
        }
        asm volatile("s_waitcnt lgkmcnt(0)" ::: "memory");
        f32x4 n1 = {0.f, 0.f, 0.f, 0.f}, n2 = n1, n3 = n1, n4 = n1;
#pragma unroll
        for (int s = 0; s < 2; ++s) {
            const int off = r16 * 144 + (8 * g + 32 * s) * 2;
            const h8 xa = lds_h8(L + 0 + off), xb = lds_h8(L + 2304 + off), xk = lds_h8(L + 4608 + off), xr = lds_h8(L + 6912 + off);
            n1 = __builtin_amdgcn_mfma_f32_16x16x32_f16(xa, xb, n1, 0, 0, 0);
            n2 = __builtin_amdgcn_mfma_f32_16x16x32_f16(xa, xk, n2, 0, 0, 0);
            n3 = __builtin_amdgcn_mfma_f32_16x16x32_f16(xb, xr, n3, 0, 0, 0);
            n4 = __builtin_amdgcn_mfma_f32_16x16x32_f16(xk, xr, n4, 0, 0, 0);
        }
#pragma unroll
        for (int q = 0; q < 4; ++q) { const int rr = 4 * g + q;
            if (!(r16 < rr)) { n1[q] = 0.f; n2[q] = 0.f; }
            if (!(rr <= r16)) { n3[q] = 0.f; n4[q] = 0.f; } }
#pragma unroll
        for (int q = 0; q < 4; ++q) { *(LAS float*)(L + 10240 + ((4 * g + q) * 16 + r16) * 4) = n1[q]; *(LAS float*)(L + 11264 + (r16 * 17 + 4 * g + q) * 4) = n2[q]; }
        *(LAS u32x2*)(L + 13120 + r16 * 48 + g * 8) = (u32x2){pkh(n3[0], n3[1]), pkh(n3[2], n3[3])};
        asm volatile("s_waitcnt lgkmcnt(0)" ::: "memory");
        float X[16], X1[16], rt[16];
#pragma unroll
        for (int i = 0; i < 16; ++i) rt[i] = (float)*(LAS const f16*)(L + 6912 + i * 144 + lane * 2);
#pragma unroll
        for (int i = 0; i < 16; ++i) {
            float x = (float)*(LAS const f16*)(L + 0 + i * 144 + lane * 2), x1 = *(LAS const float*)(L + 11264 + (r16 * 17 + i) * 4);
#pragma unroll
            for (int m4 = 0; m4 < (i + 3) / 4; ++m4) {
                const f32x4 cf = *(LAS const f32x4*)(L + 10240 + (i * 16 + m4 * 4) * 4);
#pragma unroll
                for (int q = 0; q < 4; ++q) if (m4 * 4 + q < i) { x = fmaf(X[m4 * 4 + q], cf[q], x); x1 = fmaf(X1[m4 * 4 + q], cf[q], x1); }
            }
            X[i] = x; X1[i] = x1;
        }
#pragma unroll
        for (int q = 0; q < 4; ++q) {
            *(LAS u32x2*)(L + 0 + lane * 80 + q * 8) = (u32x2){pkh(X[4 * q], X[4 * q + 1]), pkh(X[4 * q + 2], X[4 * q + 3])};
            *(LAS u32x2*)(L + 0 + lane * 80 + 32 + q * 8) = (u32x2){pkh(rt[4 * q], rt[4 * q + 1]), pkh(rt[4 * q + 2], rt[4 * q + 3])};
            if (lane < 16) *(LAS u32x2*)(L + 12352 + lane * 48 + q * 8) = (u32x2){pkh(X1[4 * q], X1[4 * q + 1]), pkh(X1[4 * q + 2], X1[4 * q + 3])};
        }
        asm volatile("s_waitcnt lgkmcnt(0)" ::: "memory");
        h8 Af[4], Ap[4], Bf[4];
#pragma unroll
        for (int t = 0; t < 4; ++t) { Af[t] = lds_h8(L + 0 + (16 * t + r16) * 80 + g * 16); Ap[t] = g < 2 ? Af[t] : zero8; Bf[t] = lds_h8(L + 13888 + (16 * t + r16) * 80 + g * 16); }
        h8 idn = zero8;
#pragma unroll
        for (int e8 = 0; e8 < 8; ++e8) if (g >= 2 && 8 * (g - 2) + e8 == r16) idn[e8] = (f16)1.f;
        const h8 c1raw = g < 2 ? lds_h8(L + 12352 + r16 * 48 + g * 16) : zero8;
        const h8 c1id = g < 2 ? c1raw : idn;
        const h8 nbraw = g < 2 ? lds_h8(L + 13120 + r16 * 48 + g * 16) : zero8;
        const h8 nbid = g < 2 ? nbraw : idn;
        unsigned char* rj = rj0;
        const f32x4 z4 = {0.f, 0.f, 0.f, 0.f};
#pragma unroll
        for (int t = 0; t < 4; ++t) {
            f32x4 d[4];
#pragma unroll
            for (int tp = 0; tp < 4; ++tp) d[tp] = __builtin_amdgcn_mfma_f32_16x16x32_f16(Ap[tp], Bf[t], z4, 0, 0, 0);
#pragma unroll
            for (int s = 0; s < 2; ++s)
                *(u32x4*)(rj + RJ_PHI + ((t * 2 + s) * 64 + lane) * 16) = (u32x4){pkh(d[2 * s][0], d[2 * s][1]), pkh(d[2 * s][2], d[2 * s][3]), pkh(d[2 * s + 1][0], d[2 * s + 1][1]), pkh(d[2 * s + 1][2], d[2 * s + 1][3])};
            const f32x4 ps = __builtin_amdgcn_mfma_f32_16x16x32_f16(c1id, Bf[t], z4, 0, 0, 0);
            *(u32x2*)(rj + RJ_PSI + (t * 64 + lane) * 8) = (u32x2){pkh(ps[0], ps[1]), pkh(ps[2], ps[3])};
        }
        {
            f32x4 d[4];
#pragma unroll
            for (int tp = 0; tp < 4; ++tp) d[tp] = __builtin_amdgcn_mfma_f32_16x16x32_f16(Af[tp], nbid, z4, 0, 0, 0);
#pragma unroll
            for (int s = 0; s < 2; ++s)
                *(u32x4*)(rj + RJ_RH + (s * 64 + lane) * 16) = (u32x4){pkh(d[2 * s][0], d[2 * s][1]), pkh(d[2 * s][2], d[2 * s][3]), pkh(d[2 * s + 1][0], d[2 * s + 1][1]), pkh(d[2 * s + 1][2], d[2 * s + 1][3])};
            const f32x4 c2 = __builtin_amdgcn_mfma_f32_16x16x32_f16(c1raw, nbraw, n4, 0, 0, 0);
            *(u32x2*)(rj + RJ_C2 + lane * 8) = (u32x2){pkh(c2[0], c2[1]), pkh(c2[2], c2[3])};
        }
        asm volatile("s_waitcnt lgkmcnt(0)" ::: "memory");
    }
}

__device__ __forceinline__ void p3s_scan(unsigned char* ws, int half, int bid, int wave, int lane) {
    const int G = gridDim.x;
    const int r16 = lane & 15, g = lane >> 4;
    const unsigned char* RJ = ws + WS_RJ; f16* Y = (f16*)(ws + WS_Y); f32x4* SST = (f32x4*)(ws + WS_SST);
    const h4 zero4 = (h4){0, 0, 0, 0};
    for (int task = wave * G + bid; task < NB * 32; task += G * NWAVES) {
        const int bh = task >> 2, vt = task & 3, b = bh >> 3, hd = bh & 7;
        f32x4 S[4];
#pragma unroll
        for (int t = 0; t < 4; ++t) S[t] = half ? SST[((size_t)task * 4 + t) * 64 + lane] : (f32x4){0.f, 0.f, 0.f, 0.f};
        const unsigned char* rj = RJ + (size_t)bh * NCHH * RJ_BYTES;
        for (int chl = 0; chl < NCHH; ++chl, rj += RJ_BYTES) {
            const int ch = half * NCHH + chl;
            h8 SB[2];
#pragma unroll
            for (int s = 0; s < 2; ++s) { const u32x4 w = (u32x4){pkh(S[2 * s][0], S[2 * s][1]), pkh(S[2 * s][2], S[2 * s][3]), pkh(S[2 * s + 1][0], S[2 * s + 1][1]), pkh(S[2 * s + 1][2], S[2 * s + 1][3])}; SB[s] = __builtin_bit_cast(h8, w); }
            const u32x2 vbw = *(const u32x2*)(rj + RJ_VB + (vt * 64 + lane) * 8);
            const h8 VBo = __builtin_bit_cast(h8, (u32x4){vbw.x, vbw.y, 0u, 0u});
            const u32x2 c2w = *(const u32x2*)(rj + RJ_C2 + lane * 8);
            const h8 C2o = __builtin_bit_cast(h8, (u32x4){c2w.x, c2w.y, 0u, 0u});
            f32x4 y = {0.f, 0.f, 0.f, 0.f};
#pragma unroll
            for (int s = 0; s < 2; ++s) { const h8 rh = __builtin_bit_cast(h8, *(const u32x4*)(rj + RJ_RH + (s * 64 + lane) * 16)); y = __builtin_amdgcn_mfma_f32_16x16x32_f16(rh, SB[s], y, 0, 0, 0); }
            y = __builtin_amdgcn_mfma_f32_16x16x32_f16(C2o, VBo, y, 0, 0, 0);
#pragma unroll
            for (int t = 0; t < 4; ++t) {
                const f32x4 dg = *(const f32x4*)(rj + RJ_DG + (16 * t + 4 * g) * 4);
                f32x4 acc = S[t] * dg;
#pragma unroll
                for (int s = 0; s < 2; ++s) { const h8 ph = __builtin_bit_cast(h8, *(const u32x4*)(rj + RJ_PHI + ((t * 2 + s) * 64 + lane) * 16)); acc = __builtin_amdgcn_mfma_f32_16x16x32_f16(ph, SB[s], acc, 0, 0, 0); }
                const u32x2 psw = *(const u32x2*)(rj + RJ_PSI + (t * 64 + lane) * 8);
                acc = __builtin_amdgcn_mfma_f32_16x16x32_f16(__builtin_bit_cast(h8, (u32x4){psw.x, psw.y, 0u, 0u}), VBo, acc, 0, 0, 0);
                S[t] = acc;
            }
            f16* yp = Y + ((size_t)b * SEQ + ch * CH + 4 * g) * 512 + hd * 64 + vt * 16 + r16;
#pragma unroll
            for (int q = 0; q < 4; ++q) yp[(size_t)q * 512] = (f16)y[q];
        }
        if (half == 0) {
#pragma unroll
            for (int t = 0; t < 4; ++t) SST[((size_t)task * 4 + t) * 64 + lane] = S[t];
        }
        (void)zero4;
    }
}
}
namespace mk {
__global__ void __launch_bounds__(NTHR, 2) mega(Params p0) {
#define PIN(i) ({ int _i = (i); asm volatile("" : "+s"(_i)); p0.in[_i]; })
    extern __shared__ __attribute__((aligned(16))) unsigned char lds_raw[];
    LAS unsigned char* lds = (LAS unsigned char*)lds_raw;
    const int wave_s = __builtin_amdgcn_readfirstlane(threadIdx.x >> 6);
    const int tid = threadIdx.x;
    volatile LAS unsigned* MISC = (volatile LAS unsigned*)(lds + MISC_OFF);
    for (int u = tid; u < (LDS_BYTES - SCR_BYTES) / 4; u += NTHR) ((LAS unsigned*)(lds + SCR_BYTES))[u] = 0u;
    __syncthreads();
    XcdBarrier bar = xcd_barrier_post((unsigned*)(p0.ws + WS_CTL) + CW_BAR, MISC + 8);
#define GRID_BAR() xcd_barrier(bar)

    for (int ph = p0.ph_lo; ph < p0.ph_hi; ++ph) {
        int tidv; asm volatile("v_mbcnt_lo_u32_b32 %0, -1, 0\n\tv_mbcnt_hi_u32_b32 %0, -1, %0" : "=v"(tidv)); tidv += wave_s * 64;
        const int lane = tidv & 63, wave = __builtin_amdgcn_readfirstlane(tidv >> 6);
        int bidv = blockIdx.x; asm volatile("" : "+s"(bidv));
        unsigned char* wsv = p0.ws; asm volatile("" : "+s"(wsv));
        if (ph == PH_P0) p0_prologue(p0, wsv, lds, bidv, wave, lane);
        else if (ph == PH_P2A) p2a_la(wsv, bidv, tidv);
        else if (ph == PH_P2C0 || ph == PH_P2C1) { const RwkvW W{PIN(12), PIN(14), PIN(17), PIN(22), PIN(23), PIN(24), nullptr, nullptr}; p2c_chunks(wsv, W, lds, ph == PH_P2C1, bidv, wave, lane); }
        else if (ph == PH_SCAN0 || ph == PH_SCAN1) p3s_scan(wsv, ph == PH_SCAN1, bidv, wave, lane);
        else if (ph == PH_ATTN) {
            const attn_body::AttnTensors AT{(const f16*)(wsv + WS_Q), (const f16*)(wsv + WS_K), (const f16*)(wsv + WS_V), (f16*)(wsv + WS_O)};
            const attn_body::StaticOrder S((int)gridDim.x, bidv);
            attn_body::attn_phase<attn_body::StaticOrder>((char*)lds_raw, AT, S, wave_s);
        }
        else if (ph == PH_ROUTE) { p6_router(wsv, lds, bidv, wave, lane); p6_expert_weights(p0, lds, bidv, wave, lane); }
        else if (ph == PH_COMB) p9_combine(wsv, bidv, wave, lane);
        else if (ph == PH_MIX) { p4_mix(wsv, PIN(7), PIN(8), PIN(9), PIN(10), PIN(11), bidv, wave, lane); p4_mix_rwkv(wsv, PIN(12), PIN(25), PIN(26), bidv, wave, lane); }
        else {
            UniSched S{wsv, ph, (int)gridDim.x, bidv};
            UniEpi E{wsv, p0};
            gemm_phase<UniSched, UniEpi>(lds, S, E, tidv);
        }
        if (ph + 1 < p0.ph_hi) { XcdBarrier bb = bar; asm volatile("" : "+s"(bb.bar), "+s"(bb.x)); xcd_barrier(bb, wave_s); }
    }
#undef GRID_BAR
}

static void add_job(Params& P, const float* src, f16* dst, const float* s1, const float* s2, int K, int N, int ldd, int mode, int nb, long sstride, long dstride) {
    TJob& j = P.jobs[P.njobs++]; j.src = src; j.dst = dst; j.s1 = s1; j.s2 = s2; j.K = K; j.N = N; j.ldd = ldd; j.mode = mode; j.nb = nb; j.sstride = sstride; j.dstride = dstride;
    j.item0 = P.nitems; P.nitems += ((K + 63) / 64) * (N / 32) * nb;
}
static void build_params(Params& P, void* const* d_in, void* d_out, void* d_ws, bool experts) {
    for (int i = 0; i < 38; ++i) P.in[i] = (const float*)d_in[i];
    P.out = (float*)d_out; P.ws = (unsigned char*)d_ws;
    unsigned char* ws = P.ws; auto F = [&](int i) { return (const float*)d_in[i]; };
    f16* WinT = (f16*)(ws + WS_WIN);
    add_job(P, F(4), WinT, F(3), nullptr, 1024, 3072, 1024, 0, 1, 0, 0);
    const float* mu = F(13);
    add_job(P, F(15), WinT + (size_t)3072 * 1024, F(3), mu, 1024, 64, 1024, 1, 1, 0, 0);
    add_job(P, F(15), WinT + (size_t)(3072 + 288) * 1024, F(3), mu, 1024, 64, 1024, 2, 1, 0, 0);
    add_job(P, F(18), WinT + (size_t)(3072 + 64) * 1024, F(3), mu + 1024, 1024, 64, 1024, 1, 1, 0, 0);
    add_job(P, F(18), WinT + (size_t)(3072 + 288 + 64) * 1024, F(3), mu + 1024, 1024, 64, 1024, 2, 1, 0, 0);
    add_job(P, F(20), WinT + (size_t)(3072 + 128) * 1024, F(3), mu + 2048, 1024, 160, 1024, 1, 1, 0, 0);
    add_job(P, F(20), WinT + (size_t)(3072 + 288 + 128) * 1024, F(3), mu + 2048, 1024, 160, 1024, 2, 1, 0, 0);
    add_job(P, F(27), (f16*)(ws + WS_WOUT), nullptr, nullptr, 1024, 1024, 1024, 0, 1, 0, 0);
    add_job(P, F(37), (f16*)(ws + WS_WPLG), F(36), nullptr, 1024, 1024, 1024, 0, 1, 0, 0);
    add_job(P, F(34), (f16*)(ws + WS_WPL), nullptr, nullptr, 256, 1024, 256, 0, 1, 0, 0);
    f16* WbT = (f16*)(ws + WS_WB);
    add_job(P, F(16), WbT, nullptr, nullptr, 64, 512, 384, 0, 1, 0, 0);
    add_job(P, F(19), WbT + (size_t)512 * 384 + 64, nullptr, nullptr, 64, 512, 384, 0, 1, 0, 0);
    add_job(P, F(21), WbT + (size_t)1024 * 384 + 128, nullptr, nullptr, 160, 512, 384, 0, 1, 0, 0);
    P.njobs0 = P.njobs; P.nitems0 = P.nitems;
    if (experts) {
        add_job(P, F(31), (f16*)(ws + WS_WUP), F(28), nullptr, 1024, 512, 1024, 0, 32, (long)1024 * 512, (long)1024 * 1024);
        add_job(P, F(32), (f16*)(ws + WS_WUP) + (size_t)512 * 1024, F(28), nullptr, 1024, 512, 1024, 0, 32, (long)1024 * 512, (long)1024 * 1024);
        add_job(P, F(33), (f16*)(ws + WS_WDN), nullptr, nullptr, 512, 1024, 512, 0, 32, (long)512 * 1024, (long)1024 * 512);
    }
}
}
namespace ad {
using mk::f16;
__global__ void __launch_bounds__(256) adapt1(const unsigned char* ws, int b, float* Z, float* L1, float* L2, float* L3, float* PE) {
    const f16* Q = (const f16*)(ws + mk::WS_Q); const f16* K = (const f16*)(ws + mk::WS_K); const f16* V = (const f16*)(ws + mk::WS_V);
    const f16* ZR = (const f16*)(ws + mk::WS_ZR); const f16* P = (const f16*)(ws + mk::WS_P); const f16* PEh = (const f16*)(ws + mk::WS_PE);
    const int t = blockIdx.x; const size_t g = (size_t)b * 2048 + t;
    for (int c = threadIdx.x; c < 3072; c += 256) {
        float v;
        if (c < 512) v = (float)Q[g * 512 + c] * (1.f / mk::C2);
        else if (c < 1024) v = (float)K[g * 512 + c - 512];
        else if (c < 1536) v = (float)V[g * 512 + c - 1024];
        else v = (float)ZR[g * 1536 + c - 1536];
        Z[(size_t)t * 3072 + c] = v;
    }
    for (int c = threadIdx.x; c < 1024; c += 256) PE[(size_t)t * 1024 + c] = (float)PEh[g * 1024 + c];
    for (int j = threadIdx.x; j < 288; j += 256) {
        float v = (float)P[g * 768 + j] + (t > 0 ? (float)P[(g - 1) * 768 + 288 + j] : 0.f);
        if (j < 64) L1[(size_t)t * 64 + j] = tanhf(v);
        else if (j < 128) L2[(size_t)t * 64 + j - 64] = v;
        else L3[(size_t)t * 160 + j - 128] = 1.f / (1.f + expf(-v));
    }
}
__global__ void __launch_bounds__(256) adapt2(const unsigned char* ws, int b, float* MIX) {
    const f16* X = (const f16*)(ws + mk::WS_MIX); const int t = blockIdx.x; const size_t g = (size_t)b * 2048 + t;
    for (int c = threadIdx.x; c < 1024; c += 256) MIX[(size_t)t * 1024 + c] = (float)X[g * 1024 + c];
}
}

extern "C" void kernel_launch(void* const* d_in, const int* in_sizes, int n_in, void* d_out, int out_size, void* d_ws, size_t ws_size, hipStream_t stream) {
    static int grid = 0;
    if (grid == 0) {
        int dev = 0, cus = 0, per_cu = 0;
        (void)hipGetDevice(&dev); (void)hipDeviceGetAttribute(&cus, hipDeviceAttributeMultiprocessorCount, dev);
        (void)hipFuncSetAttribute((const void*)mk::mega, hipFuncAttributeMaxDynamicSharedMemorySize, mk::LDS_BYTES);
        (void)hipOccupancyMaxActiveBlocksPerMultiprocessor(&per_cu, (const void*)mk::mega, mk::NTHR, mk::LDS_BYTES);
        if (per_cu < 1) { fprintf(stderr, "kernel_launch: occupancy query says %d blocks per CU\n", per_cu); per_cu = 1; }
        grid = cus * 1;
        (void)hipGetLastError();
    }
    unsigned char* mws = (unsigned char*)d_ws;
    if (ws_size < mk::WS_END1) { fprintf(stderr, "kernel_launch: workspace too small (%zu)\n", ws_size); return; }
    (void)hipMemsetAsync(mws + mk::WS_CTL, 0, mk::CTL_BYTES, stream);
    (void)hipMemsetAsync(mws + mk::WS_WIN + (size_t)3648 * 2048, 0, (size_t)192 * 2048, stream);
    (void)hipMemsetAsync(mws + mk::WS_WB, 0, (size_t)1536 * 384 * 2, stream);
    mk::Params P{};
    mk::build_params(P, d_in, d_out, mws, true);
    P.ph_lo = 0; P.ph_hi = mk::PH_END;
    void* args[] = {&P};
    hipError_t e = hipLaunchCooperativeKernel((const void*)mk::mega, dim3(grid), dim3(mk::NTHR), args, mk::LDS_BYTES, stream);
    if (e != hipSuccess) fprintf(stderr, "cooperative launch failed: %s (grid %d)\n", hipGetErrorString(e), grid);
    for (int b = 0; b < nv::NB; ++b) {
        float* out = (float*)d_out + (size_t)b * nv::S_ * nv::D_;
        if (b >= mk::NB) nv::forward_batch(d_in, b, out, (float*)d_ws, stream, 0, 1);
    }
}
```

```cpp
#define MK_NB 8
#define MK_REP_PH (-1)
#include <hip/hip_runtime.h>
#include <cstdint>
#include <cstdio>
#include <cmath>

namespace nv {
constexpr int S_ = 2048, D_ = 1024, NB = 8;
constexpr int MB = S_;

struct ALPlain { const float* A; int lda; int pad; __device__ __forceinline__ float operator()(int m, int k) const { return A[(size_t)m * lda + k]; } };
struct ALShiftMix { const float* H; const float* mu;
    __device__ __forceinline__ float operator()(int m, int k) const { float h = H[(size_t)m * 1024 + k]; float hp = (m % S_) ? H[(size_t)(m - 1) * 1024 + k] : 0.f; return h + (hp - h) * mu[k]; } };
struct ALGather { const float* A; int lda; const int* rows; int div;
    __device__ __forceinline__ float operator()(int m, int k) const { return A[(size_t)(rows[m] / div) * lda + k]; } };

template <class AL, int ACT>
__global__ void __launch_bounds__(256) sgemm(AL al, const float* __restrict__ B, int ldb, float* C, int ldc, const float* Cadd, int ldadd,
                                            int M, const int* Mptr, int N, int K) {
    __shared__ float As[16][68];
    __shared__ float Bs[16][68];
    if (Mptr) M = *Mptr;
    const int m0 = blockIdx.y * 64, n0 = blockIdx.x * 64;
    if (m0 >= M) return;
    const int tid = threadIdx.x, ty = tid / 16, tx = tid % 16;
    float acc[4][4];
#pragma unroll
    for (int i = 0; i < 4; ++i)
#pragma unroll
        for (int j = 0; j < 4; ++j) acc[i][j] = 0.f;
    for (int k0 = 0; k0 < K; k0 += 16) {
#pragma unroll
        for (int i = 0; i < 4; ++i) {
            int idx = tid + i * 256; int m = idx / 16, k = idx % 16;
            As[k][m] = (m0 + m < M) ? al(m0 + m, k0 + k) : 0.f;
            int kb = idx / 64, n = idx % 64;
            Bs[kb][n] = (n0 + n < N) ? B[(size_t)(k0 + kb) * ldb + n0 + n] : 0.f;
        }
        __syncthreads();
#pragma unroll
        for (int k = 0; k < 16; ++k) {
            float a[4], b[4];
#pragma unroll
            for (int i = 0; i < 4; ++i) { a[i] = As[k][ty * 4 + i]; b[i] = Bs[k][tx * 4 + i]; }
#pragma unroll
            for (int i = 0; i < 4; ++i)
#pragma unroll
                for (int j = 0; j < 4; ++j) acc[i][j] = fmaf(a[i], b[j], acc[i][j]);
        }
        __syncthreads();
    }
#pragma unroll
    for (int i = 0; i < 4; ++i)
#pragma unroll
        for (int j = 0; j < 4; ++j) {
            int m = m0 + ty * 4 + i, n = n0 + tx * 4 + j;
            if (m < M && n < N) {
                float v = acc[i][j];
                if (Cadd) v += Cadd[(size_t)m * ldadd + n];
                if (ACT == 1) v = tanhf(v);
                if (ACT == 2) v = 1.f / (1.f + expf(-v));
                C[(size_t)m * ldc + n] = v;
            }
        }
}

__device__ __forceinline__ float block_sum256(float v, float* red) {
    for (int o = 32; o > 0; o >>= 1) v += __shfl_xor(v, o);
    __syncthreads();
    if ((threadIdx.x & 63) == 0) red[threadIdx.x >> 6] = v;
    __syncthreads();
    return red[0] + red[1] + red[2] + red[3];
}

__global__ void __launch_bounds__(256) rmsnorm1024(const float* x, const float* g, float* out, float eps) {
    __shared__ float red[4];
    const size_t row = blockIdx.x; const int t = threadIdx.x;
    float4 v = *(const float4*)(x + row * 1024 + t * 4);
    float ss = block_sum256(v.x * v.x + v.y * v.y + v.z * v.z + v.w * v.w, red);
    float r = rsqrtf(ss * (1.f / 1024.f) + eps);
    float4 gg = *(const float4*)(g + t * 4);
    float4 o; o.x = v.x * r * gg.x; o.y = v.y * r * gg.y; o.z = v.z * r * gg.z; o.w = v.w * r * gg.w;
    *(float4*)(out + row * 1024 + t * 4) = o;
}

__global__ void __launch_bounds__(256) qk_prep(float* Z, const int* pos, const float* qg, const float* kg) {
    const int gw = blockIdx.x * 4 + (threadIdx.x >> 6), lane = threadIdx.x & 63;
    const int row = gw / 16, grp = gw % 16;
    float* p = Z + (size_t)row * 3072 + grp * 64;
    float v = p[lane];
    float ss = v * v;
    for (int o = 32; o > 0; o >>= 1) ss += __shfl_xor(ss, o);
    const float* g = grp < 8 ? qg : kg;
    float y = v * rsqrtf(ss * (1.f / 64.f) + 1e-6f) * g[lane];
    float other = __shfl_xor(y, 32);
    int i = lane & 31;
    float inv_freq = powf(10000.f, -(float)i / 32.f);
    float ang = (float)pos[row] * inv_freq;
    float c = cosf(ang), s = sinf(ang);
    float r = lane < 32 ? (y * c - other * s) : (y * c + other * s);
    p[lane] = r;
}

__global__ void __launch_bounds__(256) attn_naive(const float* Z, float* MIX, const float* lq1, const float* lk1, const float* lq2, const float* lk2, const float* og) {
    const int h = blockIdx.y, q = blockIdx.x * 32 + threadIdx.x / 8, sub = threadIdx.x % 8;
    float d1 = 0.f, d2 = 0.f;
    for (int i = 0; i < 64; ++i) { d1 += lq1[i] * lk1[i]; d2 += lq2[i] * lk2[i]; }
    const float lam = expf(d1) - expf(d2) + 0.2f;
    const float* qp = Z + (size_t)q * 3072 + h * 128;
    float m0 = -INFINITY, m1 = -INFINITY, l0 = 0.f, l1 = 0.f;
    const float scale = 0.125f;
    for (int j = sub; j <= q; j += 8) {
        const float* kp = Z + (size_t)j * 3072 + 512 + h * 128;
        float s0 = 0.f, s1 = 0.f;
        for (int d = 0; d < 64; d += 4) {
            float4 a = *(const float4*)(qp + d), b = *(const float4*)(kp + d);
            s0 += a.x * b.x + a.y * b.y + a.z * b.z + a.w * b.w;
            float4 a1 = *(const float4*)(qp + 64 + d), b1 = *(const float4*)(kp + 64 + d);
            s1 += a1.x * b1.x + a1.y * b1.y + a1.z * b1.z + a1.w * b1.w;
        }
        s0 *= scale; s1 *= scale;
        float n0 = fmaxf(m0, s0); l0 = l0 * expf(m0 - n0) + expf(s0 - n0); m0 = n0;
        float n1 = fmaxf(m1, s1); l1 = l1 * expf(m1 - n1) + expf(s1 - n1); m1 = n1;
    }
    for (int o = 1; o < 8; o <<= 1) {
        float om0 = __shfl_xor(m0, o), ol0 = __shfl_xor(l0, o), om1 = __shfl_xor(m1, o), ol1 = __shfl_xor(l1, o);
        float n0 = fmaxf(m0, om0); l0 = (m0 == -INFINITY ? 0.f : l0 * expf(m0 - n0)) + (om0 == -INFINITY ? 0.f : ol0 * expf(om0 - n0)); m0 = n0;
        float n1 = fmaxf(m1, om1); l1 = (m1 == -INFINITY ? 0.f : l1 * expf(m1 - n1)) + (om1 == -INFINITY ? 0.f : ol1 * expf(om1 - n1)); m1 = n1;
    }
    float o[16];
    for (int d = 0; d < 16; ++d) o[d] = 0.f;
    const int qmax = blockIdx.x * 32 + 31;
    for (int jb = 0; jb <= qmax; jb += 8) {
        const int j = jb + sub;
        float pj = 0.f;
        if (j <= q) {
            const float* kp = Z + (size_t)j * 3072 + 512 + h * 128;
            float s0 = 0.f, s1 = 0.f;
            for (int d = 0; d < 64; d += 4) {
                float4 a = *(const float4*)(qp + d), b = *(const float4*)(kp + d);
                s0 += a.x * b.x + a.y * b.y + a.z * b.z + a.w * b.w;
                float4 a1 = *(const float4*)(qp + 64 + d), b1 = *(const float4*)(kp + 64 + d);
                s1 += a1.x * b1.x + a1.y * b1.y + a1.z * b1.z + a1.w * b1.w;
            }
            pj = expf(s0 * scale - m0) / l0 - lam * expf(s1 * scale - m1) / l1;
        }
        for (int jj = 0; jj < 8; ++jj) {
            float pp = __shfl(pj, (threadIdx.x & 56) | jj);
            if (jb + jj <= qmax) {
                const float* vp = Z + (size_t)(jb + jj) * 3072 + 1024 + h * 128 + sub * 16;
                for (int d = 0; d < 16; ++d) o[d] += pp * vp[d];
            }
        }
    }
    float ss = 0.f;
    for (int d = 0; d < 16; ++d) ss += o[d] * o[d];
    for (int of = 1; of < 8; of <<= 1) ss += __shfl_xor(ss, of);
    float r = rsqrtf(ss * (1.f / 128.f) + 1e-5f) * 0.8f;
    for (int d = 0; d < 16; ++d) MIX[(size_t)q * 1024 + h * 128 + sub * 16 + d] = o[d] * r * og[sub * 16 + d];
}

__global__ void __launch_bounds__(256) rwkv_prep(const float* Z, const float* WL, const float* AL, const float* mu_rkv, const float* w0, const float* a0,
                                                const float* k_k, const float* k_a, float* R, float* W, float* K2, float* V, float* A2, float* B2) {
    const int gw = blockIdx.x * 4 + (threadIdx.x >> 6), lane = threadIdx.x & 63;
    const int row = gw / 8, hd = gw % 8, c = hd * 64 + lane;
    const float* z = Z + (size_t)row * 3072; const float* zp = z - 3072; const bool hp = (row % S_) != 0;
    float zr = z[1536 + c], zk = z[2048 + c], zv = z[2560 + c];
    float pr = hp ? zp[1536 + c] : 0.f, pk = hp ? zp[2048 + c] : 0.f, pv = hp ? zp[2560 + c] : 0.f;
    float r = zr + (pr - zr) * mu_rkv[c], k = zk + (pk - zk) * mu_rkv[512 + c], v = zv + (pv - zv) * mu_rkv[1024 + c];
    float wl = w0[c] + WL[(size_t)row * 512 + c];
    float nx = -wl; float sp = nx > 20.f ? nx : log1pf(expf(nx));
    float decay = expf(-expf(-sp - 0.5f));
    float a = 1.f / (1.f + expf(-(a0[c] + AL[(size_t)row * 512 + c])));
    float kk = k * k_k[c];
    float ss = kk * kk;
    for (int o = 32; o > 0; o >>= 1) ss += __shfl_xor(ss, o);
    kk = kk * rsqrtf(fmaxf(ss, 1e-24f));
    float k2 = k * (1.f + (a - 1.f) * k_a[c]);
    size_t o = (size_t)row * 512 + c;
    R[o] = r; W[o] = decay; K2[o] = k2; V[o] = v; A2[o] = -kk; B2[o] = kk * a;
}

__global__ void __launch_bounds__(64) rwkv_scan_naive(const float* R, const float* W, const float* K2, const float* V, const float* A2, const float* B2, float* Y) {
    __shared__ float sh[5][16][64];
    const int hd = blockIdx.x, lane = threadIdx.x;
    float st[64];
#pragma unroll
    for (int i = 0; i < 64; ++i) st[i] = 0.f;
    for (int t0 = 0; t0 < S_; t0 += 16) {
        __syncthreads();
        for (int i = 0; i < 16; ++i) {
            size_t o = (size_t)(t0 + i) * 512 + hd * 64 + lane;
            sh[0][i][lane] = R[o]; sh[1][i][lane] = W[o]; sh[2][i][lane] = K2[o]; sh[3][i][lane] = A2[o]; sh[4][i][lane] = B2[o];
        }
        __syncthreads();
        for (int i = 0; i < 16; ++i) {
            float v = V[(size_t)(t0 + i) * 512 + hd * 64 + lane];
            float sa = 0.f;
#pragma unroll
            for (int k = 0; k < 64; ++k) sa = fmaf(st[k], sh[3][i][k], sa);
            float y = 0.f;
#pragma unroll
            for (int k = 0; k < 64; ++k) { st[k] = st[k] * sh[1][i][k] + sa * sh[4][i][k] + v * sh[2][i][k]; y = fmaf(st[k], sh[0][i][k], y); }
            Y[(size_t)(t0 + i) * 512 + hd * 64 + lane] = y;
        }
    }
}

__global__ void __launch_bounds__(256) rwkv_post(const float* Y, const float* R, const float* K2, const float* V, const float* G, const float* r_k, const float* gn_w, const float* gn_b, float* MIX) {
    const int gw = blockIdx.x * 4 + (threadIdx.x >> 6), lane = threadIdx.x & 63;
    const int row = gw / 8, hd = gw % 8, c = hd * 64 + lane; const size_t o = (size_t)row * 512 + c;
    float y = Y[o];
    float s = y; for (int of = 32; of > 0; of >>= 1) s += __shfl_xor(s, of);
    float mu = s * (1.f / 64.f); float d = y - mu; float q = d * d; for (int of = 32; of > 0; of >>= 1) q += __shfl_xor(q, of);
    float yn = d * rsqrtf(q * (1.f / 64.f) + 64e-5f) * gn_w[c] + gn_b[c];
    float b = R[o] * K2[o] * r_k[c]; for (int of = 32; of > 0; of >>= 1) b += __shfl_xor(b, of);
    MIX[(size_t)row * 1024 + 512 + c] = (yn + b * V[o]) * G[o];
}

__global__ void __launch_bounds__(256) route(const float* LOG, int* cnt, int* list, float* wts, int M, int cap) {
    const int t = blockIdx.x * 256 + threadIdx.x; if (t >= M) return;
    const float* l = LOG + (size_t)t * 36;
    int gs = 0; float gm = l[0];
    for (int i = 1; i < 4; ++i) if (l[i] > gm) { gm = l[i]; gs = i; }
    float den = 0.f; for (int i = 0; i < 4; ++i) den += expf(l[i] - gm);
    float gw = 1.f / den;
    const float* e = l + 4 + 8 * gs;
    int i0 = 0; float v0 = e[0];
    for (int i = 1; i < 8; ++i) if (e[i] > v0) { v0 = e[i]; i0 = i; }
    int i1 = -1; float v1 = -INFINITY;
    for (int i = 0; i < 8; ++i) if (i != i0 && e[i] > v1) { v1 = e[i]; i1 = i; }
    float p1 = expf(v1 - v0); float w0 = gw / (1.f + p1), w1 = gw * p1 / (1.f + p1);
    wts[t * 2] = w0; wts[t * 2 + 1] = w1;
    int e0 = gs * 8 + i0, e1 = gs * 8 + i1;
    int p = atomicAdd(&cnt[e0], 1); list[e0 * cap + p] = t * 2;
    p = atomicAdd(&cnt[e1], 1); list[e1 * cap + p] = t * 2 + 1;
}

__global__ void __launch_bounds__(256) expert_up(const float* H2, const float* Wg, const float* Wu, const int* cnt, const int* list, float* HID, int cap) {
    __shared__ float As[16][68];
    __shared__ float Bg[16][68];
    __shared__ float Bu[16][68];
    const int e = blockIdx.z, M = cnt[e], m0 = blockIdx.y * 64, n0 = blockIdx.x * 64;
    if (m0 >= M) return;
    const int* rows = list + e * cap;
    const float* wg = Wg + (size_t)e * 1024 * 512; const float* wu = Wu + (size_t)e * 1024 * 512;
    const int tid = threadIdx.x, ty = tid / 16, tx = tid % 16;
    float ag[4][4], au[4][4];
    for (int i = 0; i < 4; ++i) for (int j = 0; j < 4; ++j) { ag[i][j] = 0.f; au[i][j] = 0.f; }
    for (int k0 = 0; k0 < 1024; k0 += 16) {
        for (int i = 0; i < 4; ++i) {
            int idx = tid + i * 256; int m = idx / 16, k = idx % 16;
            As[k][m] = (m0 + m < M) ? H2[(size_t)(rows[m0 + m] / 2) * 1024 + k0 + k] : 0.f;
            int kb = idx / 64, n = idx % 64;
            Bg[kb][n] = wg[(size_t)(k0 + kb) * 512 + n0 + n]; Bu[kb][n] = wu[(size_t)(k0 + kb) * 512 + n0 + n];
        }
        __syncthreads();
        for (int k = 0; k < 16; ++k) {
            float a[4], b[4], c[4];
            for (int i = 0; i < 4; ++i) { a[i] = As[k][ty * 4 + i]; b[i] = Bg[k][tx * 4 + i]; c[i] = Bu[k][tx * 4 + i]; }
            for (int i = 0; i < 4; ++i) for (int j = 0; j < 4; ++j) { ag[i][j] = fmaf(a[i], b[j], ag[i][j]); au[i][j] = fmaf(a[i], c[j], au[i][j]); }
        }
        __syncthreads();
    }
    for (int i = 0; i < 4; ++i) for (int j = 0; j < 4; ++j) {
        int m = m0 + ty * 4 + i, n = n0 + tx * 4 + j;
        if (m < M) { float g = ag[i][j]; HID[(size_t)rows[m] * 512 + n] = g / (1.f + expf(-g)) * au[i][j]; }
    }
}
__global__ void __launch_bounds__(256) expert_down(const float* HID, const float* Wd, const int* cnt, const int* list, float* YE, int cap) {
    __shared__ float As[16][68];
    __shared__ float Bs[16][68];
    const int e = blockIdx.z, M = cnt[e], m0 = blockIdx.y * 64, n0 = blockIdx.x * 64;
    if (m0 >= M) return;
    const int* rows = list + e * cap;
    const float* wd = Wd + (size_t)e * 512 * 1024;
    const int tid = threadIdx.x, ty = tid / 16, tx = tid % 16;
    float acc[4][4];
    for (int i = 0; i < 4; ++i) for (int j = 0; j < 4; ++j) acc[i][j] = 0.f;
    for (int k0 = 0; k0 < 512; k0 += 16) {
        for (int i = 0; i < 4; ++i) {
            int idx = tid + i * 256; int m = idx / 16, k = idx % 16;
            As[k][m] = (m0 + m < M) ? HID[(size_t)rows[m0 + m] * 512 + k0 + k] : 0.f;
            int kb = idx / 64, n = idx % 64;
            Bs[kb][n] = wd[(size_t)(k0 + kb) * 1024 + n0 + n];
        }
        __syncthreads();
        for (int k = 0; k < 16; ++k) {
            float a[4], b[4];
            for (int i = 0; i < 4; ++i) { a[i] = As[k][ty * 4 + i]; b[i] = Bs[k][tx * 4 + i]; }
            for (int i = 0; i < 4; ++i) for (int j = 0; j < 4; ++j) acc[i][j] = fmaf(a[i], b[j], acc[i][j]);
        }
        __syncthreads();
    }
    for (int i = 0; i < 4; ++i) for (int j = 0; j < 4; ++j) {
        int m = m0 + ty * 4 + i, n = n0 + tx * 4 + j;
        if (m < M) YE[(size_t)rows[m] * 1024 + n] = acc[i][j];
    }
}
__global__ void __launch_bounds__(256) moe_combine(const float* X1, const float* YE, const float* wts, float* X2) {
    const size_t t = blockIdx.x; const int c = threadIdx.x * 4;
    float4 x = *(const float4*)(X1 + t * 1024 + c), a = *(const float4*)(YE + (2 * t) * 1024 + c), b = *(const float4*)(YE + (2 * t + 1) * 1024 + c);
    float w0 = wts[2 * t], w1 = wts[2 * t + 1];
    float4 o; o.x = x.x + w0 * a.x + w1 * b.x; o.y = x.y + w0 * a.y + w1 * b.y; o.z = x.z + w0 * a.z + w1 * b.z; o.w = x.w + w0 * a.w + w1 * b.w;
    *(float4*)(X2 + t * 1024 + c) = o;
}
__global__ void __launch_bounds__(256) final_pl(const float* X2, const float* PE, const float* GATE, const float* g, float* out) {
    __shared__ float red[4];
    const size_t row = blockIdx.x; const int t = threadIdx.x;
    float4 v = *(const float4*)(PE + row * 1024 + t * 4);
    float ss = block_sum256(v.x * v.x + v.y * v.y + v.z * v.z + v.w * v.w, red);
    float r = rsqrtf(ss * (1.f / 1024.f) + 1e-6f);
    float4 gg = *(const float4*)(g + t * 4), x = *(const float4*)(X2 + row * 1024 + t * 4), ga = *(const float4*)(GATE + row * 1024 + t * 4);
    float4 o;
    o.x = x.x + v.x * r * gg.x / (1.f + expf(-ga.x)); o.y = x.y + v.y * r * gg.y / (1.f + expf(-ga.y));
    o.z = x.z + v.z * r * gg.z / (1.f + expf(-ga.z)); o.w = x.w + v.w * r * gg.w / (1.f + expf(-ga.w));
    *(float4*)(out + row * 1024 + t * 4) = o;
}

template <class AL, int ACT>
static void gemm(hipStream_t st, AL al, const float* B, int ldb, float* C, int ldc, const float* Cadd, int ldadd, int M, int N, int K) {
    dim3 grid((N + 63) / 64, (M + 63) / 64);
    sgemm<AL, ACT><<<grid, 256, 0, st>>>(al, B, ldb, C, ldc, Cadd, ldadd, M, nullptr, N, K);
}

struct NBufs { float *Z, *L1, *L2, *L3, *PE, *MIX, *Y, *X1; };
static NBufs forward_batch(void* const* d_in, int b, float* out, float* ws, hipStream_t st, int mode, int part) {
    auto F = [&](int i) { return (const float*)d_in[i]; };
    const float* x = F(0) + (size_t)b * S_ * D_; const float* p = F(1) + (size_t)b * S_ * 256; const int* pos = (const int*)d_in[2] + b * S_;
    size_t o = 0; auto take = [&](size_t n) { float* r = ws + o; o += (n + 63) / 64 * 64; return r; };
    float* HN = take((size_t)MB * 1024); float* Z = take((size_t)MB * 3072); float* MIX = take((size_t)MB * 1024);
    float* L1 = take((size_t)MB * 64); float* L2 = take((size_t)MB * 64); float* L3 = take((size_t)MB * 160);
    float* WL = take((size_t)MB * 512); float* AL = take((size_t)MB * 512); float* G = take((size_t)MB * 512);
    float* R = take((size_t)MB * 512); float* W = take((size_t)MB * 512); float* K2 = take((size_t)MB * 512); float* V = take((size_t)MB * 512);
    float* A2 = take((size_t)MB * 512); float* B2 = take((size_t)MB * 512); float* Y = take((size_t)MB * 512);
    float* X1 = take((size_t)MB * 1024); float* H2 = take((size_t)MB * 1024); float* LOG = take((size_t)MB * 36);
    float* wts = take((size_t)MB * 2); int* cnt = (int*)take(64); int* list = (int*)take((size_t)32 * MB);
    float* HID = take((size_t)MB * 2 * 512); float* YE = take((size_t)MB * 2 * 1024); float* X2 = take((size_t)MB * 1024);
    float* PE = take((size_t)MB * 1024); float* GATE = take((size_t)MB * 1024);

    NBufs nb{Z, L1, L2, L3, PE, MIX, Y, X1};
    if (part == 0) return nb;
    if (mode == 0) {
    rmsnorm1024<<<MB, 256, 0, st>>>(x, F(3), HN, 1e-6f);
    gemm<ALPlain, 0>(st, ALPlain{HN, 1024, 0}, F(4), 3072, Z, 3072, nullptr, 0, MB, 3072, 1024);
    gemm<ALShiftMix, 1>(st, ALShiftMix{HN, F(13)}, F(15), 64, L1, 64, nullptr, 0, MB, 64, 1024);
    gemm<ALShiftMix, 0>(st, ALShiftMix{HN, F(13) + 1024}, F(18), 64, L2, 64, nullptr, 0, MB, 64, 1024);
    gemm<ALShiftMix, 2>(st, ALShiftMix{HN, F(13) + 2048}, F(20), 160, L3, 160, nullptr, 0, MB, 160, 1024);
    }
    if (mode < 3) {
    gemm<ALPlain, 0>(st, ALPlain{L1, 64, 0}, F(16), 512, WL, 512, nullptr, 0, MB, 512, 64);
    gemm<ALPlain, 0>(st, ALPlain{L2, 64, 0}, F(19), 512, AL, 512, nullptr, 0, MB, 512, 64);
    gemm<ALPlain, 0>(st, ALPlain{L3, 160, 0}, F(21), 512, G, 512, nullptr, 0, MB, 512, 160);
    rwkv_prep<<<MB * 8 / 4, 256, 0, st>>>(Z, WL, AL, F(12), F(14), F(17), F(22), F(23), R, W, K2, V, A2, B2);
    rwkv_scan_naive<<<8, 64, 0, st>>>(R, W, K2, V, A2, B2, Y);
    rwkv_post<<<MB * 8 / 4, 256, 0, st>>>(Y, R, K2, V, G, F(24), F(25), F(26), MIX);
    }
    if (mode == 0) qk_prep<<<MB * 16 / 4, 256, 0, st>>>(Z, pos, F(5), F(6));
    if (mode < 2) attn_naive<<<dim3(S_ / 32, 4), 256, 0, st>>>(Z, MIX, F(7), F(8), F(9), F(10), F(11));
    gemm<ALPlain, 0>(st, ALPlain{MIX, 1024, 0}, F(27), 1024, X1, 1024, x, 1024, MB, 1024, 1024);
    rmsnorm1024<<<MB, 256, 0, st>>>(X1, F(28), H2, 1e-6f);
    gemm<ALPlain, 0>(st, ALPlain{H2, 1024, 0}, F(29), 4, LOG, 36, nullptr, 0, MB, 4, 1024);
    for (int g = 0; g < 4; ++g) gemm<ALPlain, 0>(st, ALPlain{H2, 1024, 0}, F(30) + (size_t)g * 1024 * 8, 8, LOG + 4 + 8 * g, 36, nullptr, 0, MB, 8, 1024);
    hipMemsetAsync(cnt, 0, 64 * sizeof(int), st);
    route<<<MB / 256, 256, 0, st>>>(LOG, cnt, list, wts, MB, MB);
    expert_up<<<dim3(512 / 64, MB / 64, 32), 256, 0, st>>>(H2, F(31), F(32), cnt, list, HID, MB);
    expert_down<<<dim3(1024 / 64, MB / 64, 32), 256, 0, st>>>(HID, F(33), cnt, list, YE, MB);
    moe_combine<<<MB, 256, 0, st>>>(X1, YE, wts, X2);
    rmsnorm1024<<<MB, 256, 0, st>>>(X2, F(36), H2, 1e-6f);
    gemm<ALPlain, 0>(st, ALPlain{H2, 1024, 0}, F(37), 1024, GATE, 1024, nullptr, 0, MB, 1024, 1024);
    if (mode == 0) gemm<ALPlain, 0>(st, ALPlain{p, 256, 0}, F(34), 1024, PE, 1024, nullptr, 0, MB, 1024, 256);
    final_pl<<<MB, 256, 0, st>>>(X2, PE, GATE, F(35), out);
    return nb;
}
}

namespace mk {
#define LAS __attribute__((address_space(3)))
#define GAS __attribute__((address_space(1)))
typedef _Float16 f16;
typedef _Float16 h8 __attribute__((ext_vector_type(8)));
typedef _Float16 h4 __attribute__((ext_vector_type(4)));
typedef _Float16 h2 __attribute__((ext_vector_type(2)));
typedef float f32x4 __attribute__((ext_vector_type(4)));
typedef float f32x2 __attribute__((ext_vector_type(2)));
typedef float f32x16 __attribute__((ext_vector_type(16)));
typedef unsigned u32x4 __attribute__((ext_vector_type(4)));
typedef unsigned u32x2 __attribute__((ext_vector_type(2)));

constexpr int NB = MK_NB;
constexpr int SEQ = 2048, DM = 1024;
constexpr int M = NB * SEQ;
constexpr int BM = 256, BK = 64, HALF = 128, HTB = HALF * BK * 2, STAGE_BYTES = 8 * HTB, NXCD = 8, WGM = 8;
constexpr int NWAVES = 8, NTHR = 512;
constexpr float C2 = 0.125f * 1.4426950408889634f;

__device__ __forceinline__ unsigned pkh(float lo, float hi) { h2 v = {(f16)lo, (f16)hi}; return __builtin_bit_cast(unsigned, v); }

__host__ __device__ __forceinline__ int lds_byte(int r, int c) { const int st = (r >> 4) * 2 + (c >> 5), rr = r & 15, cc = c & 31, ob = rr * 64 + cc * 2; return st * 1024 + (ob ^ (((ob >> 9) & 1) << 5)); }
__host__ __device__ __forceinline__ void stage_rc(int b, int& R, int& C) { const int st = b / 1024, sb = b % 1024, swz = sb ^ (((sb >> 9) & 1) << 5); R = (st >> 1) * 16 + swz / 64; C = (st & 1) * 32 + (swz % 64) / 2; }
__host__ __device__ __forceinline__ int perm32(int rho) { const int n = rho >> 4, i = rho & 15; return 8 * (i >> 2) + 4 * n + (i & 3); }

struct GU { const char* a; const char* b; char* o; const int* glist; const int* elist; int nt, lda2, ldb2, hsa, hsb, bmode, epi, pm, pn, aux, ldc, oc0, gcnt; };

template <class Sched, class Epi>
__device__ __forceinline__ void gemm_phase(LAS unsigned char* lds, const Sched& S, const Epi& E, const int tid) {
    const int wid = __builtin_amdgcn_readfirstlane(tid >> 6), lane = tid & 63, wr = wid >> 2, wc = wid & 3, fr = lane & 15, fq = lane >> 4;
    unsigned voffA[2], voffAh[2], voffB[2]; int hsB;
#define MK_SETV(u) do { int ln_; asm volatile("v_mbcnt_lo_u32_b32 %0, -1, 0\n\tv_mbcnt_hi_u32_b32 %0, -1, %0" : "=v"(ln_)); const int t16_ = (wid * 64 + ln_) * 16; \
        int R0, C0, R1, C1; stage_rc(t16_, R0, C0); stage_rc(t16_ + 8192, R1, C1); \
        if ((u).glist) { \
            const int g00 = R0 < (u).gcnt ? (u).glist[R0] >> 1 : 0, g01 = R1 < (u).gcnt ? (u).glist[R1] >> 1 : 0, g10 = R0 + 128 < (u).gcnt ? (u).glist[R0 + 128] >> 1 : 0, g11 = R1 + 128 < (u).gcnt ? (u).glist[R1 + 128] >> 1 : 0; \
            voffA[0] = (unsigned)(g00 * (u).lda2 + C0 * 2); voffA[1] = (unsigned)(g01 * (u).lda2 + C1 * 2); voffAh[0] = (unsigned)(g10 * (u).lda2 + C0 * 2); voffAh[1] = (unsigned)(g11 * (u).lda2 + C1 * 2); \
        } else { voffA[0] = (unsigned)(R0 * (u).lda2 + C0 * 2); voffA[1] = (unsigned)(R1 * (u).lda2 + C1 * 2); voffAh[0] = voffA[0] + (unsigned)(u).hsa; voffAh[1] = voffA[1] + (unsigned)(u).hsa; } \
        const int rb0 = (u).bmode == 0 ? R0 : (u).bmode == 1 ? ((R0 & ~31) + perm32(R0 & 31)) : (64 * ((R0 >> 5) & 3) + perm32(R0 & 31)); \
        const int rb1 = (u).bmode == 0 ? R1 : (u).bmode == 1 ? ((R1 & ~31) + perm32(R1 & 31)) : (64 * ((R1 >> 5) & 3) + perm32(R1 & 31)); \
        voffB[0] = (unsigned)(rb0 * (u).ldb2 + C0 * 2); voffB[1] = (unsigned)(rb1 * (u).ldb2 + C1 * 2); hsB = (u).hsb; } while (0)
    const size_t kstep = (size_t)(BK * 2);
    const unsigned ldsw = (unsigned)wid * 1024u;
    const int aoff = lds_byte(wr * 64 + fr, fq * 8), boff = lds_byte(wc * 32 + fr, fq * 8);
#define MK_SA(b, h) (((b) * 2 + (h)) * HTB)
#define MK_SB(b, h) ((4 + (b) * 2 + (h)) * HTB)
#define MK_STAGE(bufoff, gbase, voff) do { _Pragma("unroll") for (int _i = 0; _i < 2; ++_i) \
        __builtin_amdgcn_global_load_lds((const unsigned*)((const char*)(gbase) + (voff)[_i]), (LAS unsigned*)(lds + (bufoff) + ldsw + _i * 8192), 16, 0, 0); } while (0)
#define MK_LDA(dst, b, h) do { _Pragma("unroll") for (int m = 0; m < 4; ++m) _Pragma("unroll") for (int k = 0; k < 2; ++k) dst[m][k] = *(const LAS h8*)(lds + MK_SA(b, h) + aoff + m * 2048 + k * 1024); } while (0)
#define MK_LDB(dst, b, h) do { _Pragma("unroll") for (int n = 0; n < 2; ++n) _Pragma("unroll") for (int k = 0; k < 2; ++k) dst[n][k] = *(const LAS h8*)(lds + MK_SB(b, h) + boff + n * 2048 + k * 1024); } while (0)
#define MK_MMA(ai, bj, At, Bt) do { __builtin_amdgcn_s_setprio(1); _Pragma("unroll") for (int m = 0; m < 4; ++m) _Pragma("unroll") for (int n = 0; n < 2; ++n) _Pragma("unroll") for (int k = 0; k < 2; ++k) \
        acc[ai][bj][m][n] = __builtin_amdgcn_mfma_f32_16x16x32_f16(Bt[n][k], At[m][k], acc[ai][bj][m][n], 0, 0, 0); __builtin_amdgcn_s_setprio(0); } while (0)
#define MK_WAIT_V(n) asm volatile("s_waitcnt vmcnt(" #n ")" ::: "memory")
#define MK_WAIT_L(n) asm volatile("s_waitcnt lgkmcnt(" #n ")" ::: "memory")
#define MK_BAR __builtin_amdgcn_s_barrier()
#define MK_SCHED __builtin_amdgcn_sched_barrier(0)
    GU cur, nxt; int ui = 0;
    if (!S.next(0, cur)) return;
    f32x4 acc[2][2][4][2];
#pragma unroll
    for (int a = 0; a < 2; ++a)
#pragma unroll
        for (int b = 0; b < 2; ++b)
#pragma unroll
            for (int m = 0; m < 4; ++m)
#pragma unroll
                for (int n = 0; n < 2; ++n) acc[a][b][m][n] = (f32x4){0.f, 0.f, 0.f, 0.f};
    h8 At[4][2], B0[2][2], B1[2][2];
    const char* cA = cur.a; const char* cB = cur.b;
    MK_SETV(cur);
    MK_STAGE(MK_SB(0, 0), cB, voffB); MK_STAGE(MK_SB(0, 1), cB + hsB, voffB); MK_STAGE(MK_SA(0, 0), cA, voffA); MK_STAGE(MK_SA(0, 1), cA, voffAh);
    if (wr == 1) MK_BAR;
    MK_WAIT_V(2); MK_BAR;
    MK_STAGE(MK_SB(1, 0), cB + kstep, voffB); MK_STAGE(MK_SA(1, 0), cA + kstep, voffA); MK_STAGE(MK_SB(1, 1), cB + hsB + kstep, voffB);
    MK_WAIT_V(6); MK_BAR;
    for (;;) {
        bool has_next = false; const char* nA = cA; const char* nB = cB;
        const int nt = cur.nt;
        for (int t = 0; t < nt; t += 2) {
            const bool last = (t == nt - 2);
            if (last) { has_next = S.next(ui + 1, nxt); if (has_next) { nA = nxt.a; nB = nxt.b; } }
            const char* a1 = cA + (size_t)(t + 1) * kstep;
            const char* a2 = last ? nA : cA + (size_t)(t + 2) * kstep; const char* b2 = last ? nB : cB + (size_t)(t + 2) * kstep;
            const char* a3 = a2 + kstep; const char* b3 = b2 + kstep;
            MK_LDB(B0, 0, 0); MK_LDB(B1, 0, 1); MK_SCHED; MK_LDA(At, 0, 0); MK_STAGE(MK_SA(1, 1), a1, voffAh);
            if (last && has_next) { MK_SETV(nxt); }
            MK_WAIT_V(8); MK_WAIT_L(0); MK_BAR; MK_MMA(0, 0, At, B0); MK_MMA(0, 1, At, B1); MK_BAR; MK_SCHED;
            MK_LDA(At, 0, 1); MK_STAGE(MK_SB(0, 0), b2, voffB); MK_STAGE(MK_SB(0, 1), b2 + hsB, voffB); MK_STAGE(MK_SA(0, 0), a2, voffA);
            MK_WAIT_V(8); MK_WAIT_L(0); MK_BAR; MK_MMA(1, 0, At, B0); MK_MMA(1, 1, At, B1); MK_BAR; MK_SCHED;
            MK_LDB(B0, 1, 0); MK_LDB(B1, 1, 1); MK_SCHED; MK_LDA(At, 1, 0); MK_STAGE(MK_SA(0, 1), a2, voffAh);
            MK_WAIT_V(8); MK_WAIT_L(0); MK_BAR; MK_MMA(0, 0, At, B0); MK_MMA(0, 1, At, B1); MK_BAR; MK_SCHED;
            MK_LDA(At, 1, 1); MK_STAGE(MK_SB(1, 0), b3, voffB); MK_STAGE(MK_SB(1, 1), b3 + hsB, voffB); MK_STAGE(MK_SA(1, 0), a3, voffA);
            MK_WAIT_V(8); MK_WAIT_L(0); MK_BAR; MK_MMA(1, 0, At, B0); MK_MMA(1, 1, At, B1); MK_BAR; MK_SCHED;
        }
        if (wr == 0) MK_BAR;
        E(acc, cur, wr, wc, fr, fq);
        if (!has_next) break;
#pragma unroll
        for (int a = 0; a < 2; ++a)
#pragma unroll
            for (int b = 0; b < 2; ++b)
#pragma unroll
                for (int m = 0; m < 4; ++m)
#pragma unroll
                    for (int n = 0; n < 2; ++n) acc[a][b][m][n] = (f32x4){0.f, 0.f, 0.f, 0.f};
        cur = nxt; cA = nA; cB = nB; ++ui;
        if (wr == 1) MK_BAR;
    }
    MK_WAIT_V(0);
    MK_BAR;
#undef MK_SETV
#undef MK_SA
#undef MK_SB
#undef MK_STAGE
#undef MK_LDA
#undef MK_LDB
#undef MK_MMA
#undef MK_WAIT_V
#undef MK_WAIT_L
#undef MK_BAR
#undef MK_SCHED
}
}
namespace attn_body {
using mk::h8; using mk::f16;
using bf16=_Float16;
using bf16x8=mk::h8;
using s16x4=__attribute__((ext_vector_type(4)))short; using s16x8=__attribute__((ext_vector_type(8)))short;
using f32x16=__attribute__((ext_vector_type(16)))float;
using u32x4=__attribute__((ext_vector_type(4)))unsigned;
constexpr int BATCH=MK_NB,NHEAD=16,SEQ=2048,D=64,DM=1024; constexpr int QKP=512,VP=512,OP=1024;
constexpr int NW=8,QBLK=32,QB=QBLK*NW,KVBLK=64,NQB=SEQ/QB;
constexpr int ATTN_PITCH=DM, ATTN_UNIT_ROWS=QB;
__device__ __forceinline__ int crow(int r,int hi){return (r&3)+8*(r>>2)+4*hi;}
#define SBAR() __builtin_amdgcn_sched_barrier(0)
__device__ __forceinline__ void cmask(f32x16&p0,f32x16&p1,int jb,int qrel,int hi){
  const float NEG=-INFINITY; int kb=64*jb+4*hi;
  #pragma unroll
  for(int r=0;r<16;++r){int kv=kb+(r&3)+8*(r>>2); if(kv>qrel)p0[r]=NEG; if(kv+32>qrel)p1[r]=NEG;}
}

constexpr int NSLOT=3, SLOTB=8192;
constexpr int LDS_K=0, LDS_V=NSLOT*SLOTB, LDS_WS=2*NSLOT*SLOTB, LDS_OST=LDS_WS+NW*64*4, LDS_BYTES=LDS_OST+NW*4096;
constexpr float C2=0.125f*1.4426950408889634f;
__device__ __forceinline__ void glds16(const void*gsrc,unsigned lds_dst){unsigned keep;
  asm volatile("s_mov_b32 %0, m0\n\ts_mov_b32 m0, %2\n\ts_nop 0\n\tglobal_load_lds_dwordx4 %1, off\n\ts_mov_b32 m0, %0":"=&s"(keep):"v"(gsrc),"s"(lds_dst):"memory");}
__device__ __forceinline__ float max3f(float a,float b,float c){float r;asm("v_max3_f32 %0, %1, %2, %3":"=v"(r):"v"(a),"v"(b),"v"(c));return r;}
__device__ __forceinline__ float max2f(float a,float b){float r;asm("v_max_f32_e32 %0, %1, %2":"=v"(r):"v"(a),"v"(b));return r;}
__device__ __forceinline__ float fadd_s(float a,float b){float r;asm("v_add_f32_e32 %0, %1, %2":"=v"(r):"v"(a),"v"(b));return r;}
__device__ __forceinline__ float fsub_s(float a,float b){float r;asm("v_sub_f32_e32 %0, %1, %2":"=v"(r):"v"(a),"v"(b));return r;}
typedef float f32x2_t __attribute__((ext_vector_type(2))); typedef _Float16 bf16x2_t __attribute__((ext_vector_type(2)));
__device__ __forceinline__ unsigned cvtpk_s(float lo,float hi){f32x2_t v={lo,hi};bf16x2_t b=__builtin_convertvector(v,bf16x2_t);return __builtin_bit_cast(unsigned,b);}
#define WAIT_BAR(N) asm volatile("s_waitcnt vmcnt(" #N ") lgkmcnt(0)\n\ts_barrier":::"memory")

__device__ __forceinline__ void qkt(f32x16&p0,f32x16&p1,const char*Kslot,const bf16x8*qr,const f32x16&negm,int r32,int hi){
  const char*kb=Kslot+hi*1024+r32*16;
  #pragma unroll
  for(int d0=0;d0<4;++d0){
    const bf16x8 b0=*reinterpret_cast<const bf16x8*>(kb+d0*2048);
    const bf16x8 b1=*reinterpret_cast<const bf16x8*>(kb+d0*2048+512);
    if(d0==0){p0=__builtin_amdgcn_mfma_f32_32x32x16_f16(b0,qr[0],negm,0,0,0);p1=__builtin_amdgcn_mfma_f32_32x32x16_f16(b1,qr[0],negm,0,0,0);}
    else{p0=__builtin_amdgcn_mfma_f32_32x32x16_f16(b0,qr[d0],p0,0,0,0);p1=__builtin_amdgcn_mfma_f32_32x32x16_f16(b1,qr[d0],p1,0,0,0);}}
}
typedef __attribute__((address_space(3))) const char* lds_cptr;
typedef short v4i16_t __attribute__((ext_vector_type(4)));
__device__ __forceinline__ void kload8(bf16x8*kf,lds_cptr kp){
  kf[0]=*(const __attribute__((address_space(3))) bf16x8*)(kp);      kf[1]=*(const __attribute__((address_space(3))) bf16x8*)(kp+512);
  kf[2]=*(const __attribute__((address_space(3))) bf16x8*)(kp+2048); kf[3]=*(const __attribute__((address_space(3))) bf16x8*)(kp+2560);
  kf[4]=*(const __attribute__((address_space(3))) bf16x8*)(kp+4096); kf[5]=*(const __attribute__((address_space(3))) bf16x8*)(kp+4608);
  kf[6]=*(const __attribute__((address_space(3))) bf16x8*)(kp+6144); kf[7]=*(const __attribute__((address_space(3))) bf16x8*)(kp+6656);
}
__device__ __forceinline__ void kload2(bf16x8*kf,lds_cptr kp,int j){ kf[2*j]=*(const __attribute__((address_space(3))) bf16x8*)(kp+j*2048); kf[2*j+1]=*(const __attribute__((address_space(3))) bf16x8*)(kp+j*2048+512); }
__device__ __forceinline__ s16x4 vtr(lds_cptr p){ return __builtin_bit_cast(s16x4,__builtin_amdgcn_ds_read_tr16_b64_v4i16((__attribute__((address_space(3))) v4i16_t*)p)); }
__device__ __forceinline__ float rowmax(const f32x16&p0,const f32x16&p1){
  float a=max3f(p0[0],p0[1],p1[0]),b=max3f(p0[2],p0[3],p1[1]);a=max3f(a,p1[2],p1[3]);
  #pragma unroll
  for(int r=4;r<16;r+=4){a=max3f(a,p0[r],p0[r+1]);b=max3f(b,p0[r+2],p0[r+3]);a=max3f(a,p1[r],p1[r+1]);b=max3f(b,p1[r+2],p1[r+3]);}
  const float m=max2f(a,b);
  auto rr=__builtin_amdgcn_permlane32_swap(__float_as_uint(m),__float_as_uint(m),false,false);
  return max2f(__uint_as_float(rr[0]),__uint_as_float(rr[1]));
}
__device__ __forceinline__ void pv(f32x16*o,int vb,bf16x8 pa0,bf16x8 pa1,bf16x8 pa2,bf16x8 pa3){
  #pragma unroll
  for(int d0=0;d0<2;++d0){s16x4 lo[4],hi[4];
    #pragma unroll
    for(int ks=0;ks<4;++ks){
      asm volatile("ds_read_b64_tr_b16 %0,%1 offset:%c2":"=&v"(lo[ks]):"v"(vb),"i"(d0*4096+ks*1024):"memory");
      asm volatile("ds_read_b64_tr_b16 %0,%1 offset:%c2":"=&v"(hi[ks]):"v"(vb),"i"(d0*4096+ks*1024+512):"memory");}
    asm volatile("s_waitcnt lgkmcnt(0)":::"memory");SBAR();
    #define PK(k) __builtin_bit_cast(bf16x8,(s16x8){lo[k][0],lo[k][1],lo[k][2],lo[k][3],hi[k][0],hi[k][1],hi[k][2],hi[k][3]})
    o[d0]=__builtin_amdgcn_mfma_f32_32x32x16_f16(pa0,PK(0),o[d0],0,0,0);
    o[d0]=__builtin_amdgcn_mfma_f32_32x32x16_f16(pa1,PK(1),o[d0],0,0,0);
    o[d0]=__builtin_amdgcn_mfma_f32_32x32x16_f16(pa2,PK(2),o[d0],0,0,0);
    o[d0]=__builtin_amdgcn_mfma_f32_32x32x16_f16(pa3,PK(3),o[d0],0,0,0);
    #undef PK
  }
}

#ifndef ATTN_STORE16
#define ATTN_STORE16(p,v) (*(u32x4*)(p)=(v))
#endif
template<int THRL> __device__ __forceinline__ void attn_unit(int b,int vh,int qb,const bf16*Q,const bf16*__restrict__ K,const bf16*__restrict__ V,bf16*O,char*shm,const int wave_s){
  int tid; asm volatile("v_mbcnt_lo_u32_b32 %0, -1, 0\n\tv_mbcnt_hi_u32_b32 %0, -1, %0" : "=v"(tid)); tid+=wave_s*64;
  const int hh=vh>>2,mp=(vh>>1)&1,vhf=vh&1; const int qcol=hh*128+mp*64, vcol=hh*128+vhf*64, ocol=mp*512+hh*128+vhf*64;
  const int lane=tid&63,r32=lane&31,hi=lane>>5; const int wid=__builtin_amdgcn_readfirstlane(tid>>6);
  const long rowbase=(long)b*SEQ; const int q0=qb*QB;
  const bf16*Qw=Q+(rowbase+q0+wid*QBLK)*QKP+qcol;
  const bf16*Kh=K+rowbase*QKP+qcol,*Vh=V+rowbase*VP+vcol;
  const unsigned lds0=(unsigned)(uintptr_t)shm;
  float*wsf=(float*)(shm+LDS_WS)+wid*64;
  const bf16*ksrc=Kh+(long)lane*QKP+wid*8;
  const bf16*vsrc=Vh+(long)(16*(wid&3)+(lane>>2))*VP+(wid>>2)*32+(lane&3)*8;
  const unsigned kdst=lds0+LDS_K+wid*1024, vdst=lds0+LDS_V+wid*1024;
  #define DMA_K(t,slot) glds16(ksrc+(long)(t)*KVBLK*QKP,(unsigned)__builtin_amdgcn_readfirstlane(kdst+(slot)))
  #define DMA_V(t,slot) glds16(vsrc+(long)(t)*KVBLK*VP,(unsigned)__builtin_amdgcn_readfirstlane(vdst+(slot)))
  const int vb0=(int)(lds0+LDS_V)+((lane>>4)&1)*32+(lane&3)*8+(4*hi+((lane&15)>>2))*64;
  const char*Kbase=shm+LDS_K; bf16x8 kf[8];
  const lds_cptr shm3=(lds_cptr)shm; const lds_cptr kp0=shm3+LDS_K+hi*1024+r32*16; const lds_cptr vp0=shm3+LDS_V+((lane>>4)&1)*32+(lane&3)*8+(4*hi+((lane&15)>>2))*64;
  const int NT=(q0+QB)/KVBLK;
  DMA_K(0,0);DMA_V(0,0);DMA_K(1,SLOTB);
  bf16x8 qr[4];
  #pragma unroll
  for(int d0=0;d0<4;++d0)qr[d0]=*reinterpret_cast<const bf16x8*>(&Qw[(long)r32*QKP+d0*16+hi*8]);
  float mhat=0.f,l_reg=0.f;f32x16 o[2];o[0]=f32x16{};o[1]=f32x16{};f32x16 negm=f32x16{};asm volatile("":"+v"(negm));
  const int qrel=wid*QBLK+r32;
  #define CMASK(P0,P1,t) do{int jb_=(t)-(NT-4); if(jb_>=0)cmask(P0,P1,jb_,qrel,hi);}while(0)
  bool resc=false;
  #define START(P0,P1) do{ const float rm=rowmax(P0,P1); resc=false; \
    { const float dl=rm; mhat=fadd_s(mhat,dl); \
      _Pragma("unroll") for(int r=0;r<16;++r){P0[r]=fsub_s(P0[r],dl);P1[r]=fsub_s(P1[r],dl);} \
      _Pragma("unroll") for(int r=0;r<16;++r)negm[r]=-mhat; asm volatile("":"+v"(negm)); } \
    _Pragma("unroll") for(int r=0;r<16;++r)P0[r]=__builtin_amdgcn_exp2f(P0[r]); }while(0)
  #define RESC() do{ if(resc){ asm volatile("s_waitcnt lgkmcnt(0)":::"memory"); \
      _Pragma("unroll") for(int d_=0;d_<2;++d_) _Pragma("unroll") for(int r=0;r<16;++r)o[d_][r]*=wsf[crow(r,hi)]; } }while(0)
  f32x16 pA0,pA1,pB0,pB1;
  int sl_prev=0,sl_cur=0,sl_next=SLOTB;
  #define ROT() do{sl_prev=sl_cur;sl_cur=sl_next;sl_next=(sl_next==(NSLOT-1)*SLOTB)?0:sl_next+SLOTB;}while(0)
  DMA_K(2,2*SLOTB);
  WAIT_BAR(3);
  qkt(pA0,pA1,Kbase,qr,negm,r32,hi);asm volatile("s_nop 15\n\ts_nop 7":"+v"(pA0),"+v"(pA1));CMASK(pA0,pA1,0);
  START(pA0,pA1);
  _Pragma("unroll") for(int r=0;r<16;++r)pA1[r]=__builtin_amdgcn_exp2f(pA1[r]);
  WAIT_BAR(0);
  DMA_K(3,0);DMA_V(1,SLOTB);
  ROT();
  kload8(kf,kp0+sl_cur);
  WAIT_BAR(2);
  s16x4 vlo[8],vhi[8]; u32x4 pw0,pw1,pw2,pw3;
  #define PKW(P,B) cvtpk_s(P[B],P[B+1])
  #define PAF(k) __builtin_bit_cast(bf16x8,pw##k)
  #define VFR(i) __builtin_bit_cast(bf16x8,(s16x8){vlo[i][0],vlo[i][1],vlo[i][2],vlo[i][3],vhi[i][0],vhi[i][1],vhi[i][2],vhi[i][3]})
  #define PIN(x) asm volatile("":"+v"(x))
  #define MX3(a,b,c) __builtin_fmaxf(__builtin_fmaxf((a),(b)),(c))
  #define GAPA(MF,A0,A1,A2,A3,W0,W1,PW) do{ MF; sacc+=A0; sacc+=A1; sacc+=A2; sacc+=A3; PIN(sacc); W0; W1; PIN(PW); SBAR(); }while(0)
  #define EX(v) __builtin_amdgcn_exp2f(v)
  #define GAPB(MF,X,B) do{ MF; X[B]=EX(X[B]); X[B+1]=EX(X[B+1]); X[B+2]=EX(X[B+2]); X[B+3]=EX(X[B+3]); PIN(X); SBAR(); }while(0)
  #define VRD(i) do{ vlo[i]=vtr(vp_+(((i)>>2)*4096+((i)&3)*1024)); vhi[i]=vtr(vp_+(((i)>>2)*4096+((i)&3)*1024+512)); }while(0)
  #define KRD(G,j) do{ if(G){ kload2(kf,kp0+sl_next,j); SBAR(); } }while(0)
  #define STEP(C0,C1,P0,P1,t,GK,GV,GL) do{ SBAR(); \
    const lds_cptr vp_=vp0+sl_prev; \
    VRD(0); SBAR(); float sacc=(P0[0]+P0[1]); \
    GAPA(C0=__builtin_amdgcn_mfma_f32_32x32x16_f16(kf[0],qr[0],negm,0,0,0), P0[2],P0[3],P0[4],P0[5],     pw0[0]=PKW(P0,0), pw0[1]=PKW(P0,2), pw0); \
    VRD(4); SBAR(); GAPA(C1=__builtin_amdgcn_mfma_f32_32x32x16_f16(kf[1],qr[0],negm,0,0,0), P0[6],P0[7],P0[8],P0[9],     pw0[2]=PKW(P0,4), pw0[3]=PKW(P0,6), pw0); \
    VRD(1); SBAR(); GAPA(C0=__builtin_amdgcn_mfma_f32_32x32x16_f16(kf[2],qr[1],C0,0,0,0),   P0[10],P0[11],P0[12],P0[13], pw1[0]=PKW(P0,8), pw1[1]=PKW(P0,10), pw1); \
    VRD(5); SBAR(); GAPA(C1=__builtin_amdgcn_mfma_f32_32x32x16_f16(kf[3],qr[1],C1,0,0,0),   P0[14],P0[15],P1[0],P1[1],   pw1[2]=PKW(P0,12),pw1[3]=PKW(P0,14), pw1); \
    VRD(2); SBAR(); GAPA(C0=__builtin_amdgcn_mfma_f32_32x32x16_f16(kf[4],qr[2],C0,0,0,0),   P1[2],P1[3],P1[4],P1[5],     pw2[0]=PKW(P1,0), pw2[1]=PKW(P1,2), pw2); \
    VRD(6); SBAR(); GAPA(C1=__builtin_amdgcn_mfma_f32_32x32x16_f16(kf[5],qr[2],C1,0,0,0),   P1[6],P1[7],P1[8],P1[9],     pw2[2]=PKW(P1,4), pw2[3]=PKW(P1,6), pw2); \
    VRD(3); SBAR(); GAPA(C0=__builtin_amdgcn_mfma_f32_32x32x16_f16(kf[6],qr[3],C0,0,0,0),   P1[10],P1[11],P1[12],P1[13], pw3[0]=PKW(P1,8), pw3[1]=PKW(P1,10), pw3); \
    VRD(7); SBAR(); GAPA(C1=__builtin_amdgcn_mfma_f32_32x32x16_f16(kf[7],qr[3],C1,0,0,0),   P1[14],P1[15],0.f,0.f,       pw3[2]=PKW(P1,12),pw3[3]=PKW(P1,14), pw3); \
    l_reg+=sacc; \
    if(GK){DMA_K((t)+3,sl_cur);} if(GV){DMA_V((t)+1,sl_next);} \
    CMASK(C0,C1,t); \
    { float a=MX3(C0[0],C0[1],C1[0]),b=MX3(C0[2],C0[3],C1[1]); a=MX3(a,C1[2],C1[3]); \
      _Pragma("unroll") for(int r=4;r<16;r+=4){a=MX3(a,C0[r],C0[r+1]);b=MX3(b,C0[r+2],C0[r+3]);a=MX3(a,C1[r],C1[r+1]);b=MX3(b,C1[r+2],C1[r+3]);} \
      float rm=__builtin_fmaxf(a,b); { auto rr=__builtin_amdgcn_permlane32_swap(__float_as_uint(rm),__float_as_uint(rm),false,false); rm=__builtin_fmaxf(__uint_as_float(rr[0]),__uint_as_float(rr[1])); } \
      resc=false; \
      if(__builtin_expect(__any(rm>(float)THRL),0)){ const float dl=__builtin_fmaxf(rm,0.f); mhat+=dl; \
        _Pragma("unroll") for(int r=0;r<16;++r){C0[r]-=dl;C1[r]-=dl;} \
        _Pragma("unroll") for(int r=0;r<16;++r)negm[r]=-mhat; asm volatile("":"+v"(negm)); \
        const float f=__builtin_amdgcn_exp2f(-dl); l_reg*=f; if(hi==0)wsf[r32]=f; resc=true; } } \
    SBAR(); \
    GAPB(o[0]=__builtin_amdgcn_mfma_f32_32x32x16_f16(PAF(0),VFR(0),o[0],0,0,0), C0,0); \
    GAPB(o[1]=__builtin_amdgcn_mfma_f32_32x32x16_f16(PAF(0),VFR(4),o[1],0,0,0), C0,4); \
    KRD(GL,0); GAPB(o[0]=__builtin_amdgcn_mfma_f32_32x32x16_f16(PAF(1),VFR(1),o[0],0,0,0), C0,8); \
    KRD(GL,1); GAPB(o[1]=__builtin_amdgcn_mfma_f32_32x32x16_f16(PAF(1),VFR(5),o[1],0,0,0), C0,12); \
    KRD(GL,2); GAPB(o[0]=__builtin_amdgcn_mfma_f32_32x32x16_f16(PAF(2),VFR(2),o[0],0,0,0), C1,0); \
    KRD(GL,3); GAPB(o[1]=__builtin_amdgcn_mfma_f32_32x32x16_f16(PAF(2),VFR(6),o[1],0,0,0), C1,4); \
    GAPB(o[0]=__builtin_amdgcn_mfma_f32_32x32x16_f16(PAF(3),VFR(3),o[0],0,0,0), C1,8); \
    GAPB(o[1]=__builtin_amdgcn_mfma_f32_32x32x16_f16(PAF(3),VFR(7),o[1],0,0,0), C1,12); \
    }while(0)
  int t=1;
  #undef CMASK
  #define CMASK(P0,P1,t) do{}while(0)
  for(;t+5<NT;t+=2){
    STEP(pB0,pB1,pA0,pA1,t,true,true,true);     WAIT_BAR(2); RESC(); ROT();
    STEP(pA0,pA1,pB0,pB1,t+1,true,true,true);   WAIT_BAR(2); RESC(); ROT();
  }
  #undef CMASK
  #define CMASK(P0,P1,t) do{int jb_=(t)-(NT-4); if(jb_>=0)cmask(P0,P1,jb_,qrel,hi);}while(0)
  #define ENDW(tt) do{ if((tt)+3<NT){WAIT_BAR(2);} else if((tt)+2<NT){WAIT_BAR(1);} else {WAIT_BAR(0);} }while(0)
  for(;t+1<NT;t+=2){
    STEP(pB0,pB1,pA0,pA1,t,(t+3<NT),(t+1<NT),(t+1<NT));       ENDW(t);   RESC(); ROT();
    STEP(pA0,pA1,pB0,pB1,t+1,(t+4<NT),(t+2<NT),(t+2<NT));     ENDW(t+1); RESC(); ROT();
  }
  STEP(pB0,pB1,pA0,pA1,NT-1,false,false,false); RESC();
  { float sacc=pB0[0]+pB0[1]; _Pragma("unroll") for(int r=2;r<16;++r)sacc+=pB0[r]; _Pragma("unroll") for(int r=0;r<16;++r)sacc+=pB1[r]; l_reg+=sacc;
    pw0=(u32x4){PKW(pB0,0),PKW(pB0,2),PKW(pB0,4),PKW(pB0,6)};pw1=(u32x4){PKW(pB0,8),PKW(pB0,10),PKW(pB0,12),PKW(pB0,14)};pw2=(u32x4){PKW(pB1,0),PKW(pB1,2),PKW(pB1,4),PKW(pB1,6)};pw3=(u32x4){PKW(pB1,8),PKW(pB1,10),PKW(pB1,12),PKW(pB1,14)};
    SBAR(); pv(o,vb0+sl_cur,PAF(0),PAF(1),PAF(2),PAF(3)); }
  #undef PKW
  #undef PAF
  #undef VFR
  #undef PIN
  #undef MX3
  #undef GAPA
  #undef GAPB
  #undef EX
  #undef VRD
  #undef KRD
  #undef STEP
  #undef ENDW
  {auto rr=__builtin_amdgcn_permlane32_swap(__float_as_uint(l_reg),__float_as_uint(l_reg),false,false);l_reg=__uint_as_float(rr[0])+__uint_as_float(rr[1]);}
  if(hi==0)wsf[32+r32]=l_reg;asm volatile("s_waitcnt lgkmcnt(0)":::"memory");
  float rli[16];
  #pragma unroll
  for(int r=0;r<16;++r)rli[r]=__builtin_amdgcn_rcpf(wsf[32+crow(r,hi)]);
  bf16*Ow=O+(rowbase+q0+wid*QBLK)*OP+ocol;
  { bf16*stg=(bf16*)(shm+LDS_OST)+wid*2048;
    #pragma unroll
    for(int r=0;r<16;++r){const int orow=crow(r,hi);
      #pragma unroll
      for(int d0=0;d0<2;++d0)stg[orow*64+d0*32+r32]=(bf16)(o[d0][r]*rli[r]);}
    asm volatile("s_waitcnt lgkmcnt(0)":::"memory");
    #pragma unroll
    for(int i=0;i<4;++i){const int row=i*8+(lane>>3),ch=lane&7; const u32x4 v=*(const u32x4*)(stg+row*64+ch*8); ATTN_STORE16(Ow+(long)row*OP+ch*8,v);} }
  asm volatile("s_waitcnt lgkmcnt(0)\n\ts_barrier":::"memory");
  #undef DMA_K
  #undef DMA_V
  #undef CMASK
  #undef START
  #undef RESC
  #undef ROT
}
constexpr int ATTN_LDS_BYTES=LDS_BYTES;
struct AttnTensors { const bf16* Q; const bf16* K; const bf16* V; bf16* O; };
struct AttnUnit { int bh; int qb; };
struct StaticOrder {
  int vcu, G;
  __device__ __forceinline__ explicit StaticOrder(int grid,int block):vcu((grid%8==0)?(block%8)*(grid/8)+block/8:block),G(grid){}
  __device__ __forceinline__ bool next(int i,AttnUnit&u)const{ constexpr int NP=BATCH*64; const int ppc=(NP+G-1)/G; const int pj=i>>1; if(pj>=ppc)return false; const int pi=vcu*ppc+pj; if(pi>=NP)return false;
    const int s=pi&3; u.bh=pi>>2; u.qb=(i&1)?7-s:s; return true; }
  __device__ __forceinline__ void a_ready(const AttnUnit&)const{}
  __device__ __forceinline__ void done(const AttnUnit&)const{}
};
template<class Sched,int THRL=8> __device__ __forceinline__ void attn_phase(char*lds,const AttnTensors&T,const Sched&S,const int wave_s){
  AttnUnit u;
  for(int i=0;S.next(i,u);++i){ S.a_ready(u); attn_unit<THRL>(u.bh/NHEAD,u.bh%NHEAD,u.qb,T.Q,T.K,T.V,T.O,lds,wave_s); S.done(u); }
}
#undef SBAR
#undef WAIT_BAR
}
namespace mk {
constexpr size_t al256(size_t x) { return (x + 255) / 256 * 256; }
constexpr size_t MiB = (size_t)1 << 20;
constexpr size_t WS_CTL = 0, CTL_BYTES = 1u << 20;
constexpr int NIN = 3840;
constexpr size_t WS_WIN  = 1 * MiB;
constexpr size_t WS_WOUT = WS_WIN + (size_t)NIN * 2048;
constexpr size_t WS_WPLG = WS_WOUT + 2 * MiB;
constexpr size_t WS_WPL  = WS_WPLG + 2 * MiB;
constexpr size_t WS_WB   = WS_WPL + MiB / 2;
constexpr size_t WS_RW   = WS_WB + al256((size_t)1536 * 384 * 2);
constexpr size_t WS_SSQPE = WS_RW + (size_t)48 * 4096;
constexpr size_t WS_ROPC = WS_SSQPE + (size_t)16384 * 4;
constexpr size_t WS_ROPS = WS_ROPC + 2 * MiB;
constexpr size_t WS_BON  = WS_ROPS + 2 * MiB;
constexpr size_t WS_LIST = WS_BON + MiB / 2;
constexpr size_t WS_ASGW = WS_LIST + 2 * MiB;
constexpr size_t WS_SST  = WS_ASGW + MiB / 8;
static_assert(WS_SST + MiB <= 23 * MiB, "small region");
constexpr size_t WS_PE   = 23 * MiB;
constexpr size_t WS_HN   = 55 * MiB;
constexpr size_t WS_PH   = 87 * MiB;
constexpr size_t WS_Q    = 95 * MiB, WS_K = 111 * MiB, WS_V = 127 * MiB;
constexpr size_t WS_P    = 143 * MiB;
constexpr size_t WS_O    = 215 * MiB;
constexpr size_t WS_ZR   = 247 * MiB;
constexpr size_t WS_LA   = 55 * MiB;
constexpr size_t WS_WL   = 67 * MiB, WS_AL = 83 * MiB, WS_G = 99 * MiB;
constexpr size_t WS_RJ   = 115 * MiB;
constexpr size_t WS_VS   = 174 * MiB;
constexpr size_t WS_Y    = 190 * MiB;
constexpr size_t WS_MIX  = 55 * MiB;
constexpr size_t WS_X1   = 95 * MiB;
constexpr size_t WS_H2   = 159 * MiB;
constexpr size_t WS_WDN  = 191 * MiB;
constexpr size_t WS_WUP  = 223 * MiB;
constexpr size_t WS_HID  = 55 * MiB;
constexpr size_t WS_YE   = 223 * MiB;
constexpr size_t WS_X2H  = 159 * MiB;
constexpr size_t WS_END1 = 295 * MiB - 65536;
static_assert(WS_ZR + (size_t)16384 * 1536 * 2 <= 295 * MiB && WS_WUP + 64 * MiB <= 287 * MiB && WS_X1 + 64 * MiB <= WS_H2 && WS_H2 + 32 * MiB <= WS_WDN && WS_WDN + 32 * MiB <= WS_WUP && WS_RJ + (size_t)8 * 8 * 64 * 15104 <= WS_VS && WS_HID + (size_t)(32768 + 8192) * 1024 <= WS_X1, "ws map");

constexpr int CW_BAR = 4096, CW_CNT = 8192;

constexpr int RING_BYTES = 131072, SCR_BYTES = 8 * 19456  , MISC_OFF = SCR_BYTES + 320, LDS_BYTES = 160 * 1024;

struct TJob { const float* src; f16* dst; const float* s1; const float* s2; int K, N, ldd, mode, nb, item0; long sstride, dstride; };
constexpr int MAXJOBS = 20;
struct Params {
    const float* in[38]; float* out; unsigned char* ws;
    TJob jobs[MAXJOBS]; int njobs, nitems, ph_lo, ph_hi, njobs0, nitems0, rep_ph, pad_;
};

#define XB_TMO      128
#define XB_XCNT(j)  (256  + 64 * (j))
#define XB_XSUB(j)  (1280 + 64 * (j))
#define XB_XGEN(j)  (2304 + 64 * (j))
#define XB_TOP      3328
#define XB_TOPGEN   3392
#define XCD_BAR_WORDS 3456
#define XB_SPIN_CAP (1u << 18)
__device__ __forceinline__ unsigned xb_ld(unsigned* p)              { return __hip_atomic_load(p, __ATOMIC_RELAXED, __HIP_MEMORY_SCOPE_AGENT); }
__device__ __forceinline__ unsigned xb_add(unsigned* p, unsigned v) { return __hip_atomic_fetch_add(p, v, __ATOMIC_RELAXED, __HIP_MEMORY_SCOPE_AGENT); }
__device__ __forceinline__ unsigned xb_xcc_id() { return (unsigned)__builtin_amdgcn_s_getreg((3 << 11) | 20) & 0xFu; }
#define XB_SPIN(cond, bar) do { unsigned _sp = 0; while (cond) { __builtin_amdgcn_s_sleep(1); \
    if ((++_sp & 255u) == 0u) { if (xb_ld(&(bar)[XB_TMO])) break; if (_sp > XB_SPIN_CAP) { atomicAdd(&(bar)[XB_TMO], 1u); break; } } } } while (0)
struct XcdBarrier { unsigned* bar; unsigned x; volatile LAS unsigned* st; };
__device__ __forceinline__ XcdBarrier xcd_barrier_post(unsigned* bar, volatile LAS unsigned* st) {
    XcdBarrier b; b.bar = bar; b.x = xb_xcc_id(); b.st = st;
    if (threadIdx.x == 0) (void)xb_add(&bar[XB_XCNT(b.x)], 1u);
    return b;
}
__device__ __forceinline__ void xcd_barrier_complete(unsigned* bar, unsigned x, unsigned& nloc, unsigned& nx) {
    const unsigned G = gridDim.x * gridDim.y * gridDim.z;
    unsigned sum, cnt, mine, sp = 0u;
    for (;;) {
        sum = 0u; cnt = 0u; mine = 0u;
#pragma unroll
        for (unsigned j = 0; j < 16; ++j) { const unsigned c = xb_ld(&bar[XB_XCNT(j)]); sum += c; cnt += (c > 0u) ? 1u : 0u; mine = (j == x) ? c : mine; }
        if (sum == G) break;
        __builtin_amdgcn_s_sleep(1);
        if ((++sp & 255u) == 0u) { if (xb_ld(&bar[XB_TMO])) break; if (sp > XB_SPIN_CAP) { atomicAdd(&bar[XB_TMO], 1u); break; } }
    }
    nloc = mine > 0u ? mine : 1u; nx = cnt > 0u ? cnt : 1u;
}
__device__ __forceinline__ void xcd_barrier(const XcdBarrier& b, int wave_s) {
    int ln_; asm volatile("v_mbcnt_lo_u32_b32 %0, -1, 0\n\tv_mbcnt_hi_u32_b32 %0, -1, %0" : "=v"(ln_));
    const bool leader = wave_s == 0 && ln_ == 0;
    asm volatile("s_waitcnt vmcnt(0)" ::: "memory");
    __syncthreads();
    if (leader) {
        unsigned* bar = b.bar;
        __builtin_amdgcn_s_waitcnt(0);
        unsigned nloc = b.st[0], nx = b.st[1];
        if (nloc == 0u) { xcd_barrier_complete(bar, b.x, nloc, nx); b.st[0] = nloc; b.st[1] = nx; }
        const unsigned old = xb_add(&bar[XB_XSUB(b.x)], 1u);
        const unsigned gen = old / nloc;
        if (old + 1u == (gen + 1u) * nloc) {
            __builtin_amdgcn_fence(__ATOMIC_RELEASE, "agent");
            asm volatile("s_waitcnt vmcnt(0)" ::: "memory");
            const unsigned og = xb_add(&bar[XB_TOP], 1u);
            const unsigned tg = og / nx;
            if (og + 1u == (tg + 1u) * nx) xb_add(&bar[XB_TOPGEN], 1u);
            else XB_SPIN(xb_ld(&bar[XB_TOPGEN]) == tg, bar);
            __builtin_amdgcn_fence(__ATOMIC_ACQUIRE, "agent");
            xb_add(&bar[XB_XGEN(b.x)], 1u);
            asm volatile("s_waitcnt vmcnt(0)" ::: "memory");
        } else {
            XB_SPIN(xb_ld(&bar[XB_XGEN(b.x)]) == gen, bar);
            __builtin_amdgcn_fence(__ATOMIC_ACQUIRE, "agent");
            asm volatile("s_waitcnt vmcnt(0)" ::: "memory");
        }
    }
    __syncthreads();
}

__device__ __forceinline__ float shx(float v, int mask, int lane) { return __builtin_bit_cast(float, __builtin_amdgcn_ds_bpermute((lane ^ mask) << 2, __builtin_bit_cast(int, v))); }
__device__ __forceinline__ float wave_sum(float v, int lane) {
#pragma unroll
    for (int o = 1; o < 64; o <<= 1) v += shx(v, o, lane);
    return v;
}

__device__ __forceinline__ float wave_sum_dpp(float x) {
    int v = __builtin_bit_cast(int, x);
#define DPP_ADD(ctrl, rmask) v = __builtin_bit_cast(int, __builtin_bit_cast(float, v) + __builtin_bit_cast(float, __builtin_amdgcn_update_dpp(0, v, ctrl, rmask, 0xf, true)))
    DPP_ADD(0x111, 0xf); DPP_ADD(0x112, 0xf); DPP_ADD(0x114, 0xf); DPP_ADD(0x118, 0xf); DPP_ADD(0x142, 0xa); DPP_ADD(0x143, 0xc);
#undef DPP_ADD
    return __builtin_bit_cast(float, __builtin_amdgcn_readlane(v, 63));
}
constexpr int TR_WAVE_LDS = 64 * 68 * 4;
__device__ __forceinline__ void p0_transpose_item(const TJob& J, int item, LAS float* scr, int lane) {
    const int kblks = (J.K + 63) / 64, nblk = (J.N + 63) / 64, per = kblks * nblk;
    const int bi = item / per, r = item % per, kb = r / nblk, nbk = r % nblk, k0 = 64 * kb, n0 = 64 * nbk;
    const float* W = J.src + (size_t)bi * J.sstride; f16* WT = J.dst + (size_t)bi * J.dstride;
    const int c4 = (lane & 15) * 4, kr = lane >> 4;
    f32x4 v[16];
#pragma unroll
    for (int i = 0; i < 16; ++i) { const int k = k0 + 4 * i + kr; v[i] = (f32x4){0.f, 0.f, 0.f, 0.f};
        if (k < J.K && n0 + c4 < J.N) v[i] = *(const f32x4*)(W + (size_t)k * J.N + n0 + c4); }
    if (J.s1) {
#pragma unroll
        for (int i = 0; i < 16; ++i) { const int k = k0 + 4 * i + kr; float s = 1.f;
            if (k < J.K) { s = J.s1[k]; if (J.mode == 1) s *= 1.f - J.s2[k]; else if (J.mode == 2) s *= J.s2[k]; }
            v[i] = v[i] * s; }
    }
#pragma unroll
    for (int i = 0; i < 16; ++i) { const int kk = 4 * i + kr; *(LAS f32x4*)(scr + kk * 68 + (c4 ^ (4 * ((kk >> 3) & 7)))) = v[i]; }
    asm volatile("s_waitcnt lgkmcnt(0)" ::: "memory");
    const int c = lane & 7, nn = lane >> 3;
    if (k0 + 8 * c < J.K) {
#pragma unroll
        for (int jn = 0; jn < 8; ++jn) { const int n = nn + 8 * jn; const LAS float* s = scr + (8 * c) * 68 + (n ^ (4 * c));
            if (n0 + n < J.N) {
                u32x4 o; o.x = pkh(s[0 * 68], s[1 * 68]); o.y = pkh(s[2 * 68], s[3 * 68]); o.z = pkh(s[4 * 68], s[5 * 68]); o.w = pkh(s[6 * 68], s[7 * 68]);
                *(u32x4*)(WT + (size_t)(n0 + n) * J.ldd + k0 + 8 * c) = o; } }
    }
    asm volatile("s_waitcnt lgkmcnt(0)" ::: "memory");
}

__device__ __forceinline__ void p0_prologue(const Params& p, unsigned char* ws, LAS unsigned char* lds, int bid, int wave, int lane) {
    LAS float* scr = (LAS float*)(lds + wave * TR_WAVE_LDS);
    const int G = gridDim.x, gw = bid * NWAVES + wave, NGW = G * NWAVES;
    for (int it = gw; it < p.nitems0; it += NGW) {
        int j = 0;
        while (j + 1 < p.njobs0 && it >= p.jobs[j + 1].item0) ++j;
        p0_transpose_item(p.jobs[j], it - p.jobs[j].item0, scr, lane);
    }
    const float* x = p.in[0]; f16* HN = (f16*)(ws + WS_HN);
    for (int m = gw; m < M; m += NGW) {
        const f32x4* xr = (const f32x4*)(x + (size_t)m * 1024) + lane;
        f32x4 v[4]; float s = 0.f;
#pragma unroll
        for (int j = 0; j < 4; ++j) { v[j] = xr[64 * j]; s += (v[j].x * v[j].x + v[j].y * v[j].y) + (v[j].z * v[j].z + v[j].w * v[j].w); }
        const float r = rsqrtf(wave_sum(s, lane) * (1.f / 1024.f) + 1e-6f);
        u32x2* o8 = (u32x2*)(HN + (size_t)m * 1024) + lane;
#pragma unroll
        for (int j = 0; j < 4; ++j) o8[64 * j] = (u32x2){pkh(v[j].x * r, v[j].y * r), pkh(v[j].z * r, v[j].w * r)};
    }
    const float* pp = p.in[1]; f16* PH = (f16*)(ws + WS_PH);
    const int gt = bid * NTHR + wave * 64 + lane, NGT = G * NTHR;
    for (int i = gt; i < M * 256 / 8; i += NGT) {
        const f32x4 a = *((const f32x4*)pp + 2 * (size_t)i), b = *((const f32x4*)pp + 2 * (size_t)i + 1);
        *((u32x4*)PH + i) = (u32x4){pkh(a.x, a.y), pkh(a.z, a.w), pkh(b.x, b.y), pkh(b.z, b.w)};
    }
    const int* pos = (const int*)p.in[2]; float* rc = (float*)(ws + WS_ROPC); float* rs = (float*)(ws + WS_ROPS);
    for (int i = gt; i < M * 32; i += NGT) {
        const int t = i >> 5, f = i & 31; const float inv = powf(10000.f, -(float)f / 32.f); const float ang = (float)pos[t] * inv;
        rc[i] = cosf(ang); rs[i] = sinf(ang);
    }
    float* ssq = (float*)(ws + WS_SSQPE);
    for (int i = gt; i < M; i += NGT) ssq[i] = 0.f;
    float* RW = (float*)(ws + WS_RW); const float* gm = p.in[28]; const float* wg = p.in[29]; const float* we = p.in[30];
    for (int i = gt; i < 48 * 1024; i += NGT) {
        const int c = i >> 10, k = i & 1023;
        const float w = c < 4 ? wg[k * 4 + c] : (c < 36 ? we[(size_t)((c - 4) >> 3) * 8192 + k * 8 + ((c - 4) & 7)] : 0.f);
        RW[i] = w * gm[k];
    }
}

enum { EPI_QK = 0, EPI_ST16 = 1, EPI_PE = 2, EPI_X1 = 3, EPI_UP = 4, EPI_DOWN = 5, EPI_FINAL = 6 };
enum { PH_P0 = 0, PH_P1, PH_ATTN, PH_P2A, PH_P2B, PH_P2C0, PH_SCAN0, PH_P2C1, PH_SCAN1, PH_MIX, PH_OUT, PH_ROUTE, PH_UP, PH_DOWN, PH_COMB, PH_GATE, PH_END };
struct UniSched {
    const unsigned char* ws; int ph, G, c;
    __device__ __forceinline__ bool next(int i, GU& u) const {
        unsigned char* w = const_cast<unsigned char*>(ws);
        u.aux = 0; u.glist = nullptr; u.elist = nullptr; u.gcnt = 0;
        if (ph == PH_P1) {
            constexpr int nM = M / BM, nN = NIN / BM, nwg = nM * nN, nPE = nM * 4;
            const int rounds = (nwg + G - 1) / G, rem = nwg % G;
            const long L = (long)i * G + c;
            if (L < nwg) {
                int wgid = (int)L; { const int q = nwg / NXCD, r = nwg % NXCD, xcd = wgid % NXCD, off = wgid / NXCD; wgid = (xcd < r ? xcd * (q + 1) : r * (q + 1) + (xcd - r) * q) + off; }
                const int nig = WGM * nN, gid = wgid / nig, fm = gid * WGM, gsz = (nM - fm) < WGM ? (nM - fm) : WGM;
                const int pm = fm + ((wgid % nig) % gsz), pn = (wgid % nig) / gsz;
                u.pm = pm; u.pn = pn; u.nt = 16; u.lda2 = 2048; u.ldb2 = 2048; u.hsa = 128 * 2048;
                u.a = (const char*)(ws + WS_HN) + (size_t)pm * 256 * 2048;
                u.b = (const char*)(ws + WS_WIN) + (size_t)pn * 256 * 2048;
                if (pn < 4) { u.bmode = 2; u.hsb = 32 * 2048; u.epi = EPI_QK; u.o = (char*)(w + (pn < 2 ? WS_Q : WS_K)); u.ldc = 512; u.oc0 = 256 * (pn & 1); u.aux = pn < 2; }
                else { u.bmode = 1; u.hsb = 128 * 2048; u.epi = EPI_ST16;
                    if (pn < 6) { u.o = (char*)(w + WS_V); u.ldc = 512; u.oc0 = 256 * (pn - 4); }
                    else if (pn < 12) { u.o = (char*)(w + WS_ZR); u.ldc = 1536; u.oc0 = 256 * (pn - 6); }
                    else { u.o = (char*)(w + WS_P); u.ldc = 768; u.oc0 = 256 * (pn - 12); } }
                return true;
            }
            int Lp;
            if (rem == 0) Lp = (int)(L - nwg);
            else { if (c < rem) return false; Lp = (i - (rounds - 1)) * (G - rem) + (c - rem); }
            if (Lp >= nPE) return false;
            const int pm = Lp >> 2, pn = Lp & 3;
            u.pm = pm; u.pn = pn; u.nt = 4; u.lda2 = 512; u.ldb2 = 512; u.hsa = 128 * 512; u.hsb = 128 * 512; u.bmode = 1; u.epi = EPI_PE;
            u.a = (const char*)(ws + WS_PH) + (size_t)pm * 256 * 512;
            u.b = (const char*)(ws + WS_WPL) + (size_t)pn * 256 * 512;
            u.o = (char*)(w + WS_PE); u.ldc = 1024; u.oc0 = 256 * pn;
            return true;
        }
        if (ph == PH_P2B) {
            constexpr int nM = M / BM, nwg = nM * 6;
            const int L = i * G + c; if (L >= nwg) return false;
            const int pm = L / 6, pn = L % 6;
            u.pm = pm; u.pn = pn; u.nt = 6; u.lda2 = 768; u.ldb2 = 768; u.hsa = 128 * 768; u.hsb = 128 * 768; u.bmode = 1; u.epi = EPI_ST16;
            u.a = (const char*)(ws + WS_LA) + (size_t)pm * 256 * 768; u.b = (const char*)(ws + WS_WB) + (size_t)pn * 256 * 768;
            u.o = (char*)(w + (pn < 2 ? WS_WL : pn < 4 ? WS_AL : WS_G)); u.ldc = 512; u.oc0 = 256 * (pn & 1);
            return true;
        }
        if (ph == PH_OUT || ph == PH_GATE) {
            constexpr int nM = M / BM, nN = 4, nwg = nM * nN;
            const long L = (long)i * G + c; if (L >= nwg) return false;
            int wgid = (int)L; { const int q = nwg / NXCD, r = nwg % NXCD, xcd = wgid % NXCD, off = wgid / NXCD; wgid = (xcd < r ? xcd * (q + 1) : r * (q + 1) + (xcd - r) * q) + off; }
            const int nig = WGM * nN, gid = wgid / nig, fm = gid * WGM, gsz = (nM - fm) < WGM ? (nM - fm) : WGM;
            const int pm = fm + ((wgid % nig) % gsz), pn = (wgid % nig) / gsz;
            u.pm = pm; u.pn = pn; u.nt = 16; u.lda2 = 2048; u.ldb2 = 2048; u.hsa = 128 * 2048; u.hsb = 128 * 2048; u.bmode = 0;
            u.a = (const char*)(ws + (ph == PH_OUT ? WS_MIX : WS_X2H)) + (size_t)pm * 256 * 2048;
            u.b = (const char*)(ws + (ph == PH_OUT ? WS_WOUT : WS_WPLG)) + (size_t)pn * 256 * 2048;
            u.epi = ph == PH_OUT ? EPI_X1 : EPI_FINAL; u.o = nullptr; u.ldc = 1024; u.oc0 = 256 * pn;
            return true;
        }
        if (ph == PH_UP || ph == PH_DOWN) {
            const int vc = (G % 8 == 0) ? (c % 8) * (G / 8) + c / 8 : c;
            const int L = i * G + vc, T = L >> 2, pn = L & 3;
            const int* cnt = (const int*)(ws + WS_CTL) + CW_CNT;
            int e = 0, t0 = 0, cn = 0;
            for (; e < 32; ++e) { cn = __builtin_amdgcn_readfirstlane(cnt[e]); const int nte = (cn + 255) >> 8; if (T < t0 + nte) break; t0 += nte; }
            if (e >= 32) return false;
            const int rt = T - t0;
            u.pm = T; u.pn = pn; u.aux = e; u.gcnt = cn - rt * 256;
            const int* lst = (const int*)(ws + WS_LIST) + (size_t)e * M + rt * 256;
            if (ph == PH_UP) {
                u.glist = lst; u.a = (const char*)(ws + WS_H2); u.lda2 = 2048; u.hsa = 0; u.nt = 16;
                u.b = (const char*)(ws + WS_WUP) + (size_t)e * 1024 * 2048 + (size_t)pn * 128 * 2048; u.ldb2 = 2048; u.hsb = 512 * 2048; u.bmode = 1;
                u.epi = EPI_UP; u.o = (char*)(w + WS_HID); u.ldc = 512; u.oc0 = 128 * pn;
            } else {
                u.elist = lst; u.a = (const char*)(ws + WS_HID) + (size_t)T * 256 * 1024; u.lda2 = 1024; u.hsa = 128 * 1024; u.nt = 8;
                u.b = (const char*)(ws + WS_WDN) + (size_t)e * 1024 * 1024 + (size_t)pn * 256 * 1024; u.ldb2 = 1024; u.hsb = 128 * 1024; u.bmode = 1;
                u.epi = EPI_DOWN; u.o = (char*)(w + WS_YE); u.ldc = 1024; u.oc0 = 256 * pn;
            }
            return true;
        }
        return false;
    }
};
struct UniEpi {
    unsigned char* ws; const Params& P;
    __device__ __forceinline__ const float* pin(int i) const { asm volatile("" : "+s"(i)); return P.in[i]; }
    __device__ __forceinline__ void operator()(const f32x4 (&acc)[2][2][4][2], const GU& u, int wr, int wc, int fr, int fq) const {
        const int row0 = u.pm * BM + wr * 64 + fr, ln = fq * 16 + fr;
        if (u.epi == EPI_ST16 || u.epi == EPI_PE) {
            f16* O = (f16*)u.o; const int ldc = u.ldc, col0 = u.oc0;
            float* ssq = (float*)(ws + WS_SSQPE);
#pragma unroll
            for (int ai = 0; ai < 2; ++ai)
#pragma unroll
                for (int m = 0; m < 4; ++m) {
                    const int row = row0 + ai * HALF + m * 16; f16* rp = O + (size_t)row * ldc + col0 + wc * 32 + 8 * fq; float s = 0.f;
#pragma unroll
                    for (int bj = 0; bj < 2; ++bj) { const f32x4 v0 = acc[ai][bj][m][0], v1 = acc[ai][bj][m][1];
                        s += (v0[0] * v0[0] + v0[1] * v0[1]) + (v0[2] * v0[2] + v0[3] * v0[3]) + (v1[0] * v1[0] + v1[1] * v1[1]) + (v1[2] * v1[2] + v1[3] * v1[3]);
                        *(u32x4*)(rp + bj * HALF) = (u32x4){pkh(v0[0], v0[1]), pkh(v0[2], v0[3]), pkh(v1[0], v1[1]), pkh(v1[2], v1[3])}; }
                    if (u.epi == EPI_PE) { s += shx(s, 16, ln); s += shx(s, 32, ln); if (fq == 0) atomicAdd(ssq + row, s); }
                }
            return;
        }
        if (u.epi == EPI_X1 || u.epi == EPI_FINAL) {
            const float* xin = u.epi == EPI_X1 ? pin(0) : (const float*)(ws + WS_X1); const float* gpl = pin(35); float* outp = P.out;
            float* O = u.epi == EPI_X1 ? (float*)(ws + WS_X1) : outp;
            const f16* PE = (const f16*)(ws + WS_PE); const float* ssq = (const float*)(ws + WS_SSQPE);
#pragma unroll
            for (int ai = 0; ai < 2; ++ai)
#pragma unroll
                for (int m = 0; m < 4; ++m) {
                    const int row = row0 + ai * HALF + m * 16; const size_t ro = (size_t)row * 1024 + u.oc0 + wc * 32 + 4 * fq;
                    float rpe = 0.f; if (u.epi == EPI_FINAL) rpe = rsqrtf(ssq[row] * (1.f / 1024.f) + 1e-6f);
#pragma unroll
                    for (int bj = 0; bj < 2; ++bj)
#pragma unroll
                        for (int n = 0; n < 2; ++n) { const size_t o = ro + bj * HALF + n * 16; const f32x4 xr = *(const f32x4*)(xin + o); f32x4 v = acc[ai][bj][m][n];
                            if (u.epi == EPI_FINAL) { const h4 pe = *(const h4*)(PE + o); const f32x4 gp = *(const f32x4*)(gpl + (o - (size_t)row * 1024));
#pragma unroll
                                for (int j = 0; j < 4; ++j) v[j] = (float)pe[j] * rpe * gp[j] / (1.f + __expf(-v[j])); }
                            *(f32x4*)(O + o) = xr + v; }
                    asm volatile("" ::: "memory");
                }
            return;
        }
        if (u.epi == EPI_UP) {
            f16* O = (f16*)u.o;
#pragma unroll
            for (int ai = 0; ai < 2; ++ai)
#pragma unroll
                for (int m = 0; m < 4; ++m) {
                    const int row = row0 + ai * HALF + m * 16; unsigned w4[4];
#pragma unroll
                    for (int n = 0; n < 2; ++n) { const f32x4 gt = acc[ai][0][m][n], up = acc[ai][1][m][n]; float h[4];
#pragma unroll
                        for (int j = 0; j < 4; ++j) h[j] = gt[j] / (1.f + __expf(-gt[j])) * up[j];
                        w4[2 * n] = pkh(h[0], h[1]); w4[2 * n + 1] = pkh(h[2], h[3]); }
                    *(u32x4*)(O + (size_t)row * 512 + u.oc0 + wc * 32 + 8 * fq) = (u32x4){w4[0], w4[1], w4[2], w4[3]};
                    asm volatile("" ::: "memory");
                }
            return;
        }
        if (u.epi == EPI_DOWN) {
            f16* O = (f16*)u.o; const float* aw = (const float*)(ws + WS_ASGW);
#pragma unroll
            for (int ai = 0; ai < 2; ++ai)
#pragma unroll
                for (int m = 0; m < 4; ++m) {
                    const int r = wr * 64 + fr + ai * HALF + m * 16;
                    if (r < u.gcnt) { const int slot = u.elist[r]; const float wgt = aw[slot]; f16* rp = O + (size_t)slot * 1024 + u.oc0 + wc * 32 + 8 * fq;
#pragma unroll
                        for (int bj = 0; bj < 2; ++bj) { const f32x4 v0 = acc[ai][bj][m][0] * wgt, v1 = acc[ai][bj][m][1] * wgt;
                            *(u32x4*)(rp + bj * HALF) = (u32x4){pkh(v0[0], v0[1]), pkh(v0[2], v0[3]), pkh(v1[0], v1[1]), pkh(v1[2], v1[3])}; } }
                    asm volatile("" ::: "memory");
                }
            return;
        }
        const bool isq = u.aux != 0; const float* g = isq ? pin(5) : pin(6); const float osc = isq ? C2 : 1.f;
        f16* O = (f16*)u.o; const int colb = u.oc0 + 64 * wc + 8 * fq;
        const float* rc = (const float*)(ws + WS_ROPC); const float* rs = (const float*)(ws + WS_ROPS);
        f32x4 gl[2][2];
#pragma unroll
        for (int bj = 0; bj < 2; ++bj)
#pragma unroll
            for (int n = 0; n < 2; ++n) gl[bj][n] = *(const f32x4*)(g + 32 * bj + 8 * fq + 4 * n);
#pragma unroll
        for (int ai = 0; ai < 2; ++ai)
#pragma unroll
            for (int m = 0; m < 4; ++m) {
                const int row = row0 + ai * HALF + m * 16; float s = 0.f;
#pragma unroll
                for (int bj = 0; bj < 2; ++bj)
#pragma unroll
                    for (int n = 0; n < 2; ++n) { const f32x4 v = acc[ai][bj][m][n]; s += (v[0] * v[0] + v[1] * v[1]) + (v[2] * v[2] + v[3] * v[3]); }
                s += shx(s, 16, ln); s += shx(s, 32, ln);
                const float ri = rsqrtf(s * (1.f / 64.f) + 1e-6f);
                unsigned lo[4], hi[4];
#pragma unroll
                for (int n = 0; n < 2; ++n) {
                    const f32x4 c = *(const f32x4*)(rc + (size_t)row * 32 + 8 * fq + 4 * n), sn = *(const f32x4*)(rs + (size_t)row * 32 + 8 * fq + 4 * n);
                    const f32x4 y0 = acc[ai][0][m][n] * gl[0][n] * ri, y1 = acc[ai][1][m][n] * gl[1][n] * ri;
                    const f32x4 l = (y0 * c - y1 * sn) * osc, h = (y1 * c + y0 * sn) * osc;
                    lo[2 * n] = pkh(l[0], l[1]); lo[2 * n + 1] = pkh(l[2], l[3]); hi[2 * n] = pkh(h[0], h[1]); hi[2 * n + 1] = pkh(h[2], h[3]);
                }
                f16* rp = O + (size_t)row * 512 + colb;
                *(u32x4*)rp = (u32x4){lo[0], lo[1], lo[2], lo[3]};
                *(u32x4*)(rp + 32) = (u32x4){hi[0], hi[1], hi[2], hi[3]};
            }
    }
};

__device__ __forceinline__ void p4_mix(unsigned char* ws, const float* lq1, const float* lk1, const float* lq2, const float* lk2, const float* ogp, int bid, int wave, int lane) {
    const int gw = bid * NWAVES + wave, NGW = gridDim.x * NWAVES;
    const float d1 = wave_sum(lq1[lane] * lk1[lane], lane), d2 = wave_sum(lq2[lane] * lk2[lane], lane);
    const float lam = expf(d1) - expf(d2) + 0.2f;
    const f16* O = (const f16*)(ws + WS_O); f16* MIX = (f16*)(ws + WS_MIX);
    const float* og = ogp + (lane & 15) * 8; float g[8];
#pragma unroll
    for (int j = 0; j < 8; ++j) g[j] = og[j] * 0.8f;
    for (int m = gw; m < M; m += NGW) {
        const h8 a = *(const h8*)(O + (size_t)m * 1024 + lane * 8), b = *(const h8*)(O + (size_t)m * 1024 + 512 + lane * 8);
        float o[8]; float s = 0.f;
#pragma unroll
        for (int j = 0; j < 8; ++j) { o[j] = (float)a[j] - lam * (float)b[j]; s += o[j] * o[j]; }
        s += shx(s, 1, lane); s += shx(s, 2, lane); s += shx(s, 4, lane); s += shx(s, 8, lane);
        const float r = rsqrtf(s * (1.f / 128.f) + 1e-5f);
        *(u32x4*)(MIX + (size_t)m * 1024 + lane * 8) = (u32x4){pkh(o[0] * r * g[0], o[1] * r * g[1]), pkh(o[2] * r * g[2], o[3] * r * g[3]), pkh(o[4] * r * g[4], o[5] * r * g[5]), pkh(o[6] * r * g[6], o[7] * r * g[7])};
    }
}
__device__ __forceinline__ void p4_mix_rwkv(unsigned char* ws, const float* mu_rkv, const float* gn_w, const float* gn_b, int bid, int wave, int lane) {
    const int gw = bid * NWAVES + wave, NGW = gridDim.x * NWAVES;
    const f16* Y = (const f16*)(ws + WS_Y); const float* BON = (const float*)(ws + WS_BON);
    const f16* VS = (const f16*)(ws + WS_VS); const f16* Gg = (const f16*)(ws + WS_G); f16* MIX = (f16*)(ws + WS_MIX);
    (void)mu_rkv;
    for (int it = gw; it < M * 8; it += NGW) {
        const int m = it >> 3, hd = it & 7, c = hd * 64 + lane;
        const float y = (float)Y[(size_t)m * 512 + c];
        const float mu = wave_sum(y, lane) * (1.f / 64.f), d = y - mu, var = wave_sum(d * d, lane) * (1.f / 64.f);
        const float yn = d * rsqrtf(var + 64e-5f) * gn_w[c] + gn_b[c];
        const float v = (float)VS[(size_t)m * 512 + c];
        const float gg = (float)Gg[(size_t)m * 512 + c];
        MIX[(size_t)m * 1024 + 512 + c] = (f16)((yn + BON[(size_t)m * 8 + hd] * v) * gg);
    }
}


__device__ __forceinline__ void p6_expert_weights(const Params& p, LAS unsigned char* lds, int bid, int wave, int lane) {
    LAS float* scr = (LAS float*)(lds + wave * TR_WAVE_LDS);
    const int gw = bid * NWAVES + wave, NGW = gridDim.x * NWAVES;
    for (int it = p.nitems0 + gw; it < p.nitems; it += NGW) {
        int j = p.njobs0;
        while (j + 1 < p.njobs && it >= p.jobs[j + 1].item0) ++j;
        p0_transpose_item(p.jobs[j], it - p.jobs[j].item0, scr, lane);
    }
}
__device__ __forceinline__ void p6_router(unsigned char* ws, LAS unsigned char* lds, int bid, int wave, int lane) {
    const float* X1 = (const float*)(ws + WS_X1); const float* RW = (const float*)(ws + WS_RW); f16* H2 = (f16*)(ws + WS_H2);
    int* cnt = (int*)(ws + WS_CTL) + CW_CNT; int* LIST = (int*)(ws + WS_LIST); float* ASGW = (float*)(ws + WS_ASGW);
    LAS float* lg = (LAS float*)(lds + wave * 4096);
    const int gw = bid * NWAVES + wave, NGW = gridDim.x * NWAVES, r = lane & 15, kq = lane >> 4;
    for (int task = gw; task < M / 16; task += NGW) {
        const int row0 = task * 16;
        const float* xr = X1 + (size_t)(row0 + r) * 1024 + 4 * kq;
        f32x4 acc[3] = {{0.f, 0.f, 0.f, 0.f}, {0.f, 0.f, 0.f, 0.f}, {0.f, 0.f, 0.f, 0.f}}; float ssq = 0.f;
#pragma unroll 2
        for (int j = 0; j < 64; ++j) {
            const f32x4 xa = *(const f32x4*)(xr + 16 * j);
            ssq += (xa[0] * xa[0] + xa[1] * xa[1]) + (xa[2] * xa[2] + xa[3] * xa[3]);
#pragma unroll
            for (int t = 0; t < 3; ++t) { const f32x4 wb = *(const f32x4*)(RW + (size_t)(16 * t + r) * 1024 + 16 * j + 4 * kq);
#pragma unroll
                for (int e = 0; e < 4; ++e) acc[t] = __builtin_amdgcn_mfma_f32_16x16x4f32(xa[e], wb[e], acc[t], 0, 0, 0); }
        }
        ssq += shx(ssq, 16, lane); ssq += shx(ssq, 32, lane);
        const float rstd = rsqrtf(ssq * (1.f / 1024.f) + 1e-6f);
        if (kq == 0) lg[768 + r] = rstd;
#pragma unroll
        for (int t = 0; t < 3; ++t)
#pragma unroll
            for (int q = 0; q < 4; ++q) lg[(4 * kq + q) * 48 + 16 * t + r] = acc[t][q];
        asm volatile("s_waitcnt lgkmcnt(0)" ::: "memory");
#pragma unroll 4
        for (int j = 0; j < 64; ++j) { const f32x4 xa = *(const f32x4*)(xr + 16 * j);
            *(u32x2*)(H2 + (size_t)(row0 + r) * 1024 + 16 * j + 4 * kq) = (u32x2){pkh(xa[0] * rstd, xa[1] * rstd), pkh(xa[2] * rstd, xa[3] * rstd)}; }
        if (lane < 16) {
            const int t = row0 + lane; const float rs = lg[768 + lane]; const LAS float* l = lg + lane * 48;
            int gs = 0; float gm = l[0] * rs;
#pragma unroll
            for (int i = 1; i < 4; ++i) { const float v = l[i] * rs; if (v > gm) { gm = v; gs = i; } }
            float den = 0.f;
#pragma unroll
            for (int i = 0; i < 4; ++i) den += expf(l[i] * rs - gm);
            const float gwt = 1.f / den;
            float ev[8];
#pragma unroll
            for (int i = 0; i < 8; ++i) { float v = 0.f;
#pragma unroll
                for (int gq = 0; gq < 4; ++gq) if (gq == gs) v = l[4 + 8 * gq + i];
                ev[i] = v * rs; }
            int i0 = 0; float v0 = ev[0];
#pragma unroll
            for (int i = 1; i < 8; ++i) if (ev[i] > v0) { v0 = ev[i]; i0 = i; }
            int i1 = 0; float v1 = -INFINITY;
#pragma unroll
            for (int i = 0; i < 8; ++i) if (i != i0 && ev[i] > v1) { v1 = ev[i]; i1 = i; }
            const float p1 = expf(v1 - v0), w0 = gwt / (1.f + p1), w1 = gwt * p1 / (1.f + p1);
            const int e0 = gs * 8 + i0, e1 = gs * 8 + i1;
            ASGW[2 * t] = w0; ASGW[2 * t + 1] = w1;
            int pos = atomicAdd(cnt + e0, 1); LIST[(size_t)e0 * M + pos] = 2 * t;
            pos = atomicAdd(cnt + e1, 1); LIST[(size_t)e1 * M + pos] = 2 * t + 1;
        }
        asm volatile("s_waitcnt lgkmcnt(0)" ::: "memory");
    }
}
__device__ __forceinline__ void p9_combine(unsigned char* ws, int bid, int wave, int lane) {
    float* X1 = (float*)(ws + WS_X1); const f16* YE = (const f16*)(ws + WS_YE); f16* X2H = (f16*)(ws + WS_X2H);
    const int gw = bid * NWAVES + wave, NGW = gridDim.x * NWAVES;
    for (int m = gw; m < M; m += NGW) {
        f32x4 v[4]; float s = 0.f;
#pragma unroll
        for (int j = 0; j < 4; ++j) {
            const size_t c = (size_t)lane * 4 + 256 * j;
            v[j] = *(const f32x4*)(X1 + (size_t)m * 1024 + c);
            const h4 a = *(const h4*)(YE + (size_t)(2 * m) * 1024 + c), b = *(const h4*)(YE + (size_t)(2 * m + 1) * 1024 + c);
#pragma unroll
            for (int q = 0; q < 4; ++q) { v[j][q] += (float)a[q] + (float)b[q]; s += v[j][q] * v[j][q]; }
        }
        const float r = rsqrtf(wave_sum(s, lane) * (1.f / 1024.f) + 1e-6f);
#pragma unroll
        for (int j = 0; j < 4; ++j) {
            const size_t c = (size_t)lane * 4 + 256 * j;
            *(f32x4*)(X1 + (size_t)m * 1024 + c) = v[j];
            *(u32x2*)(X2H + (size_t)m * 1024 + c) = (u32x2){pkh(v[j][0] * r, v[j][1] * r), pkh(v[j][2] * r, v[j][3] * r)};
        }
    }
}
}
namespace mk {
constexpr int CH = 16, NCH = SEQ / CH;
constexpr int NCHH = NCH / 2, NJOBH = NB * 8 * NCHH;
constexpr int P2C_WAVE_LDS = 19456;
constexpr int RJ_PHI = 0, RJ_RH = 8192, RJ_PSI = 10240, RJ_C2 = 12288, RJ_VB = 12800, RJ_DG = 14848, RJ_BYTES = 15104;

struct RwkvW { const float *mu_rkv, *w0, *a0, *k_k, *k_a, *r_k, *gn_w, *gn_b; };

struct TokVals { float r, k2, v, a, b, lw; };
__device__ __forceinline__ TokVals rwkv_tok(const f16* ZR, const f16* WL, const f16* AL, const RwkvW& W, size_t row, bool hasprev, int c, int lane) {
    const f16* z = ZR + row * 1536; const f16* zp = z - 1536;
    const float zr = (float)z[c], zk = (float)z[512 + c], zv = (float)z[1024 + c];
    const float pr = hasprev ? (float)zp[c] : 0.f, pk = hasprev ? (float)zp[512 + c] : 0.f, pv = hasprev ? (float)zp[1024 + c] : 0.f;
    TokVals o;
    o.r = zr + (pr - zr) * W.mu_rkv[c]; const float k = zk + (pk - zk) * W.mu_rkv[512 + c]; o.v = zv + (pv - zv) * W.mu_rkv[1024 + c];
    o.lw = 0.f;
    const float ag = __builtin_amdgcn_rcpf(1.f + __expf(-(W.a0[c] + (float)AL[row * 512 + c])));
    float kk = k * W.k_k[c];
    const float ss = wave_sum_dpp(kk * kk);
    kk *= rsqrtf(fmaxf(ss, 1e-24f));
    o.k2 = k * (1.f + (ag - 1.f) * W.k_a[c]); o.a = -kk; o.b = kk * ag;
    return o;
}

__device__ __forceinline__ void p2a_la(unsigned char* ws, int bid, int tid) {
    const f16* P = (const f16*)(ws + WS_P); f16* LA = (f16*)(ws + WS_LA);
    const int gt = bid * NTHR + tid, NGT = gridDim.x * NTHR;
    for (int i = gt; i < M * 48; i += NGT) {
        const int t = i / 48, c8 = (i % 48) * 8; u32x4 o = (u32x4){0u, 0u, 0u, 0u};
        if (c8 < 288) {
            const h8 a = *(const h8*)(P + (size_t)t * 768 + c8); h8 b = (h8){0, 0, 0, 0, 0, 0, 0, 0};
            if (t % SEQ) b = *(const h8*)(P + (size_t)(t - 1) * 768 + 288 + c8);
            float v[8];
#pragma unroll
            for (int j = 0; j < 8; ++j) { float x = (float)a[j] + (float)b[j]; v[j] = c8 < 64 ? tanhf(x) : (c8 < 128 ? x : 1.f / (1.f + expf(-x))); }
            o = (u32x4){pkh(v[0], v[1]), pkh(v[2], v[3]), pkh(v[4], v[5]), pkh(v[6], v[7])};
        }
        *(u32x4*)(LA + (size_t)t * 384 + c8) = o;
    }
}

__device__ __forceinline__ h8 lds_h8(LAS const unsigned char* p) { return *(LAS const h8*)p; }
__device__ __forceinline__ void p2c_chunks(unsigned char* ws, const RwkvW& W, LAS unsigned char* lds, int half, int bid, int wave, int lane) {
    LAS unsigned char* L = lds + wave * P2C_WAVE_LDS;
    const f16* ZR = (const f16*)(ws + WS_ZR); const f16* WL = (const f16*)(ws + WS_WL); const f16* AL = (const f16*)(ws + WS_AL); f16* VS = (f16*)(ws + WS_VS);
    unsigned char* RJ = ws + WS_RJ; float* BON = (float*)(ws + WS_BON);
    const int gw = bid * NWAVES + wave, NGW = gridDim.x * NWAVES;
    const int r16 = lane & 15, g = lane >> 4;
    const h8 zero8 = (h8){0, 0, 0, 0, 0, 0, 0, 0};
    for (int job = gw; job < NJOBH; job += NGW) {
        const int bh = job / NCHH, ch = half * NCHH + job % NCHH, b = bh >> 3, hd = bh & 7, c = hd * 64 + lane;
        const size_t row0 = (size_t)b * SEQ + ch * CH;
        unsigned char* rj0 = RJ + (size_t)job * RJ_BYTES;
        {
            float lwv[16]; float GL = 0.f;
#pragma unroll
            for (int i = 0; i < 16; ++i) {
                const float wl = W.w0[c] + (float)WL[(row0 + i) * 512 + c];
                const float nx = -wl; const float sp = nx > 20.f ? nx : __logf(1.f + __expf(nx));
                lwv[i] = -__expf(-sp - 0.5f); GL += lwv[i];
            }
            float G = 0.f, eprev = 1.f; float vq[4];
#pragma unroll
            for (int i = 0; i < 16; ++i) {
                const TokVals tv = rwkv_tok(ZR, WL, AL, W, row0 + i, (ch * CH + i) != 0, c, lane);
                G += lwv[i]; const float ei = __expf(G), einv = __builtin_amdgcn_rcpf(ei), f = __expf(GL - G);
                *(LAS f16*)(L + 0 + i * 144 + lane * 2) = (f16)(tv.a * eprev); *(LAS f16*)(L + 2304 + i * 144 + lane * 2) = (f16)(tv.b * einv);
                *(LAS f16*)(L + 4608 + i * 144 + lane * 2) = (f16)(tv.k2 * einv); *(LAS f16*)(L + 6912 + i * 144 + lane * 2) = (f16)(tv.r * ei);
                *(LAS f16*)(L + 13888 + lane * 80 + i * 2) = (f16)(tv.b * f); *(LAS f16*)(L + 13888 + lane * 80 + 32 + i * 2) = (f16)(tv.k2 * f);
                eprev = ei; vq[i & 3] = tv.v; VS[(row0 + i) * 512 + c] = (f16)tv.v;
                if ((i & 3) == 3) *(u32x2*)(rj0 + RJ_VB + ((lane >> 4) * 64 + (lane & 15) + 16 * (i >> 2)) * 8) = (u32x2){pkh(vq[0], vq[1]), pkh(vq[2], vq[3])};
                const float bon = wave_sum_dpp(tv.r * tv.k2 * W.r_k[c]);
                if (lane == 0) BON[(row0 + i) * 8 + hd] = bon;
            }
            *(float*)(rj0 + RJ_DG + lane * 4) = __expf(GL);
        }
        asm volatile("s_waitcnt lgkmcnt(0)" ::: "memory");
        f32x4 n1 = {0.f, 0.f, 0.f, 0.f}, n2 = n1, n3 = n1, n4 = n1;
#pragma unroll
        for (int s = 0; s < 2; ++s) {
            const int off = r16 * 144 + (8 * g + 32 * s) * 2;
            const h8 xa = lds_h8(L + 0 + off), xb = lds_h8(L + 2304 + off), xk = lds_h8(L + 4608 + off), xr = lds_h8(L + 6912 + off);
            n1 = __builtin_amdgcn_mfma_f32_16x16x32_f16(xa, xb, n1, 0, 0, 0);
            n2 = __builtin_amdgcn_mfma_f32_16x16x32_f16(xa, xk, n2, 0, 0, 0);
            n3 = __builtin_amdgcn_mfma_f32_16x16x32_f16(xb, xr, n3, 0, 0, 0);
            n4 = __builtin_amdgcn_mfma_f32_16x16x32_f16(xk, xr, n4, 0, 0, 0);
        }
#pragma unroll
        for (int q = 0; q < 4; ++q) { const int rr = 4 * g + q;
            if (!(r16 < rr)) { n1[q] = 0.f; n2[q] = 0.f; }
            if (!(rr <= r16)) { n3[q] = 0.f; n4[q] = 0.f; } }
#pragma unroll
        for (int q = 0; q < 4; ++q) { *(LAS float*)(L + 10240 + ((4 * g + q) * 16 + r16) * 4) = n1[q]; *(LAS float*)(L + 11264 + (r16 * 17 + 4 * g + q) * 4) = n2[q]; }
        *(LAS u32x2*)(L + 13120 + r16 * 48 + g * 8) = (u32x2){pkh(n3[0], n3[1]), pkh(n3[2], n3[3])};
        asm volatile("s_waitcnt lgkmcnt(0)" ::: "memory");
        float X[16], X1[16], rt[16];
#pragma unroll
        for (int i = 0; i < 16; ++i) rt[i] = (float)*(LAS const f16*)(L + 6912 + i * 144 + lane * 2);
#pragma unroll
        for (int i = 0; i < 16; ++i) {
            float x = (float)*(LAS const f16*)(L + 0 + i * 144 + lane * 2), x1 = *(LAS const float*)(L + 11264 + (r16 * 17 + i) * 4);
#pragma unroll
            for (int m4 = 0; m4 < (i + 3) / 4; ++m4) {
                const f32x4 cf = *(LAS const f32x4*)(L + 10240 + (i * 16 + m4 * 4) * 4);
#pragma unroll
                for (int q = 0; q < 4; ++q) if (m4 * 4 + q < i) { x = fmaf(X[m4 * 4 + q], cf[q], x); x1 = fmaf(X1[m4 * 4 + q], cf[q], x1); }
            }
            X[i] = x; X1[i] = x1;
        }
#pragma unroll
        for (int q = 0; q < 4; ++q) {
            *(LAS u32x2*)(L + 0 + lane * 80 + q * 8) = (u32x2){pkh(X[4 * q], X[4 * q + 1]), pkh(X[4 * q + 2], X[4 * q + 3])};
            *(LAS u32x2*)(L + 0 + lane * 80 + 32 + q * 8) = (u32x2){pkh(rt[4 * q], rt[4 * q + 1]), pkh(rt[4 * q + 2], rt[4 * q + 3])};
            if (lane < 16) *(LAS u32x2*)(L + 12352 + lane * 48 + q * 8) = (u32x2){pkh(X1[4 * q], X1[4 * q + 1]), pkh(X1[4 * q + 2], X1[4 * q + 3])};
        }
        asm volatile("s_waitcnt lgkmcnt(0)" ::: "memory");
        h8 Af[4], Ap[4], Bf[4];
#pragma unroll
        for (int t = 0; t < 4; ++t) { Af[t] = lds_h8(L + 0 + (16 * t + r16) * 80 + g * 16); Ap[t] = g < 2 ? Af[t] : zero8; Bf[t] = lds_h8(L + 13888 + (16 * t + r16) * 80 + g * 16); }
        h8 idn = zero8;
#pragma unroll
        for (int e8 = 0; e8 < 8; ++e8) if (g >= 2 && 8 * (g - 2) + e8 == r16) idn[e8] = (f16)1.f;
        const h8 c1raw = g < 2 ? lds_h8(L + 12352 + r16 * 48 + g * 16) : zero8;
        const h8 c1id = g < 2 ? c1raw : idn;
        const h8 nbraw = g < 2 ? lds_h8(L + 13120 + r16 * 48 + g * 16) : zero8;
        const h8 nbid = g < 2 ? nbraw : idn;
        unsigned char* rj = rj0;
        const f32x4 z4 = {0.f, 0.f, 0.f, 0.f};
#pragma unroll
        for (int t = 0; t < 4; ++t) {
            f32x4 d[4];
#pragma unroll
            for (int tp = 0; tp < 4; ++tp) d[tp] = __builtin_amdgcn_mfma_f32_16x16x32_f16(Ap[tp], Bf[t], z4, 0, 0, 0);
#pragma unroll
            for (int s = 0; s < 2; ++s)
                *(u32x4*)(rj + RJ_PHI + ((t * 2 + s) * 64 + lane) * 16) = (u32x4){pkh(d[2 * s][0], d[2 * s][1]), pkh(d[2 * s][2], d[2 * s][3]), pkh(d[2 * s + 1][0], d[2 * s + 1][1]), pkh(d[2 * s + 1][2], d[2 * s + 1][3])};
            const f32x4 ps = __builtin_amdgcn_mfma_f32_16x16x32_f16(c1id, Bf[t], z4, 0, 0, 0);
            *(u32x2*)(rj + RJ_PSI + (t * 64 + lane) * 8) = (u32x2){pkh(ps[0], ps[1]), pkh(ps[2], ps[3])};
        }
        {
            f32x4 d[4];
#pragma unroll
            for (int tp = 0; tp < 4; ++tp) d[tp] = __builtin_amdgcn_mfma_f32_16x16x32_f16(Af[tp], nbid, z4, 0, 0, 0);
#pragma unroll
            for (int s = 0; s < 2; ++s)
                *(u32x4*)(rj + RJ_RH + (s * 64 + lane) * 16) = (u32x4){pkh(d[2 * s][0], d[2 * s][1]), pkh(d[2 * s][2], d[2 * s][3]), pkh(d[2 * s + 1][0], d[2 * s + 1][1]), pkh(d[2 * s + 1][2], d[2 * s + 1][3])};
            const f32x4 c2 = __builtin_amdgcn_mfma_f32_16x16x32_f16(c1raw, nbraw, n4, 0, 0, 0);
            *(u32x2*)(rj + RJ_C2 + lane * 8) = (u32x2){pkh(c2[0], c2[1]), pkh(c2[2], c2[3])};
        }
        asm volatile("s_waitcnt lgkmcnt(0)" ::: "memory");
    }
}

struct ScanOps { u32x4 phi[8]; u32x4 rh[2]; u32x2 psi[4]; u32x2 c2, vb; f32x4 dg[4]; };
__device__ __forceinline__ void scan_load(ScanOps& o, const unsigned char* rj, int vt, int lane, int g) {
#pragma unroll
    for (int i = 0; i < 8; ++i) o.phi[i] = *(const u32x4*)(rj + RJ_PHI + (i * 64 + lane) * 16);
#pragma unroll
    for (int s = 0; s < 2; ++s) o.rh[s] = *(const u32x4*)(rj + RJ_RH + (s * 64 + lane) * 16);
#pragma unroll
    for (int t = 0; t < 4; ++t) { o.psi[t] = *(const u32x2*)(rj + RJ_PSI + (t * 64 + lane) * 8); o.dg[t] = *(const f32x4*)(rj + RJ_DG + (16 * t + 4 * g) * 4); }
    o.c2 = *(const u32x2*)(rj + RJ_C2 + lane * 8); o.vb = *(const u32x2*)(rj + RJ_VB + (vt * 64 + lane) * 8);
}
__device__ __forceinline__ void scan_step(f32x4 (&S)[4], const ScanOps& o, f16* yp) {
    h8 SB[2];
#pragma unroll
    for (int s = 0; s < 2; ++s) { const u32x4 w = (u32x4){pkh(S[2 * s][0], S[2 * s][1]), pkh(S[2 * s][2], S[2 * s][3]), pkh(S[2 * s + 1][0], S[2 * s + 1][1]), pkh(S[2 * s + 1][2], S[2 * s + 1][3])}; SB[s] = __builtin_bit_cast(h8, w); }
    const h8 VBo = __builtin_bit_cast(h8, (u32x4){o.vb.x, o.vb.y, 0u, 0u});
    f32x4 y = {0.f, 0.f, 0.f, 0.f};
#pragma unroll
    for (int s = 0; s < 2; ++s) y = __builtin_amdgcn_mfma_f32_16x16x32_f16(__builtin_bit_cast(h8, o.rh[s]), SB[s], y, 0, 0, 0);
    y = __builtin_amdgcn_mfma_f32_16x16x32_f16(__builtin_bit_cast(h8, (u32x4){o.c2.x, o.c2.y, 0u, 0u}), VBo, y, 0, 0, 0);
#pragma unroll
    for (int t = 0; t < 4; ++t) {
        f32x4 acc = S[t] * o.dg[t];
#pragma unroll
        for (int s = 0; s < 2; ++s) acc = __builtin_amdgcn_mfma_f32_16x16x32_f16(__builtin_bit_cast(h8, o.phi[t * 2 + s]), SB[s], acc, 0, 0, 0);
        acc = __builtin_amdgcn_mfma_f32_16x16x32_f16(__builtin_bit_cast(h8, (u32x4){o.psi[t].x, o.psi[t].y, 0u, 0u}), VBo, acc, 0, 0, 0);
        S[t] = acc;
    }
#pragma unroll
    for (int q = 0; q < 4; ++q) yp[(size_t)q * 512] = (f16)y[q];
}
__device__ __forceinline__ void p3s_scan(unsigned char* ws, int half, int bid, int wave, int lane) {
    const int G = gridDim.x;
    const int r16 = lane & 15, g = lane >> 4;
    const unsigned char* RJ = ws + WS_RJ; f16* Y = (f16*)(ws + WS_Y); f32x4* SST = (f32x4*)(ws + WS_SST);
    for (int task = wave * G + bid; task < NB * 32; task += G * NWAVES) {
        const int bh = task >> 2, vt = task & 3, b = bh >> 3, hd = bh & 7;
        f32x4 S[4];
#pragma unroll
        for (int t = 0; t < 4; ++t) S[t] = half ? SST[((size_t)task * 4 + t) * 64 + lane] : (f32x4){0.f, 0.f, 0.f, 0.f};
        const unsigned char* rj = RJ + (size_t)bh * NCHH * RJ_BYTES;
        f16* yp = Y + ((size_t)b * SEQ + half * NCHH * CH + 4 * g) * 512 + hd * 64 + vt * 16 + r16;
        ScanOps A, B;
        scan_load(A, rj, vt, lane, g);
        for (int chl = 0; chl < NCHH; chl += 2) {
            scan_load(B, rj + RJ_BYTES, vt, lane, g);
            scan_step(S, A, yp);
            if (chl + 2 < NCHH) scan_load(A, rj + 2 * RJ_BYTES, vt, lane, g);
            scan_step(S, B, yp + (size_t)CH * 512);
            rj += 2 * RJ_BYTES; yp += (size_t)2 * CH * 512;
        }
        if (half == 0) {
#pragma unroll
            for (int t = 0; t < 4; ++t) SST[((size_t)task * 4 + t) * 64 + lane] = S[t];
        }
    }
}
}
namespace mk {
__global__ void __launch_bounds__(NTHR, 2) mega(Params p0) {
#define PIN(i) ({ int _i = (i); asm volatile("" : "+s"(_i)); p0.in[_i]; })
    extern __shared__ __attribute__((aligned(16))) unsigned char lds_raw[];
    LAS unsigned char* lds = (LAS unsigned char*)lds_raw;
    const int wave_s = __builtin_amdgcn_readfirstlane(threadIdx.x >> 6);
    const int tid = threadIdx.x;
    volatile LAS unsigned* MISC = (volatile LAS unsigned*)(lds + MISC_OFF);
    for (int u = tid; u < (LDS_BYTES - SCR_BYTES) / 4; u += NTHR) ((LAS unsigned*)(lds + SCR_BYTES))[u] = 0u;
    __syncthreads();
    XcdBarrier bar = xcd_barrier_post((unsigned*)(p0.ws + WS_CTL) + CW_BAR, MISC + 8);
#define GRID_BAR() xcd_barrier(bar)

    int rep_left = 1;
    for (int ph = p0.ph_lo; ph < p0.ph_hi; ++ph) {
        int tidv; asm volatile("v_mbcnt_lo_u32_b32 %0, -1, 0\n\tv_mbcnt_hi_u32_b32 %0, -1, %0" : "=v"(tidv)); tidv += wave_s * 64;
        const int lane = tidv & 63, wave = __builtin_amdgcn_readfirstlane(tidv >> 6);
        int bidv = blockIdx.x; asm volatile("" : "+s"(bidv));
        unsigned char* wsv = p0.ws; asm volatile("" : "+s"(wsv));
        if (ph == PH_P0) p0_prologue(p0, wsv, lds, bidv, wave, lane);
        else if (ph == PH_P2A) p2a_la(wsv, bidv, tidv);
        else if (ph == PH_P2C0 || ph == PH_P2C1) { const RwkvW W{PIN(12), PIN(14), PIN(17), PIN(22), PIN(23), PIN(24), nullptr, nullptr}; p2c_chunks(wsv, W, lds, ph == PH_P2C1, bidv, wave, lane); }
        else if (ph == PH_SCAN0 || ph == PH_SCAN1) p3s_scan(wsv, ph == PH_SCAN1, bidv, wave, lane);
        else if (ph == PH_ATTN) {
            const attn_body::AttnTensors AT{(const f16*)(wsv + WS_Q), (const f16*)(wsv + WS_K), (const f16*)(wsv + WS_V), (f16*)(wsv + WS_O)};
            const attn_body::StaticOrder S((int)gridDim.x, bidv);
            attn_body::attn_phase<attn_body::StaticOrder>((char*)lds_raw, AT, S, wave_s);
        }
        else if (ph == PH_ROUTE) { p6_router(wsv, lds, bidv, wave, lane); __syncthreads(); p6_expert_weights(p0, lds, bidv, wave, lane); }
        else if (ph == PH_COMB) p9_combine(wsv, bidv, wave, lane);
        else if (ph == PH_MIX) { p4_mix(wsv, PIN(7), PIN(8), PIN(9), PIN(10), PIN(11), bidv, wave, lane); p4_mix_rwkv(wsv, PIN(12), PIN(25), PIN(26), bidv, wave, lane); }
        else {
            UniSched S{wsv, ph, (int)gridDim.x, bidv};
            UniEpi E{wsv, p0};
            gemm_phase<UniSched, UniEpi>(lds, S, E, tidv);
        }
        if (ph == p0.rep_ph && rep_left) { rep_left = 0; --ph; }
        if (ph + 1 < p0.ph_hi) { XcdBarrier bb = bar; asm volatile("" : "+s"(bb.bar), "+s"(bb.x)); xcd_barrier(bb, wave_s); }
    }
#undef GRID_BAR
}

static void add_job(Params& P, const float* src, f16* dst, const float* s1, const float* s2, int K, int N, int ldd, int mode, int nb, long sstride, long dstride) {
    TJob& j = P.jobs[P.njobs++]; j.src = src; j.dst = dst; j.s1 = s1; j.s2 = s2; j.K = K; j.N = N; j.ldd = ldd; j.mode = mode; j.nb = nb; j.sstride = sstride; j.dstride = dstride;
    j.item0 = P.nitems; P.nitems += ((K + 63) / 64) * ((N + 63) / 64) * nb;
}
static void build_params(Params& P, void* const* d_in, void* d_out, void* d_ws, bool experts) {
    for (int i = 0; i < 38; ++i) P.in[i] = (const float*)d_in[i];
    P.out = (float*)d_out; P.ws = (unsigned char*)d_ws;
    unsigned char* ws = P.ws; auto F = [&](int i) { return (const float*)d_in[i]; };
    f16* WinT = (f16*)(ws + WS_WIN);
    add_job(P, F(4), WinT, F(3), nullptr, 1024, 3072, 1024, 0, 1, 0, 0);
    const float* mu = F(13);
    add_job(P, F(15), WinT + (size_t)3072 * 1024, F(3), mu, 1024, 64, 1024, 1, 1, 0, 0);
    add_job(P, F(15), WinT + (size_t)(3072 + 288) * 1024, F(3), mu, 1024, 64, 1024, 2, 1, 0, 0);
    add_job(P, F(18), WinT + (size_t)(3072 + 64) * 1024, F(3), mu + 1024, 1024, 64, 1024, 1, 1, 0, 0);
    add_job(P, F(18), WinT + (size_t)(3072 + 288 + 64) * 1024, F(3), mu + 1024, 1024, 64, 1024, 2, 1, 0, 0);
    add_job(P, F(20), WinT + (size_t)(3072 + 128) * 1024, F(3), mu + 2048, 1024, 160, 1024, 1, 1, 0, 0);
    add_job(P, F(20), WinT + (size_t)(3072 + 288 + 128) * 1024, F(3), mu + 2048, 1024, 160, 1024, 2, 1, 0, 0);
    add_job(P, F(27), (f16*)(ws + WS_WOUT), nullptr, nullptr, 1024, 1024, 1024, 0, 1, 0, 0);
    add_job(P, F(37), (f16*)(ws + WS_WPLG), F(36), nullptr, 1024, 1024, 1024, 0, 1, 0, 0);
    add_job(P, F(34), (f16*)(ws + WS_WPL), nullptr, nullptr, 256, 1024, 256, 0, 1, 0, 0);
    f16* WbT = (f16*)(ws + WS_WB);
    add_job(P, F(16), WbT, nullptr, nullptr, 64, 512, 384, 0, 1, 0, 0);
    add_job(P, F(19), WbT + (size_t)512 * 384 + 64, nullptr, nullptr, 64, 512, 384, 0, 1, 0, 0);
    add_job(P, F(21), WbT + (size_t)1024 * 384 + 128, nullptr, nullptr, 160, 512, 384, 0, 1, 0, 0);
    P.njobs0 = P.njobs; P.nitems0 = P.nitems;
    if (experts) {
        add_job(P, F(31), (f16*)(ws + WS_WUP), F(28), nullptr, 1024, 512, 1024, 0, 32, (long)1024 * 512, (long)1024 * 1024);
        add_job(P, F(32), (f16*)(ws + WS_WUP) + (size_t)512 * 1024, F(28), nullptr, 1024, 512, 1024, 0, 32, (long)1024 * 512, (long)1024 * 1024);
        add_job(P, F(33), (f16*)(ws + WS_WDN), nullptr, nullptr, 512, 1024, 512, 0, 32, (long)512 * 1024, (long)1024 * 512);
    }
}
}
namespace ad {
using mk::f16;
__global__ void __launch_bounds__(256) adapt1(const unsigned char* ws, int b, float* Z, float* L1, float* L2, float* L3, float* PE) {
    const f16* Q = (const f16*)(ws + mk::WS_Q); const f16* K = (const f16*)(ws + mk::WS_K); const f16* V = (const f16*)(ws + mk::WS_V);
    const f16* ZR = (const f16*)(ws + mk::WS_ZR); const f16* P = (const f16*)(ws + mk::WS_P); const f16* PEh = (const f16*)(ws + mk::WS_PE);
    const int t = blockIdx.x; const size_t g = (size_t)b * 2048 + t;
    for (int c = threadIdx.x; c < 3072; c += 256) {
        float v;
        if (c < 512) v = (float)Q[g * 512 + c] * (1.f / mk::C2);
        else if (c < 1024) v = (float)K[g * 512 + c - 512];
        else if (c < 1536) v = (float)V[g * 512 + c - 1024];
        else v = (float)ZR[g * 1536 + c - 1536];
        Z[(size_t)t * 3072 + c] = v;
    }
    for (int c = threadIdx.x; c < 1024; c += 256) PE[(size_t)t * 1024 + c] = (float)PEh[g * 1024 + c];
    for (int j = threadIdx.x; j < 288; j += 256) {
        float v = (float)P[g * 768 + j] + (t > 0 ? (float)P[(g - 1) * 768 + 288 + j] : 0.f);
        if (j < 64) L1[(size_t)t * 64 + j] = tanhf(v);
        else if (j < 128) L2[(size_t)t * 64 + j - 64] = v;
        else L3[(size_t)t * 160 + j - 128] = 1.f / (1.f + expf(-v));
    }
}
__global__ void __launch_bounds__(256) adapt2(const unsigned char* ws, int b, float* MIX) {
    const f16* X = (const f16*)(ws + mk::WS_MIX); const int t = blockIdx.x; const size_t g = (size_t)b * 2048 + t;
    for (int c = threadIdx.x; c < 1024; c += 256) MIX[(size_t)t * 1024 + c] = (float)X[g * 1024 + c];
}
}

extern "C" void kernel_launch(void* const* d_in, const int* in_sizes, int n_in, void* d_out, int out_size, void* d_ws, size_t ws_size, hipStream_t stream) {
    static int grid = 0;
    if (grid == 0) {
        int dev = 0, cus = 0, per_cu = 0;
        (void)hipGetDevice(&dev); (void)hipDeviceGetAttribute(&cus, hipDeviceAttributeMultiprocessorCount, dev);
        (void)hipFuncSetAttribute((const void*)mk::mega, hipFuncAttributeMaxDynamicSharedMemorySize, mk::LDS_BYTES);
        (void)hipOccupancyMaxActiveBlocksPerMultiprocessor(&per_cu, (const void*)mk::mega, mk::NTHR, mk::LDS_BYTES);
        if (per_cu < 1) { fprintf(stderr, "kernel_launch: occupancy query says %d blocks per CU\n", per_cu); per_cu = 1; }
        grid = cus * 1;
        (void)hipGetLastError();
    }
    unsigned char* mws = (unsigned char*)d_ws;
    if (ws_size < mk::WS_END1) { fprintf(stderr, "kernel_launch: workspace too small (%zu)\n", ws_size); return; }
    (void)hipMemsetAsync(mws + mk::WS_CTL, 0, mk::CTL_BYTES, stream);
    (void)hipMemsetAsync(mws + mk::WS_WIN + (size_t)3648 * 2048, 0, (size_t)192 * 2048, stream);
    (void)hipMemsetAsync(mws + mk::WS_WB, 0, (size_t)1536 * 384 * 2, stream);
    mk::Params P{};
    mk::build_params(P, d_in, d_out, mws, true);
    P.ph_lo = 0; P.ph_hi = mk::PH_END; P.rep_ph = MK_REP_PH;
    void* args[] = {&P};
    hipError_t e = hipLaunchCooperativeKernel((const void*)mk::mega, dim3(grid), dim3(mk::NTHR), args, mk::LDS_BYTES, stream);
    if (e != hipSuccess) fprintf(stderr, "cooperative launch failed: %s (grid %d)\n", hipGetErrorString(e), grid);
    for (int b = 0; b < nv::NB; ++b) {
        float* out = (float*)d_out + (size_t)b * nv::S_ * nv::D_;
        if (b >= mk::NB) nv::forward_batch(d_in, b, out, (float*)d_ws, stream, 0, 1);
    }
}
```

```cpp
#define MK_NB 8
#define MK_REP_PH (-1)
#include <hip/hip_runtime.h>
#include <cstdint>
#include <cstdio>
#include <cmath>

namespace nv {
constexpr int S_ = 2048, D_ = 1024, NB = 8;
constexpr int MB = S_;

struct ALPlain { const float* A; int lda; int pad; __device__ __forceinline__ float operator()(int m, int k) const { return A[(size_t)m * lda + k]; } };
struct ALShiftMix { const float* H; const float* mu;
    __device__ __forceinline__ float operator()(int m, int k) const { float h = H[(size_t)m * 1024 + k]; float hp = (m % S_) ? H[(size_t)(m - 1) * 1024 + k] : 0.f; return h + (hp - h) * mu[k]; } };
struct ALGather { const float* A; int lda; const int* rows; int div;
    __device__ __forceinline__ float operator()(int m, int k) const { return A[(size_t)(rows[m] / div) * lda + k]; } };

template <class AL, int ACT>
__global__ void __launch_bounds__(256) sgemm(AL al, const float* __restrict__ B, int ldb, float* C, int ldc, const float* Cadd, int ldadd,
                                            int M, const int* Mptr, int N, int K) {
    __shared__ float As[16][68];
    __shared__ float Bs[16][68];
    if (Mptr) M = *Mptr;
    const int m0 = blockIdx.y * 64, n0 = blockIdx.x * 64;
    if (m0 >= M) return;
    const int tid = threadIdx.x, ty = tid / 16, tx = tid % 16;
    float acc[4][4];
#pragma unroll
    for (int i = 0; i < 4; ++i)
#pragma unroll
        for (int j = 0; j < 4; ++j) acc[i][j] = 0.f;
    for (int k0 = 0; k0 < K; k0 += 16) {
#pragma unroll
        for (int i = 0; i < 4; ++i) {
            int idx = tid + i * 256; int m = idx / 16, k = idx % 16;
            As[k][m] = (m0 + m < M) ? al(m0 + m, k0 + k) : 0.f;
            int kb = idx / 64, n = idx % 64;
            Bs[kb][n] = (n0 + n < N) ? B[(size_t)(k0 + kb) * ldb + n0 + n] : 0.f;
        }
        __syncthreads();
#pragma unroll
        for (int k = 0; k < 16; ++k) {
            float a[4], b[4];
#pragma unroll
            for (int i = 0; i < 4; ++i) { a[i] = As[k][ty * 4 + i]; b[i] = Bs[k][tx * 4 + i]; }
#pragma unroll
            for (int i = 0; i < 4; ++i)
#pragma unroll
                for (int j = 0; j < 4; ++j) acc[i][j] = fmaf(a[i], b[j], acc[i][j]);
        }
        __syncthreads();
    }
#pragma unroll
    for (int i = 0; i < 4; ++i)
#pragma unroll
        for (int j = 0; j < 4; ++j) {
            int m = m0 + ty * 4 + i, n = n0 + tx * 4 + j;
            if (m < M && n < N) {
                float v = acc[i][j];
                if (Cadd) v += Cadd[(size_t)m * ldadd + n];
                if (ACT == 1) v = tanhf(v);
                if (ACT == 2) v = 1.f / (1.f + expf(-v));
                C[(size_t)m * ldc + n] = v;
            }
        }
}

__device__ __forceinline__ float block_sum256(float v, float* red) {
    for (int o = 32; o > 0; o >>= 1) v += __shfl_xor(v, o);
    __syncthreads();
    if ((threadIdx.x & 63) == 0) red[threadIdx.x >> 6] = v;
    __syncthreads();
    return red[0] + red[1] + red[2] + red[3];
}

__global__ void __launch_bounds__(256) rmsnorm1024(const float* x, const float* g, float* out, float eps) {
    __shared__ float red[4];
    const size_t row = blockIdx.x; const int t = threadIdx.x;
    float4 v = *(const float4*)(x + row * 1024 + t * 4);
    float ss = block_sum256(v.x * v.x + v.y * v.y + v.z * v.z + v.w * v.w, red);
    float r = rsqrtf(ss * (1.f / 1024.f) + eps);
    float4 gg = *(const float4*)(g + t * 4);
    float4 o; o.x = v.x * r * gg.x; o.y = v.y * r * gg.y; o.z = v.z * r * gg.z; o.w = v.w * r * gg.w;
    *(float4*)(out + row * 1024 + t * 4) = o;
}

__global__ void __launch_bounds__(256) qk_prep(float* Z, const int* pos, const float* qg, const float* kg) {
    const int gw = blockIdx.x * 4 + (threadIdx.x >> 6), lane = threadIdx.x & 63;
    const int row = gw / 16, grp = gw % 16;
    float* p = Z + (size_t)row * 3072 + grp * 64;
    float v = p[lane];
    float ss = v * v;
    for (int o = 32; o > 0; o >>= 1) ss += __shfl_xor(ss, o);
    const float* g = grp < 8 ? qg : kg;
    float y = v * rsqrtf(ss * (1.f / 64.f) + 1e-6f) * g[lane];
    float other = __shfl_xor(y, 32);
    int i = lane & 31;
    float inv_freq = powf(10000.f, -(float)i / 32.f);
    float ang = (float)pos[row] * inv_freq;
    float c = cosf(ang), s = sinf(ang);
    float r = lane < 32 ? (y * c - other * s) : (y * c + other * s);
    p[lane] = r;
}

__global__ void __launch_bounds__(256) attn_naive(const float* Z, float* MIX, const float* lq1, const float* lk1, const float* lq2, const float* lk2, const float* og) {
    const int h = blockIdx.y, q = blockIdx.x * 32 + threadIdx.x / 8, sub = threadIdx.x % 8;
    float d1 = 0.f, d2 = 0.f;
    for (int i = 0; i < 64; ++i) { d1 += lq1[i] * lk1[i]; d2 += lq2[i] * lk2[i]; }
    const float lam = expf(d1) - expf(d2) + 0.2f;
    const float* qp = Z + (size_t)q * 3072 + h * 128;
    float m0 = -INFINITY, m1 = -INFINITY, l0 = 0.f, l1 = 0.f;
    const float scale = 0.125f;
    for (int j = sub; j <= q; j += 8) {
        const float* kp = Z + (size_t)j * 3072 + 512 + h * 128;
        float s0 = 0.f, s1 = 0.f;
        for (int d = 0; d < 64; d += 4) {
            float4 a = *(const float4*)(qp + d), b = *(const float4*)(kp + d);
            s0 += a.x * b.x + a.y * b.y + a.z * b.z + a.w * b.w;
            float4 a1 = *(const float4*)(qp + 64 + d), b1 = *(const float4*)(kp + 64 + d);
            s1 += a1.x * b1.x + a1.y * b1.y + a1.z * b1.z + a1.w * b1.w;
        }
        s0 *= scale; s1 *= scale;
        float n0 = fmaxf(m0, s0); l0 = l0 * expf(m0 - n0) + expf(s0 - n0); m0 = n0;
        float n1 = fmaxf(m1, s1); l1 = l1 * expf(m1 - n1) + expf(s1 - n1); m1 = n1;
    }
    for (int o = 1; o < 8; o <<= 1) {
        float om0 = __shfl_xor(m0, o), ol0 = __shfl_xor(l0, o), om1 = __shfl_xor(m1, o), ol1 = __shfl_xor(l1, o);
        float n0 = fmaxf(m0, om0); l0 = (m0 == -INFINITY ? 0.f : l0 * expf(m0 - n0)) + (om0 == -INFINITY ? 0.f : ol0 * expf(om0 - n0)); m0 = n0;
        float n1 = fmaxf(m1, om1); l1 = (m1 == -INFINITY ? 0.f : l1 * expf(m1 - n1)) + (om1 == -INFINITY ? 0.f : ol1 * expf(om1 - n1)); m1 = n1;
    }
    float o[16];
    for (int d = 0; d < 16; ++d) o[d] = 0.f;
    const int qmax = blockIdx.x * 32 + 31;
    for (int jb = 0; jb <= qmax; jb += 8) {
        const int j = jb + sub;
        float pj = 0.f;
        if (j <= q) {
            const float* kp = Z + (size_t)j * 3072 + 512 + h * 128;
            float s0 = 0.f, s1 = 0.f;
            for (int d = 0; d < 64; d += 4) {
                float4 a = *(const float4*)(qp + d), b = *(const float4*)(kp + d);
                s0 += a.x * b.x + a.y * b.y + a.z * b.z + a.w * b.w;
                float4 a1 = *(const float4*)(qp + 64 + d), b1 = *(const float4*)(kp + 64 + d);
                s1 += a1.x * b1.x + a1.y * b1.y + a1.z * b1.z + a1.w * b1.w;
            }
            pj = expf(s0 * scale - m0) / l0 - lam * expf(s1 * scale - m1) / l1;
        }
        for (int jj = 0; jj < 8; ++jj) {
            float pp = __shfl(pj, (threadIdx.x & 56) | jj);
            if (jb + jj <= qmax) {
                const float* vp = Z + (size_t)(jb + jj) * 3072 + 1024 + h * 128 + sub * 16;
                for (int d = 0; d < 16; ++d) o[d] += pp * vp[d];
            }
        }
    }
    float ss = 0.f;
    for (int d = 0; d < 16; ++d) ss += o[d] * o[d];
    for (int of = 1; of < 8; of <<= 1) ss += __shfl_xor(ss, of);
    float r = rsqrtf(ss * (1.f / 128.f) + 1e-5f) * 0.8f;
    for (int d = 0; d < 16; ++d) MIX[(size_t)q * 1024 + h * 128 + sub * 16 + d] = o[d] * r * og[sub * 16 + d];
}

__global__ void __launch_bounds__(256) rwkv_prep(const float* Z, const float* WL, const float* AL, const float* mu_rkv, const float* w0, const float* a0,
                                                const float* k_k, const float* k_a, float* R, float* W, float* K2, float* V, float* A2, float* B2) {
    const int gw = blockIdx.x * 4 + (threadIdx.x >> 6), lane = threadIdx.x & 63;
    const int row = gw / 8, hd = gw % 8, c = hd * 64 + lane;
    const float* z = Z + (size_t)row * 3072; const float* zp = z - 3072; const bool hp = (row % S_) != 0;
    float zr = z[1536 + c], zk = z[2048 + c], zv = z[2560 + c];
    float pr = hp ? zp[1536 + c] : 0.f, pk = hp ? zp[2048 + c] : 0.f, pv = hp ? zp[2560 + c] : 0.f;
    float r = zr + (pr - zr) * mu_rkv[c], k = zk + (pk - zk) * mu_rkv[512 + c], v = zv + (pv - zv) * mu_rkv[1024 + c];
    float wl = w0[c] + WL[(size_t)row * 512 + c];
    float nx = -wl; float sp = nx > 20.f ? nx : log1pf(expf(nx));
    float decay = expf(-expf(-sp - 0.5f));
    float a = 1.f / (1.f + expf(-(a0[c] + AL[(size_t)row * 512 + c])));
    float kk = k * k_k[c];
    float ss = kk * kk;
    for (int o = 32; o > 0; o >>= 1) ss += __shfl_xor(ss, o);
    kk = kk * rsqrtf(fmaxf(ss, 1e-24f));
    float k2 = k * (1.f + (a - 1.f) * k_a[c]);
    size_t o = (size_t)row * 512 + c;
    R[o] = r; W[o] = decay; K2[o] = k2; V[o] = v; A2[o] = -kk; B2[o] = kk * a;
}

__global__ void __launch_bounds__(64) rwkv_scan_naive(const float* R, const float* W, const float* K2, const float* V, const float* A2, const float* B2, float* Y) {
    __shared__ float sh[5][16][64];
    const int hd = blockIdx.x, lane = threadIdx.x;
    float st[64];
#pragma unroll
    for (int i = 0; i < 64; ++i) st[i] = 0.f;
    for (int t0 = 0; t0 < S_; t0 += 16) {
        __syncthreads();
        for (int i = 0; i < 16; ++i) {
            size_t o = (size_t)(t0 + i) * 512 + hd * 64 + lane;
            sh[0][i][lane] = R[o]; sh[1][i][lane] = W[o]; sh[2][i][lane] = K2[o]; sh[3][i][lane] = A2[o]; sh[4][i][lane] = B2[o];
        }
        __syncthreads();
        for (int i = 0; i < 16; ++i) {
            float v = V[(size_t)(t0 + i) * 512 + hd * 64 + lane];
            float sa = 0.f;
#pragma unroll
            for (int k = 0; k < 64; ++k) sa = fmaf(st[k], sh[3][i][k], sa);
            float y = 0.f;
#pragma unroll
            for (int k = 0; k < 64; ++k) { st[k] = st[k] * sh[1][i][k] + sa * sh[4][i][k] + v * sh[2][i][k]; y = fmaf(st[k], sh[0][i][k], y); }
            Y[(size_t)(t0 + i) * 512 + hd * 64 + lane] = y;
        }
    }
}

__global__ void __launch_bounds__(256) rwkv_post(const float* Y, const float* R, const float* K2, const float* V, const float* G, const float* r_k, const float* gn_w, const float* gn_b, float* MIX) {
    const int gw = blockIdx.x * 4 + (threadIdx.x >> 6), lane = threadIdx.x & 63;
    const int row = gw / 8, hd = gw % 8, c = hd * 64 + lane; const size_t o = (size_t)row * 512 + c;
    float y = Y[o];
    float s = y; for (int of = 32; of > 0; of >>= 1) s += __shfl_xor(s, of);
    float mu = s * (1.f / 64.f); float d = y - mu; float q = d * d; for (int of = 32; of > 0; of >>= 1) q += __shfl_xor(q, of);
    float yn = d * rsqrtf(q * (1.f / 64.f) + 64e-5f) * gn_w[c] + gn_b[c];
    float b = R[o] * K2[o] * r_k[c]; for (int of = 32; of > 0; of >>= 1) b += __shfl_xor(b, of);
    MIX[(size_t)row * 1024 + 512 + c] = (yn + b * V[o]) * G[o];
}

__global__ void __launch_bounds__(256) route(const float* LOG, int* cnt, int* list, float* wts, int M, int cap) {
    const int t = blockIdx.x * 256 + threadIdx.x; if (t >= M) return;
    const float* l = LOG + (size_t)t * 36;
    int gs = 0; float gm = l[0];
    for (int i = 1; i < 4; ++i) if (l[i] > gm) { gm = l[i]; gs = i; }
    float den = 0.f; for (int i = 0; i < 4; ++i) den += expf(l[i] - gm);
    float gw = 1.f / den;
    const float* e = l + 4 + 8 * gs;
    int i0 = 0; float v0 = e[0];
    for (int i = 1; i < 8; ++i) if (e[i] > v0) { v0 = e[i]; i0 = i; }
    int i1 = -1; float v1 = -INFINITY;
    for (int i = 0; i < 8; ++i) if (i != i0 && e[i] > v1) { v1 = e[i]; i1 = i; }
    float p1 = expf(v1 - v0); float w0 = gw / (1.f + p1), w1 = gw * p1 / (1.f + p1);
    wts[t * 2] = w0; wts[t * 2 + 1] = w1;
    int e0 = gs * 8 + i0, e1 = gs * 8 + i1;
    int p = atomicAdd(&cnt[e0], 1); list[e0 * cap + p] = t * 2;
    p = atomicAdd(&cnt[e1], 1); list[e1 * cap + p] = t * 2 + 1;
}

__global__ void __launch_bounds__(256) expert_up(const float* H2, const float* Wg, const float* Wu, const int* cnt, const int* list, float* HID, int cap) {
    __shared__ float As[16][68];
    __shared__ float Bg[16][68];
    __shared__ float Bu[16][68];
    const int e = blockIdx.z, M = cnt[e], m0 = blockIdx.y * 64, n0 = blockIdx.x * 64;
    if (m0 >= M) return;
    const int* rows = list + e * cap;
    const float* wg = Wg + (size_t)e * 1024 * 512; const float* wu = Wu + (size_t)e * 1024 * 512;
    const int tid = threadIdx.x, ty = tid / 16, tx = tid % 16;
    float ag[4][4], au[4][4];
    for (int i = 0; i < 4; ++i) for (int j = 0; j < 4; ++j) { ag[i][j] = 0.f; au[i][j] = 0.f; }
    for (int k0 = 0; k0 < 1024; k0 += 16) {
        for (int i = 0; i < 4; ++i) {
            int idx = tid + i * 256; int m = idx / 16, k = idx % 16;
            As[k][m] = (m0 + m < M) ? H2[(size_t)(rows[m0 + m] / 2) * 1024 + k0 + k] : 0.f;
            int kb = idx / 64, n = idx % 64;
            Bg[kb][n] = wg[(size_t)(k0 + kb) * 512 + n0 + n]; Bu[kb][n] = wu[(size_t)(k0 + kb) * 512 + n0 + n];
        }
        __syncthreads();
        for (int k = 0; k < 16; ++k) {
            float a[4], b[4], c[4];
            for (int i = 0; i < 4; ++i) { a[i] = As[k][ty * 4 + i]; b[i] = Bg[k][tx * 4 + i]; c[i] = Bu[k][tx * 4 + i]; }
            for (int i = 0; i < 4; ++i) for (int j = 0; j < 4; ++j) { ag[i][j] = fmaf(a[i], b[j], ag[i][j]); au[i][j] = fmaf(a[i], c[j], au[i][j]); }
        }
        __syncthreads();
    }
    for (int i = 0; i < 4; ++i) for (int j = 0; j < 4; ++j) {
        int m = m0 + ty * 4 + i, n = n0 + tx * 4 + j;
        if (m < M) { float g = ag[i][j]; HID[(size_t)rows[m] * 512 + n] = g / (1.f + expf(-g)) * au[i][j]; }
    }
}
__global__ void __launch_bounds__(256) expert_down(const float* HID, const float* Wd, const int* cnt, const int* list, float* YE, int cap) {
    __shared__ float As[16][68];
    __shared__ float Bs[16][68];
    const int e = blockIdx.z, M = cnt[e], m0 = blockIdx.y * 64, n0 = blockIdx.x * 64;
    if (m0 >= M) return;
    const int* rows = list + e * cap;
    const float* wd = Wd + (size_t)e * 512 * 1024;
    const int tid = threadIdx.x, ty = tid / 16, tx = tid % 16;
    float acc[4][4];
    for (int i = 0; i < 4; ++i) for (int j = 0; j < 4; ++j) acc[i][j] = 0.f;
    for (int k0 = 0; k0 < 512; k0 += 16) {
        for (int i = 0; i < 4; ++i) {
            int idx = tid + i * 256; int m = idx / 16, k = idx % 16;
            As[k][m] = (m0 + m < M) ? HID[(size_t)rows[m0 + m] * 512 + k0 + k] : 0.f;
            int kb = idx / 64, n = idx % 64;
            Bs[kb][n] = wd[(size_t)(k0 + kb) * 1024 + n0 + n];
        }
        __syncthreads();
        for (int k = 0; k < 16; ++k) {
            float a[4], b[4];
            for (int i = 0; i < 4; ++i) { a[i] = As[k][ty * 4 + i]; b[i] = Bs[k][tx * 4 + i]; }
            for (int i = 0; i < 4; ++i) for (int j = 0; j < 4; ++j) acc[i][j] = fmaf(a[i], b[j], acc[i][j]);
        }
        __syncthreads();
    }
    for (int i = 0; i < 4; ++i) for (int j = 0; j < 4; ++j) {
        int m = m0 + ty * 4 + i, n = n0 + tx * 4 + j;
        if (m < M) YE[(size_t)rows[m] * 1024 + n] = acc[i][j];
    }
}
__global__ void __launch_bounds__(256) moe_combine(const float* X1, const float* YE, const float* wts, float* X2) {
    const size_t t = blockIdx.x; const int c = threadIdx.x * 4;
    float4 x = *(const float4*)(X1 + t * 1024 + c), a = *(const float4*)(YE + (2 * t) * 1024 + c), b = *(const float4*)(YE + (2 * t + 1) * 1024 + c);
    float w0 = wts[2 * t], w1 = wts[2 * t + 1];
    float4 o; o.x = x.x + w0 * a.x + w1 * b.x; o.y = x.y + w0 * a.y + w1 * b.y; o.z = x.z + w0 * a.z + w1 * b.z; o.w = x.w + w0 * a.w + w1 * b.w;
    *(float4*)(X2 + t * 1024 + c) = o;
}
__global__ void __launch_bounds__(256) final_pl(const float* X2, const float* PE, const float* GATE, const float* g, float* out) {
    __shared__ float red[4];
    const size_t row = blockIdx.x; const int t = threadIdx.x;
    float4 v = *(const float4*)(PE + row * 1024 + t * 4);
    float ss = block_sum256(v.x * v.x + v.y * v.y + v.z * v.z + v.w * v.w, red);
    float r = rsqrtf(ss * (1.f / 1024.f) + 1e-6f);
    float4 gg = *(const float4*)(g + t * 4), x = *(const float4*)(X2 + row * 1024 + t * 4), ga = *(const float4*)(GATE + row * 1024 + t * 4);
    float4 o;
    o.x = x.x + v.x * r * gg.x / (1.f + expf(-ga.x)); o.y = x.y + v.y * r * gg.y / (1.f + expf(-ga.y));
    o.z = x.z + v.z * r * gg.z / (1.f + expf(-ga.z)); o.w = x.w + v.w * r * gg.w / (1.f + expf(-ga.w));
    *(float4*)(out + row * 1024 + t * 4) = o;
}

template <class AL, int ACT>
static void gemm(hipStream_t st, AL al, const float* B, int ldb, float* C, int ldc, const float* Cadd, int ldadd, int M, int N, int K) {
    dim3 grid((N + 63) / 64, (M + 63) / 64);
    sgemm<AL, ACT><<<grid, 256, 0, st>>>(al, B, ldb, C, ldc, Cadd, ldadd, M, nullptr, N, K);
}

struct NBufs { float *Z, *L1, *L2, *L3, *PE, *MIX, *Y, *X1; };
static NBufs forward_batch(void* const* d_in, int b, float* out, float* ws, hipStream_t st, int mode, int part) {
    auto F = [&](int i) { return (const float*)d_in[i]; };
    const float* x = F(0) + (size_t)b * S_ * D_; const float* p = F(1) + (size_t)b * S_ * 256; const int* pos = (const int*)d_in[2] + b * S_;
    size_t o = 0; auto take = [&](size_t n) { float* r = ws + o; o += (n + 63) / 64 * 64; return r; };
    float* HN = take((size_t)MB * 1024); float* Z = take((size_t)MB * 3072); float* MIX = take((size_t)MB * 1024);
    float* L1 = take((size_t)MB * 64); float* L2 = take((size_t)MB * 64); float* L3 = take((size_t)MB * 160);
    float* WL = take((size_t)MB * 512); float* AL = take((size_t)MB * 512); float* G = take((size_t)MB * 512);
    float* R = take((size_t)MB * 512); float* W = take((size_t)MB * 512); float* K2 = take((size_t)MB * 512); float* V = take((size_t)MB * 512);
    float* A2 = take((size_t)MB * 512); float* B2 = take((size_t)MB * 512); float* Y = take((size_t)MB * 512);
    float* X1 = take((size_t)MB * 1024); float* H2 = take((size_t)MB * 1024); float* LOG = take((size_t)MB * 36);
    float* wts = take((size_t)MB * 2); int* cnt = (int*)take(64); int* list = (int*)take((size_t)32 * MB);
    float* HID = take((size_t)MB * 2 * 512); float* YE = take((size_t)MB * 2 * 1024); float* X2 = take((size_t)MB * 1024);
    float* PE = take((size_t)MB * 1024); float* GATE = take((size_t)MB * 1024);

    NBufs nb{Z, L1, L2, L3, PE, MIX, Y, X1};
    if (part == 0) return nb;
    if (mode == 0) {
    rmsnorm1024<<<MB, 256, 0, st>>>(x, F(3), HN, 1e-6f);
    gemm<ALPlain, 0>(st, ALPlain{HN, 1024, 0}, F(4), 3072, Z, 3072, nullptr, 0, MB, 3072, 1024);
    gemm<ALShiftMix, 1>(st, ALShiftMix{HN, F(13)}, F(15), 64, L1, 64, nullptr, 0, MB, 64, 1024);
    gemm<ALShiftMix, 0>(st, ALShiftMix{HN, F(13) + 1024}, F(18), 64, L2, 64, nullptr, 0, MB, 64, 1024);
    gemm<ALShiftMix, 2>(st, ALShiftMix{HN, F(13) + 2048}, F(20), 160, L3, 160, nullptr, 0, MB, 160, 1024);
    }
    if (mode < 3) {
    gemm<ALPlain, 0>(st, ALPlain{L1, 64, 0}, F(16), 512, WL, 512, nullptr, 0, MB, 512, 64);
    gemm<ALPlain, 0>(st, ALPlain{L2, 64, 0}, F(19), 512, AL, 512, nullptr, 0, MB, 512, 64);
    gemm<ALPlain, 0>(st, ALPlain{L3, 160, 0}, F(21), 512, G, 512, nullptr, 0, MB, 512, 160);
    rwkv_prep<<<MB * 8 / 4, 256, 0, st>>>(Z, WL, AL, F(12), F(14), F(17), F(22), F(23), R, W, K2, V, A2, B2);
    rwkv_scan_naive<<<8, 64, 0, st>>>(R, W, K2, V, A2, B2, Y);
    rwkv_post<<<MB * 8 / 4, 256, 0, st>>>(Y, R, K2, V, G, F(24), F(25), F(26), MIX);
    }
    if (mode == 0) qk_prep<<<MB * 16 / 4, 256, 0, st>>>(Z, pos, F(5), F(6));
    if (mode < 2) attn_naive<<<dim3(S_ / 32, 4), 256, 0, st>>>(Z, MIX, F(7), F(8), F(9), F(10), F(11));
    gemm<ALPlain, 0>(st, ALPlain{MIX, 1024, 0}, F(27), 1024, X1, 1024, x, 1024, MB, 1024, 1024);
    rmsnorm1024<<<MB, 256, 0, st>>>(X1, F(28), H2, 1e-6f);
    gemm<ALPlain, 0>(st, ALPlain{H2, 1024, 0}, F(29), 4, LOG, 36, nullptr, 0, MB, 4, 1024);
    for (int g = 0; g < 4; ++g) gemm<ALPlain, 0>(st, ALPlain{H2, 1024, 0}, F(30) + (size_t)g * 1024 * 8, 8, LOG + 4 + 8 * g, 36, nullptr, 0, MB, 8, 1024);
    hipMemsetAsync(cnt, 0, 64 * sizeof(int), st);
    route<<<MB / 256, 256, 0, st>>>(LOG, cnt, list, wts, MB, MB);
    expert_up<<<dim3(512 / 64, MB / 64, 32), 256, 0, st>>>(H2, F(31), F(32), cnt, list, HID, MB);
    expert_down<<<dim3(1024 / 64, MB / 64, 32), 256, 0, st>>>(HID, F(33), cnt, list, YE, MB);
    moe_combine<<<MB, 256, 0, st>>>(X1, YE, wts, X2);
    rmsnorm1024<<<MB, 256, 0, st>>>(X2, F(36), H2, 1e-6f);
    gemm<ALPlain, 0>(st, ALPlain{H2, 1024, 0}, F(37), 1024, GATE, 1024, nullptr, 0, MB, 1024, 1024);
    if (mode == 0) gemm<ALPlain, 0>(st, ALPlain{p, 256, 0}, F(34), 1024, PE, 1024, nullptr, 0, MB, 1024, 256);
    final_pl<<<MB, 256, 0, st>>>(X2, PE, GATE, F(35), out);
    return nb;
}
}

namespace mk {
#define LAS __attribute__((address_space(3)))
#define GAS __attribute__((address_space(1)))
typedef _Float16 f16;
typedef _Float16 h8 __attribute__((ext_vector_type(8)));
typedef _Float16 h4 __attribute__((ext_vector_type(4)));
typedef _Float16 h2 __attribute__((ext_vector_type(2)));
typedef float f32x4 __attribute__((ext_vector_type(4)));
typedef float f32x2 __attribute__((ext_vector_type(2)));
typedef float f32x16 __attribute__((ext_vector_type(16)));
typedef unsigned u32x4 __attribute__((ext_vector_type(4)));
typedef unsigned u32x2 __attribute__((ext_vector_type(2)));

constexpr int NB = MK_NB;
constexpr int SEQ = 2048, DM = 1024;
constexpr int M = NB * SEQ;
constexpr int BM = 256, BK = 64, HALF = 128, HTB = HALF * BK * 2, STAGE_BYTES = 8 * HTB, NXCD = 8, WGM = 8;
constexpr int NWAVES = 8, NTHR = 512;
constexpr float C2 = 0.125f * 1.4426950408889634f;

__device__ __forceinline__ unsigned pkh(float lo, float hi) { h2 v = {(f16)lo, (f16)hi}; return __builtin_bit_cast(unsigned, v); }

__host__ __device__ __forceinline__ int lds_byte(int r, int c) { const int st = (r >> 4) * 2 + (c >> 5), rr = r & 15, cc = c & 31, ob = rr * 64 + cc * 2; return st * 1024 + (ob ^ (((ob >> 9) & 1) << 5)); }
__host__ __device__ __forceinline__ void stage_rc(int b, int& R, int& C) { const int st = b / 1024, sb = b % 1024, swz = sb ^ (((sb >> 9) & 1) << 5); R = (st >> 1) * 16 + swz / 64; C = (st & 1) * 32 + (swz % 64) / 2; }
__host__ __device__ __forceinline__ int perm32(int rho) { const int n = rho >> 4, i = rho & 15; return 8 * (i >> 2) + 4 * n + (i & 3); }

struct GU { const char* a; const char* b; char* o; const int* glist; const int* elist; int nt, lda2, ldb2, hsa, hsb, bmode, epi, pm, pn, aux, ldc, oc0, gcnt; };

template <class Sched, class Epi>
__device__ __forceinline__ void gemm_phase(LAS unsigned char* lds, const Sched& S, const Epi& E, const int tid) {
    const int wid = __builtin_amdgcn_readfirstlane(tid >> 6), lane = tid & 63, wr = wid >> 2, wc = wid & 3, fr = lane & 15, fq = lane >> 4;
    unsigned voffA[2], voffAh[2], voffB[2]; int hsB;
#define MK_SETV(u) do { int ln_; asm volatile("v_mbcnt_lo_u32_b32 %0, -1, 0\n\tv_mbcnt_hi_u32_b32 %0, -1, %0" : "=v"(ln_)); const int t16_ = (wid * 64 + ln_) * 16; \
        int R0, C0, R1, C1; stage_rc(t16_, R0, C0); stage_rc(t16_ + 8192, R1, C1); \
        if ((u).glist) { \
            const int g00 = R0 < (u).gcnt ? (u).glist[R0] >> 1 : 0, g01 = R1 < (u).gcnt ? (u).glist[R1] >> 1 : 0, g10 = R0 + 128 < (u).gcnt ? (u).glist[R0 + 128] >> 1 : 0, g11 = R1 + 128 < (u).gcnt ? (u).glist[R1 + 128] >> 1 : 0; \
            voffA[0] = (unsigned)(g00 * (u).lda2 + C0 * 2); voffA[1] = (unsigned)(g01 * (u).lda2 + C1 * 2); voffAh[0] = (unsigned)(g10 * (u).lda2 + C0 * 2); voffAh[1] = (unsigned)(g11 * (u).lda2 + C1 * 2); \
        } else { voffA[0] = (unsigned)(R0 * (u).lda2 + C0 * 2); voffA[1] = (unsigned)(R1 * (u).lda2 + C1 * 2); voffAh[0] = voffA[0] + (unsigned)(u).hsa; voffAh[1] = voffA[1] + (unsigned)(u).hsa; } \
        const int rb0 = (u).bmode == 0 ? R0 : (u).bmode == 1 ? ((R0 & ~31) + perm32(R0 & 31)) : (64 * ((R0 >> 5) & 3) + perm32(R0 & 31)); \
        const int rb1 = (u).bmode == 0 ? R1 : (u).bmode == 1 ? ((R1 & ~31) + perm32(R1 & 31)) : (64 * ((R1 >> 5) & 3) + perm32(R1 & 31)); \
        voffB[0] = (unsigned)(rb0 * (u).ldb2 + C0 * 2); voffB[1] = (unsigned)(rb1 * (u).ldb2 + C1 * 2); hsB = (u).hsb; } while (0)
    const size_t kstep = (size_t)(BK * 2);
    const unsigned ldsw = (unsigned)wid * 1024u;
    const int aoff = lds_byte(wr * 64 + fr, fq * 8), boff = lds_byte(wc * 32 + fr, fq * 8);
#define MK_SA(b, h) (((b) * 2 + (h)) * HTB)
#define MK_SB(b, h) ((4 + (b) * 2 + (h)) * HTB)
#define MK_STAGE(bufoff, gbase, voff) do { _Pragma("unroll") for (int _i = 0; _i < 2; ++_i) \
        __builtin_amdgcn_global_load_lds((const unsigned*)((const char*)(gbase) + (voff)[_i]), (LAS unsigned*)(lds + (bufoff) + ldsw + _i * 8192), 16, 0, 0); } while (0)
#define MK_LDA(dst, b, h) do { _Pragma("unroll") for (int m = 0; m < 4; ++m) _Pragma("unroll") for (int k = 0; k < 2; ++k) dst[m][k] = *(const LAS h8*)(lds + MK_SA(b, h) + aoff + m * 2048 + k * 1024); } while (0)
#define MK_LDB(dst, b, h) do { _Pragma("unroll") for (int n = 0; n < 2; ++n) _Pragma("unroll") for (int k = 0; k < 2; ++k) dst[n][k] = *(const LAS h8*)(lds + MK_SB(b, h) + boff + n * 2048 + k * 1024); } while (0)
#define MK_MMA(ai, bj, At, Bt) do { __builtin_amdgcn_s_setprio(1); _Pragma("unroll") for (int m = 0; m < 4; ++m) _Pragma("unroll") for (int n = 0; n < 2; ++n) _Pragma("unroll") for (int k = 0; k < 2; ++k) \
        acc[ai][bj][m][n] = __builtin_amdgcn_mfma_f32_16x16x32_f16(Bt[n][k], At[m][k], acc[ai][bj][m][n], 0, 0, 0); __builtin_amdgcn_s_setprio(0); } while (0)
#define MK_WAIT_V(n) asm volatile("s_waitcnt vmcnt(" #n ")" ::: "memory")
#define MK_WAIT_L(n) asm volatile("s_waitcnt lgkmcnt(" #n ")" ::: "memory")
#define MK_BAR __builtin_amdgcn_s_barrier()
#define MK_SCHED __builtin_amdgcn_sched_barrier(0)
    GU cur, nxt; int ui = 0;
    if (!S.next(0, cur)) return;
    f32x4 acc[2][2][4][2];
#pragma unroll
    for (int a = 0; a < 2; ++a)
#pragma unroll
        for (int b = 0; b < 2; ++b)
#pragma unroll
            for (int m = 0; m < 4; ++m)
#pragma unroll
                for (int n = 0; n < 2; ++n) acc[a][b][m][n] = (f32x4){0.f, 0.f, 0.f, 0.f};
    h8 At[4][2], B0[2][2], B1[2][2];
    const char* cA = cur.a; const char* cB = cur.b;
    MK_SETV(cur);
    MK_STAGE(MK_SB(0, 0), cB, voffB); MK_STAGE(MK_SB(0, 1), cB + hsB, voffB); MK_STAGE(MK_SA(0, 0), cA, voffA); MK_STAGE(MK_SA(0, 1), cA, voffAh);
    if (wr == 1) MK_BAR;
    MK_WAIT_V(2); MK_BAR;
    MK_STAGE(MK_SB(1, 0), cB + kstep, voffB); MK_STAGE(MK_SA(1, 0), cA + kstep, voffA); MK_STAGE(MK_SB(1, 1), cB + hsB + kstep, voffB);
    MK_WAIT_V(6); MK_BAR;
    for (;;) {
        bool has_next = false; const char* nA = cA; const char* nB = cB;
        const int nt = cur.nt;
        for (int t = 0; t < nt; t += 2) {
            const bool last = (t == nt - 2);
            if (last) { has_next = S.next(ui + 1, nxt); if (has_next) { nA = nxt.a; nB = nxt.b; } }
            const char* a1 = cA + (size_t)(t + 1) * kstep;
            const char* a2 = last ? nA : cA + (size_t)(t + 2) * kstep; const char* b2 = last ? nB : cB + (size_t)(t + 2) * kstep;
            const char* a3 = a2 + kstep; const char* b3 = b2 + kstep;
            MK_LDB(B0, 0, 0); MK_LDB(B1, 0, 1); MK_SCHED; MK_LDA(At, 0, 0); MK_STAGE(MK_SA(1, 1), a1, voffAh);
            if (last && has_next) { MK_SETV(nxt); }
            MK_WAIT_V(8); MK_WAIT_L(0); MK_BAR; MK_MMA(0, 0, At, B0); MK_MMA(0, 1, At, B1); MK_BAR; MK_SCHED;
            MK_LDA(At, 0, 1); MK_STAGE(MK_SB(0, 0), b2, voffB); MK_STAGE(MK_SB(0, 1), b2 + hsB, voffB); MK_STAGE(MK_SA(0, 0), a2, voffA);
            MK_WAIT_V(8); MK_WAIT_L(0); MK_BAR; MK_MMA(1, 0, At, B0); MK_MMA(1, 1, At, B1); MK_BAR; MK_SCHED;
            MK_LDB(B0, 1, 0); MK_LDB(B1, 1, 1); MK_SCHED; MK_LDA(At, 1, 0); MK_STAGE(MK_SA(0, 1), a2, voffAh);
            MK_WAIT_V(8); MK_WAIT_L(0); MK_BAR; MK_MMA(0, 0, At, B0); MK_MMA(0, 1, At, B1); MK_BAR; MK_SCHED;
            MK_LDA(At, 1, 1); MK_STAGE(MK_SB(1, 0), b3, voffB); MK_STAGE(MK_SB(1, 1), b3 + hsB, voffB); MK_STAGE(MK_SA(1, 0), a3, voffA);
            MK_WAIT_V(8); MK_WAIT_L(0); MK_BAR; MK_MMA(1, 0, At, B0); MK_MMA(1, 1, At, B1); MK_BAR; MK_SCHED;
        }
        if (wr == 0) MK_BAR;
        E(acc, cur, wr, wc, fr, fq);
        if (!has_next) break;
#pragma unroll
        for (int a = 0; a < 2; ++a)
#pragma unroll
            for (int b = 0; b < 2; ++b)
#pragma unroll
                for (int m = 0; m < 4; ++m)
#pragma unroll
                    for (int n = 0; n < 2; ++n) acc[a][b][m][n] = (f32x4){0.f, 0.f, 0.f, 0.f};
        cur = nxt; cA = nA; cB = nB; ++ui;
        if (wr == 1) MK_BAR;
    }
    MK_WAIT_V(0);
    MK_BAR;
#undef MK_SETV
#undef MK_SA
#undef MK_SB
#undef MK_STAGE
#undef MK_LDA
#undef MK_LDB
#undef MK_MMA
#undef MK_WAIT_V
#undef MK_WAIT_L
#undef MK_BAR
#undef MK_SCHED
}
}
namespace attn_body {
using mk::h8; using mk::f16;
using bf16=_Float16;
using bf16x8=mk::h8;
using s16x4=__attribute__((ext_vector_type(4)))short; using s16x8=__attribute__((ext_vector_type(8)))short;
using f32x16=__attribute__((ext_vector_type(16)))float;
using u32x4=__attribute__((ext_vector_type(4)))unsigned;
constexpr int BATCH=MK_NB,NHEAD=16,SEQ=2048,D=64,DM=1024; constexpr int QKP=512,VP=512,OP=1024;
constexpr int NW=8,QBLK=32,QB=QBLK*NW,KVBLK=64,NQB=SEQ/QB;
constexpr int ATTN_PITCH=DM, ATTN_UNIT_ROWS=QB;
__device__ __forceinline__ int crow(int r,int hi){return (r&3)+8*(r>>2)+4*hi;}
#define SBAR() __builtin_amdgcn_sched_barrier(0)
__device__ __forceinline__ void cmask(f32x16&p0,f32x16&p1,int jb,int qrel,int hi){
  const float NEG=-INFINITY; int kb=64*jb+4*hi;
  #pragma unroll
  for(int r=0;r<16;++r){int kv=kb+(r&3)+8*(r>>2); if(kv>qrel)p0[r]=NEG; if(kv+32>qrel)p1[r]=NEG;}
}

constexpr int NSLOT=3, SLOTB=8192;
constexpr int LDS_K=0, LDS_V=NSLOT*SLOTB, LDS_WS=2*NSLOT*SLOTB, LDS_OST=LDS_WS+NW*64*4, LDS_BYTES=LDS_OST+NW*4096;
constexpr float C2=0.125f*1.4426950408889634f;
__device__ __forceinline__ void glds16(const void*gsrc,unsigned lds_dst){unsigned keep;
  asm volatile("s_mov_b32 %0, m0\n\ts_mov_b32 m0, %2\n\ts_nop 0\n\tglobal_load_lds_dwordx4 %1, off\n\ts_mov_b32 m0, %0":"=&s"(keep):"v"(gsrc),"s"(lds_dst):"memory");}
__device__ __forceinline__ float max3f(float a,float b,float c){float r;asm("v_max3_f32 %0, %1, %2, %3":"=v"(r):"v"(a),"v"(b),"v"(c));return r;}
__device__ __forceinline__ float max2f(float a,float b){float r;asm("v_max_f32_e32 %0, %1, %2":"=v"(r):"v"(a),"v"(b));return r;}
__device__ __forceinline__ float fadd_s(float a,float b){float r;asm("v_add_f32_e32 %0, %1, %2":"=v"(r):"v"(a),"v"(b));return r;}
__device__ __forceinline__ float fsub_s(float a,float b){float r;asm("v_sub_f32_e32 %0, %1, %2":"=v"(r):"v"(a),"v"(b));return r;}
typedef float f32x2_t __attribute__((ext_vector_type(2))); typedef _Float16 bf16x2_t __attribute__((ext_vector_type(2)));
__device__ __forceinline__ unsigned cvtpk_s(float lo,float hi){f32x2_t v={lo,hi};bf16x2_t b=__builtin_convertvector(v,bf16x2_t);return __builtin_bit_cast(unsigned,b);}
#define WAIT_BAR(N) asm volatile("s_waitcnt vmcnt(" #N ") lgkmcnt(0)\n\ts_barrier":::"memory")

__device__ __forceinline__ void qkt(f32x16&p0,f32x16&p1,const char*Kslot,const bf16x8*qr,const f32x16&negm,int r32,int hi){
  const char*kb=Kslot+hi*1024+r32*16;
  #pragma unroll
  for(int d0=0;d0<4;++d0){
    const bf16x8 b0=*reinterpret_cast<const bf16x8*>(kb+d0*2048);
    const bf16x8 b1=*reinterpret_cast<const bf16x8*>(kb+d0*2048+512);
    if(d0==0){p0=__builtin_amdgcn_mfma_f32_32x32x16_f16(b0,qr[0],negm,0,0,0);p1=__builtin_amdgcn_mfma_f32_32x32x16_f16(b1,qr[0],negm,0,0,0);}
    else{p0=__builtin_amdgcn_mfma_f32_32x32x16_f16(b0,qr[d0],p0,0,0,0);p1=__builtin_amdgcn_mfma_f32_32x32x16_f16(b1,qr[d0],p1,0,0,0);}}
}
typedef __attribute__((address_space(3))) const char* lds_cptr;
typedef short v4i16_t __attribute__((ext_vector_type(4)));
__device__ __forceinline__ void kload8(bf16x8*kf,lds_cptr kp){
  kf[0]=*(const __attribute__((address_space(3))) bf16x8*)(kp);      kf[1]=*(const __attribute__((address_space(3))) bf16x8*)(kp+512);
  kf[2]=*(const __attribute__((address_space(3))) bf16x8*)(kp+2048); kf[3]=*(const __attribute__((address_space(3))) bf16x8*)(kp+2560);
  kf[4]=*(const __attribute__((address_space(3))) bf16x8*)(kp+4096); kf[5]=*(const __attribute__((address_space(3))) bf16x8*)(kp+4608);
  kf[6]=*(const __attribute__((address_space(3))) bf16x8*)(kp+6144); kf[7]=*(const __attribute__((address_space(3))) bf16x8*)(kp+6656);
}
__device__ __forceinline__ void kload2(bf16x8*kf,lds_cptr kp,int j){ kf[2*j]=*(const __attribute__((address_space(3))) bf16x8*)(kp+j*2048); kf[2*j+1]=*(const __attribute__((address_space(3))) bf16x8*)(kp+j*2048+512); }
__device__ __forceinline__ s16x4 vtr(lds_cptr p){ return __builtin_bit_cast(s16x4,__builtin_amdgcn_ds_read_tr16_b64_v4i16((__attribute__((address_space(3))) v4i16_t*)p)); }
__device__ __forceinline__ float rowmax(const f32x16&p0,const f32x16&p1){
  float a=max3f(p0[0],p0[1],p1[0]),b=max3f(p0[2],p0[3],p1[1]);a=max3f(a,p1[2],p1[3]);
  #pragma unroll
  for(int r=4;r<16;r+=4){a=max3f(a,p0[r],p0[r+1]);b=max3f(b,p0[r+2],p0[r+3]);a=max3f(a,p1[r],p1[r+1]);b=max3f(b,p1[r+2],p1[r+3]);}
  const float m=max2f(a,b);
  auto rr=__builtin_amdgcn_permlane32_swap(__float_as_uint(m),__float_as_uint(m),false,false);
  return max2f(__uint_as_float(rr[0]),__uint_as_float(rr[1]));
}
__device__ __forceinline__ void pv(f32x16*o,int vb,bf16x8 pa0,bf16x8 pa1,bf16x8 pa2,bf16x8 pa3){
  #pragma unroll
  for(int d0=0;d0<2;++d0){s16x4 lo[4],hi[4];
    #pragma unroll
    for(int ks=0;ks<4;++ks){
      asm volatile("ds_read_b64_tr_b16 %0,%1 offset:%c2":"=&v"(lo[ks]):"v"(vb),"i"(d0*4096+ks*1024):"memory");
      asm volatile("ds_read_b64_tr_b16 %0,%1 offset:%c2":"=&v"(hi[ks]):"v"(vb),"i"(d0*4096+ks*1024+512):"memory");}
    asm volatile("s_waitcnt lgkmcnt(0)":::"memory");SBAR();
    #define PK(k) __builtin_bit_cast(bf16x8,(s16x8){lo[k][0],lo[k][1],lo[k][2],lo[k][3],hi[k][0],hi[k][1],hi[k][2],hi[k][3]})
    o[d0]=__builtin_amdgcn_mfma_f32_32x32x16_f16(pa0,PK(0),o[d0],0,0,0);
    o[d0]=__builtin_amdgcn_mfma_f32_32x32x16_f16(pa1,PK(1),o[d0],0,0,0);
    o[d0]=__builtin_amdgcn_mfma_f32_32x32x16_f16(pa2,PK(2),o[d0],0,0,0);
    o[d0]=__builtin_amdgcn_mfma_f32_32x32x16_f16(pa3,PK(3),o[d0],0,0,0);
    #undef PK
  }
}

#ifndef ATTN_STORE16
#define ATTN_STORE16(p,v) (*(u32x4*)(p)=(v))
#endif
template<int THRL> __device__ __forceinline__ void attn_unit(int b,int vh,int qb,const bf16*Q,const bf16*__restrict__ K,const bf16*__restrict__ V,bf16*O,char*shm,const int wave_s){
  int tid; asm volatile("v_mbcnt_lo_u32_b32 %0, -1, 0\n\tv_mbcnt_hi_u32_b32 %0, -1, %0" : "=v"(tid)); tid+=wave_s*64;
  const int hh=vh>>2,mp=(vh>>1)&1,vhf=vh&1; const int qcol=hh*128+mp*64, vcol=hh*128+vhf*64, ocol=mp*512+hh*128+vhf*64;
  const int lane=tid&63,r32=lane&31,hi=lane>>5; const int wid=__builtin_amdgcn_readfirstlane(tid>>6);
  const long rowbase=(long)b*SEQ; const int q0=qb*QB;
  const bf16*Qw=Q+(rowbase+q0+wid*QBLK)*QKP+qcol;
  const bf16*Kh=K+rowbase*QKP+qcol,*Vh=V+rowbase*VP+vcol;
  const unsigned lds0=(unsigned)(uintptr_t)shm;
  float*wsf=(float*)(shm+LDS_WS)+wid*64;
  const bf16*ksrc=Kh+(long)lane*QKP+wid*8;
  const bf16*vsrc=Vh+(long)(16*(wid&3)+(lane>>2))*VP+(wid>>2)*32+(lane&3)*8;
  const unsigned kdst=lds0+LDS_K+wid*1024, vdst=lds0+LDS_V+wid*1024;
  #define DMA_K(t,slot) glds16(ksrc+(long)(t)*KVBLK*QKP,(unsigned)__builtin_amdgcn_readfirstlane(kdst+(slot)))
  #define DMA_V(t,slot) glds16(vsrc+(long)(t)*KVBLK*VP,(unsigned)__builtin_amdgcn_readfirstlane(vdst+(slot)))
  const int vb0=(int)(lds0+LDS_V)+((lane>>4)&1)*32+(lane&3)*8+(4*hi+((lane&15)>>2))*64;
  const char*Kbase=shm+LDS_K; bf16x8 kf[8];
  const lds_cptr shm3=(lds_cptr)shm; const lds_cptr kp0=shm3+LDS_K+hi*1024+r32*16; const lds_cptr vp0=shm3+LDS_V+((lane>>4)&1)*32+(lane&3)*8+(4*hi+((lane&15)>>2))*64;
  const int NT=(q0+QB)/KVBLK;
  DMA_K(0,0);DMA_V(0,0);DMA_K(1,SLOTB);
  bf16x8 qr[4];
  #pragma unroll
  for(int d0=0;d0<4;++d0)qr[d0]=*reinterpret_cast<const bf16x8*>(&Qw[(long)r32*QKP+d0*16+hi*8]);
  float mhat=0.f,l_reg=0.f;f32x16 o[2];o[0]=f32x16{};o[1]=f32x16{};f32x16 negm=f32x16{};asm volatile("":"+v"(negm));
  const int qrel=wid*QBLK+r32;
  #define CMASK(P0,P1,t) do{int jb_=(t)-(NT-4); if(jb_>=0)cmask(P0,P1,jb_,qrel,hi);}while(0)
  bool resc=false;
  #define START(P0,P1) do{ const float rm=rowmax(P0,P1); resc=false; \
    { const float dl=rm; mhat=fadd_s(mhat,dl); \
      _Pragma("unroll") for(int r=0;r<16;++r){P0[r]=fsub_s(P0[r],dl);P1[r]=fsub_s(P1[r],dl);} \
      _Pragma("unroll") for(int r=0;r<16;++r)negm[r]=-mhat; asm volatile("":"+v"(negm)); } \
    _Pragma("unroll") for(int r=0;r<16;++r)P0[r]=__builtin_amdgcn_exp2f(P0[r]); }while(0)
  #define RESC() do{ if(resc){ asm volatile("s_waitcnt lgkmcnt(0)":::"memory"); \
      _Pragma("unroll") for(int d_=0;d_<2;++d_) _Pragma("unroll") for(int r=0;r<16;++r)o[d_][r]*=wsf[crow(r,hi)]; } }while(0)
  f32x16 pA0,pA1,pB0,pB1;
  int sl_prev=0,sl_cur=0,sl_next=SLOTB;
  #define ROT() do{sl_prev=sl_cur;sl_cur=sl_next;sl_next=(sl_next==(NSLOT-1)*SLOTB)?0:sl_next+SLOTB;}while(0)
  DMA_K(2,2*SLOTB);
  WAIT_BAR(3);
  qkt(pA0,pA1,Kbase,qr,negm,r32,hi);asm volatile("s_nop 15\n\ts_nop 7":"+v"(pA0),"+v"(pA1));CMASK(pA0,pA1,0);
  START(pA0,pA1);
  _Pragma("unroll") for(int r=0;r<16;++r)pA1[r]=__builtin_amdgcn_exp2f(pA1[r]);
  WAIT_BAR(0);
  DMA_K(3,0);DMA_V(1,SLOTB);
  ROT();
  kload8(kf,kp0+sl_cur);
  WAIT_BAR(2);
  s16x4 vlo[8],vhi[8]; u32x4 pw0,pw1,pw2,pw3;
  #define PKW(P,B) cvtpk_s(P[B],P[B+1])
  #define PAF(k) __builtin_bit_cast(bf16x8,pw##k)
  #define VFR(i) __builtin_bit_cast(bf16x8,(s16x8){vlo[i][0],vlo[i][1],vlo[i][2],vlo[i][3],vhi[i][0],vhi[i][1],vhi[i][2],vhi[i][3]})
  #define PIN(x) asm volatile("":"+v"(x))
  #define MX3(a,b,c) __builtin_fmaxf(__builtin_fmaxf((a),(b)),(c))
  #define GAPA(MF,A0,A1,A2,A3,W0,W1,PW) do{ MF; sacc+=A0; sacc+=A1; sacc+=A2; sacc+=A3; PIN(sacc); W0; W1; PIN(PW); SBAR(); }while(0)
  #define EX(v) __builtin_amdgcn_exp2f(v)
  #define GAPB(MF,X,B) do{ MF; X[B]=EX(X[B]); X[B+1]=EX(X[B+1]); X[B+2]=EX(X[B+2]); X[B+3]=EX(X[B+3]); PIN(X); SBAR(); }while(0)
  #define VRD(i) do{ vlo[i]=vtr(vp_+(((i)>>2)*4096+((i)&3)*1024)); vhi[i]=vtr(vp_+(((i)>>2)*4096+((i)&3)*1024+512)); }while(0)
  #define KRD(G,j) do{ if(G){ kload2(kf,kp0+sl_next,j); SBAR(); } }while(0)
  #define STEP(C0,C1,P0,P1,t,GK,GV,GL) do{ SBAR(); \
    const lds_cptr vp_=vp0+sl_prev; \
    VRD(0); SBAR(); float sacc=(P0[0]+P0[1]); \
    GAPA(C0=__builtin_amdgcn_mfma_f32_32x32x16_f16(kf[0],qr[0],negm,0,0,0), P0[2],P0[3],P0[4],P0[5],     pw0[0]=PKW(P0,0), pw0[1]=PKW(P0,2), pw0); \
    VRD(4); SBAR(); GAPA(C1=__builtin_amdgcn_mfma_f32_32x32x16_f16(kf[1],qr[0],negm,0,0,0), P0[6],P0[7],P0[8],P0[9],     pw0[2]=PKW(P0,4), pw0[3]=PKW(P0,6), pw0); \
    VRD(1); SBAR(); GAPA(C0=__builtin_amdgcn_mfma_f32_32x32x16_f16(kf[2],qr[1],C0,0,0,0),   P0[10],P0[11],P0[12],P0[13], pw1[0]=PKW(P0,8), pw1[1]=PKW(P0,10), pw1); \
    VRD(5); SBAR(); GAPA(C1=__builtin_amdgcn_mfma_f32_32x32x16_f16(kf[3],qr[1],C1,0,0,0),   P0[14],P0[15],P1[0],P1[1],   pw1[2]=PKW(P0,12),pw1[3]=PKW(P0,14), pw1); \
    VRD(2); SBAR(); GAPA(C0=__builtin_amdgcn_mfma_f32_32x32x16_f16(kf[4],qr[2],C0,0,0,0),   P1[2],P1[3],P1[4],P1[5],     pw2[0]=PKW(P1,0), pw2[1]=PKW(P1,2), pw2); \
    VRD(6); SBAR(); GAPA(C1=__builtin_amdgcn_mfma_f32_32x32x16_f16(kf[5],qr[2],C1,0,0,0),   P1[6],P1[7],P1[8],P1[9],     pw2[2]=PKW(P1,4), pw2[3]=PKW(P1,6), pw2); \
    VRD(3); SBAR(); GAPA(C0=__builtin_amdgcn_mfma_f32_32x32x16_f16(kf[6],qr[3],C0,0,0,0),   P1[10],P1[11],P1[12],P1[13], pw3[0]=PKW(P1,8), pw3[1]=PKW(P1,10), pw3); \
    VRD(7); SBAR(); GAPA(C1=__builtin_amdgcn_mfma_f32_32x32x16_f16(kf[7],qr[3],C1,0,0,0),   P1[14],P1[15],0.f,0.f,       pw3[2]=PKW(P1,12),pw3[3]=PKW(P1,14), pw3); \
    l_reg+=sacc; \
    if(GK){DMA_K((t)+3,sl_cur);} if(GV){DMA_V((t)+1,sl_next);} \
    CMASK(C0,C1,t); \
    { float a=MX3(C0[0],C0[1],C1[0]),b=MX3(C0[2],C0[3],C1[1]); a=MX3(a,C1[2],C1[3]); \
      _Pragma("unroll") for(int r=4;r<16;r+=4){a=MX3(a,C0[r],C0[r+1]);b=MX3(b,C0[r+2],C0[r+3]);a=MX3(a,C1[r],C1[r+1]);b=MX3(b,C1[r+2],C1[r+3]);} \
      float rm=__builtin_fmaxf(a,b); { auto rr=__builtin_amdgcn_permlane32_swap(__float_as_uint(rm),__float_as_uint(rm),false,false); rm=__builtin_fmaxf(__uint_as_float(rr[0]),__uint_as_float(rr[1])); } \
      resc=false; \
      if(__builtin_expect(__any(rm>(float)THRL),0)){ const float dl=__builtin_fmaxf(rm,0.f); mhat+=dl; \
        _Pragma("unroll") for(int r=0;r<16;++r){C0[r]-=dl;C1[r]-=dl;} \
        _Pragma("unroll") for(int r=0;r<16;++r)negm[r]=-mhat; asm volatile("":"+v"(negm)); \
        const float f=__builtin_amdgcn_exp2f(-dl); l_reg*=f; if(hi==0)wsf[r32]=f; resc=true; } } \
    SBAR(); \
    GAPB(o[0]=__builtin_amdgcn_mfma_f32_32x32x16_f16(PAF(0),VFR(0),o[0],0,0,0), C0,0); \
    GAPB(o[1]=__builtin_amdgcn_mfma_f32_32x32x16_f16(PAF(0),VFR(4),o[1],0,0,0), C0,4); \
    KRD(GL,0); GAPB(o[0]=__builtin_amdgcn_mfma_f32_32x32x16_f16(PAF(1),VFR(1),o[0],0,0,0), C0,8); \
    KRD(GL,1); GAPB(o[1]=__builtin_amdgcn_mfma_f32_32x32x16_f16(PAF(1),VFR(5),o[1],0,0,0), C0,12); \
    KRD(GL,2); GAPB(o[0]=__builtin_amdgcn_mfma_f32_32x32x16_f16(PAF(2),VFR(2),o[0],0,0,0), C1,0); \
    KRD(GL,3); GAPB(o[1]=__builtin_amdgcn_mfma_f32_32x32x16_f16(PAF(2),VFR(6),o[1],0,0,0), C1,4); \
    GAPB(o[0]=__builtin_amdgcn_mfma_f32_32x32x16_f16(PAF(3),VFR(3),o[0],0,0,0), C1,8); \
    GAPB(o[1]=__builtin_amdgcn_mfma_f32_32x32x16_f16(PAF(3),VFR(7),o[1],0,0,0), C1,12); \
    }while(0)
  int t=1;
  #undef CMASK
  #define CMASK(P0,P1,t) do{}while(0)
  for(;t+5<NT;t+=2){
    STEP(pB0,pB1,pA0,pA1,t,true,true,true);     WAIT_BAR(2); RESC(); ROT();
    STEP(pA0,pA1,pB0,pB1,t+1,true,true,true);   WAIT_BAR(2); RESC(); ROT();
  }
  #undef CMASK
  #define CMASK(P0,P1,t) do{int jb_=(t)-(NT-4); if(jb_>=0)cmask(P0,P1,jb_,qrel,hi);}while(0)
  #define ENDW(tt) do{ if((tt)+3<NT){WAIT_BAR(2);} else if((tt)+2<NT){WAIT_BAR(1);} else {WAIT_BAR(0);} }while(0)
  for(;t+1<NT;t+=2){
    STEP(pB0,pB1,pA0,pA1,t,(t+3<NT),(t+1<NT),(t+1<NT));       ENDW(t);   RESC(); ROT();
    STEP(pA0,pA1,pB0,pB1,t+1,(t+4<NT),(t+2<NT),(t+2<NT));     ENDW(t+1); RESC(); ROT();
  }
  STEP(pB0,pB1,pA0,pA1,NT-1,false,false,false); RESC();
  { float sacc=pB0[0]+pB0[1]; _Pragma("unroll") for(int r=2;r<16;++r)sacc+=pB0[r]; _Pragma("unroll") for(int r=0;r<16;++r)sacc+=pB1[r]; l_reg+=sacc;
    pw0=(u32x4){PKW(pB0,0),PKW(pB0,2),PKW(pB0,4),PKW(pB0,6)};pw1=(u32x4){PKW(pB0,8),PKW(pB0,10),PKW(pB0,12),PKW(pB0,14)};pw2=(u32x4){PKW(pB1,0),PKW(pB1,2),PKW(pB1,4),PKW(pB1,6)};pw3=(u32x4){PKW(pB1,8),PKW(pB1,10),PKW(pB1,12),PKW(pB1,14)};
    SBAR(); pv(o,vb0+sl_cur,PAF(0),PAF(1),PAF(2),PAF(3)); }
  #undef PKW
  #undef PAF
  #undef VFR
  #undef PIN
  #undef MX3
  #undef GAPA
  #undef GAPB
  #undef EX
  #undef VRD
  #undef KRD
  #undef STEP
  #undef ENDW
  {auto rr=__builtin_amdgcn_permlane32_swap(__float_as_uint(l_reg),__float_as_uint(l_reg),false,false);l_reg=__uint_as_float(rr[0])+__uint_as_float(rr[1]);}
  if(hi==0)wsf[32+r32]=l_reg;asm volatile("s_waitcnt lgkmcnt(0)":::"memory");
  float rli[16];
  #pragma unroll
  for(int r=0;r<16;++r)rli[r]=__builtin_amdgcn_rcpf(wsf[32+crow(r,hi)]);
  bf16*Ow=O+(rowbase+q0+wid*QBLK)*OP+ocol;
  { bf16*stg=(bf16*)(shm+LDS_OST)+wid*2048;
    #pragma unroll
    for(int r=0;r<16;++r){const int orow=crow(r,hi);
      #pragma unroll
      for(int d0=0;d0<2;++d0)stg[orow*64+d0*32+r32]=(bf16)(o[d0][r]*rli[r]);}
    asm volatile("s_waitcnt lgkmcnt(0)":::"memory");
    #pragma unroll
    for(int i=0;i<4;++i){const int row=i*8+(lane>>3),ch=lane&7; const u32x4 v=*(const u32x4*)(stg+row*64+ch*8); ATTN_STORE16(Ow+(long)row*OP+ch*8,v);} }
  asm volatile("s_waitcnt lgkmcnt(0)\n\ts_barrier":::"memory");
  #undef DMA_K
  #undef DMA_V
  #undef CMASK
  #undef START
  #undef RESC
  #undef ROT
}
constexpr int ATTN_LDS_BYTES=LDS_BYTES;
struct AttnTensors { const bf16* Q; const bf16* K; const bf16* V; bf16* O; };
struct AttnUnit { int bh; int qb; };
struct StaticOrder {
  int vcu, G;
  __device__ __forceinline__ explicit StaticOrder(int grid,int block):vcu((grid%8==0)?(block%8)*(grid/8)+block/8:block),G(grid){}
  __device__ __forceinline__ bool next(int i,AttnUnit&u)const{ constexpr int NP=BATCH*64; const int ppc=(NP+G-1)/G; const int pj=i>>1; if(pj>=ppc)return false; const int pi=vcu*ppc+pj; if(pi>=NP)return false;
    const int s=pi&3; u.bh=pi>>2; u.qb=(i&1)?7-s:s; return true; }
  __device__ __forceinline__ void a_ready(const AttnUnit&)const{}
  __device__ __forceinline__ void done(const AttnUnit&)const{}
};
template<class Sched,int THRL=8> __device__ __forceinline__ void attn_phase(char*lds,const AttnTensors&T,const Sched&S,const int wave_s){
  AttnUnit u;
  for(int i=0;S.next(i,u);++i){ S.a_ready(u); attn_unit<THRL>(u.bh/NHEAD,u.bh%NHEAD,u.qb,T.Q,T.K,T.V,T.O,lds,wave_s); S.done(u); }
}
#undef SBAR
#undef WAIT_BAR
}
namespace mk {
constexpr size_t al256(size_t x) { return (x + 255) / 256 * 256; }
constexpr size_t MiB = (size_t)1 << 20;
constexpr size_t WS_CTL = 0, CTL_BYTES = 1u << 20;
constexpr int NIN = 3840;
constexpr size_t WS_WIN  = 1 * MiB;
constexpr size_t WS_WOUT = WS_WIN + (size_t)NIN * 2048;
constexpr size_t WS_WPLG = WS_WOUT + 2 * MiB;
constexpr size_t WS_WPL  = WS_WPLG + 2 * MiB;
constexpr size_t WS_WB   = WS_WPL + MiB / 2;
constexpr size_t WS_RW   = WS_WB + al256((size_t)1536 * 384 * 2);
constexpr size_t WS_SSQPE = WS_RW + (size_t)48 * 4096;
constexpr size_t WS_RSPE = WS_SSQPE + MiB;
constexpr size_t WS_ROPC = WS_RSPE + (size_t)16384 * 4;
constexpr size_t WS_ROPS = WS_ROPC + 2 * MiB;
constexpr size_t WS_BON  = WS_ROPS + 2 * MiB;
constexpr size_t WS_LIST = WS_BON + MiB / 2;
constexpr size_t WS_ASGW = WS_LIST + 2 * MiB;
constexpr size_t WS_SST  = WS_ASGW + MiB / 8;
static_assert(WS_SST + MiB <= 23 * MiB, "small region");
constexpr size_t WS_PE   = 23 * MiB;
constexpr size_t WS_HN   = 55 * MiB;
constexpr size_t WS_PH   = 87 * MiB;
constexpr size_t WS_Q    = 95 * MiB, WS_K = 111 * MiB, WS_V = 127 * MiB;
constexpr size_t WS_P    = 143 * MiB;
constexpr size_t WS_O    = 215 * MiB;
constexpr size_t WS_ZR   = 247 * MiB;
constexpr size_t WS_LA   = 55 * MiB;
constexpr size_t WS_WL   = 67 * MiB, WS_AL = 83 * MiB, WS_G = 99 * MiB;
constexpr size_t WS_RJ   = 115 * MiB;
constexpr size_t WS_VS   = 174 * MiB;
constexpr size_t WS_Y    = 190 * MiB;
constexpr size_t WS_MIX  = 55 * MiB;
constexpr size_t WS_X1   = 95 * MiB;
constexpr size_t WS_H2   = 159 * MiB;
constexpr size_t WS_WDN  = 191 * MiB;
constexpr size_t WS_WUP  = 223 * MiB;
constexpr size_t WS_HID  = 55 * MiB;
constexpr size_t WS_YE   = 223 * MiB;
constexpr size_t WS_X2H  = 159 * MiB;
constexpr size_t WS_END1 = 295 * MiB - 65536;
static_assert(WS_ZR + (size_t)16384 * 1536 * 2 <= 295 * MiB && WS_WUP + 64 * MiB <= 287 * MiB && WS_X1 + 64 * MiB <= WS_H2 && WS_H2 + 32 * MiB <= WS_WDN && WS_WDN + 32 * MiB <= WS_WUP && WS_RJ + (size_t)8 * 8 * 64 * 15104 <= WS_VS && WS_HID + (size_t)(32768 + 8192) * 1024 <= WS_X1, "ws map");

constexpr int CW_BAR = 4096, CW_CNT = 8192;

constexpr int RING_BYTES = 131072, SCR_BYTES = 8 * 19456  , MISC_OFF = SCR_BYTES + 320, LDS_BYTES = 160 * 1024;

struct TJob { const float* src; f16* dst; const float* s1; const float* s2; int K, N, ldd, mode, nb, item0; long sstride, dstride; };
constexpr int MAXJOBS = 20;
struct Params {
    const float* in[38]; float* out; unsigned char* ws;
    TJob jobs[MAXJOBS]; int njobs, nitems, ph_lo, ph_hi, njobs0, nitems0, rep_ph, pad_;
};

#define XB_TMO      128
#define XB_XCNT(j)  (256  + 64 * (j))
#define XB_XSUB(j)  (1280 + 64 * (j))
#define XB_XGEN(j)  (2304 + 64 * (j))
#define XB_TOP      3328
#define XB_TOPGEN   3392
#define XCD_BAR_WORDS 3456
#define XB_SPIN_CAP (1u << 18)
__device__ __forceinline__ unsigned xb_ld(unsigned* p)              { return __hip_atomic_load(p, __ATOMIC_RELAXED, __HIP_MEMORY_SCOPE_AGENT); }
__device__ __forceinline__ unsigned xb_add(unsigned* p, unsigned v) { return __hip_atomic_fetch_add(p, v, __ATOMIC_RELAXED, __HIP_MEMORY_SCOPE_AGENT); }
__device__ __forceinline__ unsigned xb_xcc_id() { return (unsigned)__builtin_amdgcn_s_getreg((3 << 11) | 20) & 0xFu; }
#define XB_SPIN(cond, bar) do { unsigned _sp = 0; while (cond) { __builtin_amdgcn_s_sleep(1); \
    if ((++_sp & 255u) == 0u) { if (xb_ld(&(bar)[XB_TMO])) break; if (_sp > XB_SPIN_CAP) { atomicAdd(&(bar)[XB_TMO], 1u); break; } } } } while (0)
struct XcdBarrier { unsigned* bar; unsigned x; volatile LAS unsigned* st; };
__device__ __forceinline__ XcdBarrier xcd_barrier_post(unsigned* bar, volatile LAS unsigned* st) {
    XcdBarrier b; b.bar = bar; b.x = xb_xcc_id(); b.st = st;
    if (threadIdx.x == 0) (void)xb_add(&bar[XB_XCNT(b.x)], 1u);
    return b;
}
__device__ __forceinline__ void xcd_barrier_complete(unsigned* bar, unsigned x, unsigned& nloc, unsigned& nx) {
    const unsigned G = gridDim.x * gridDim.y * gridDim.z;
    unsigned sum, cnt, mine, sp = 0u;
    for (;;) {
        sum = 0u; cnt = 0u; mine = 0u;
#pragma unroll
        for (unsigned j = 0; j < 16; ++j) { const unsigned c = xb_ld(&bar[XB_XCNT(j)]); sum += c; cnt += (c > 0u) ? 1u : 0u; mine = (j == x) ? c : mine; }
        if (sum == G) break;
        __builtin_amdgcn_s_sleep(1);
        if ((++sp & 255u) == 0u) { if (xb_ld(&bar[XB_TMO])) break; if (sp > XB_SPIN_CAP) { atomicAdd(&bar[XB_TMO], 1u); break; } }
    }
    nloc = mine > 0u ? mine : 1u; nx = cnt > 0u ? cnt : 1u;
}
__device__ __forceinline__ void xcd_barrier(const XcdBarrier& b, int wave_s) {
    int ln_; asm volatile("v_mbcnt_lo_u32_b32 %0, -1, 0\n\tv_mbcnt_hi_u32_b32 %0, -1, %0" : "=v"(ln_));
    const bool leader = wave_s == 0 && ln_ == 0;
    asm volatile("s_waitcnt vmcnt(0)" ::: "memory");
    __syncthreads();
    if (leader) {
        unsigned* bar = b.bar;
        __builtin_amdgcn_s_waitcnt(0);
        unsigned nloc = b.st[0], nx = b.st[1];
        if (nloc == 0u) { xcd_barrier_complete(bar, b.x, nloc, nx); b.st[0] = nloc; b.st[1] = nx; }
        const unsigned old = xb_add(&bar[XB_XSUB(b.x)], 1u);
        const unsigned gen = old / nloc;
        if (old + 1u == (gen + 1u) * nloc) {
            __builtin_amdgcn_fence(__ATOMIC_RELEASE, "agent");
            asm volatile("s_waitcnt vmcnt(0)" ::: "memory");
            const unsigned og = xb_add(&bar[XB_TOP], 1u);
            const unsigned tg = og / nx;
            if (og + 1u == (tg + 1u) * nx) xb_add(&bar[XB_TOPGEN], 1u);
            else XB_SPIN(xb_ld(&bar[XB_TOPGEN]) == tg, bar);
            __builtin_amdgcn_fence(__ATOMIC_ACQUIRE, "agent");
            xb_add(&bar[XB_XGEN(b.x)], 1u);
            asm volatile("s_waitcnt vmcnt(0)" ::: "memory");
        } else {
            XB_SPIN(xb_ld(&bar[XB_XGEN(b.x)]) == gen, bar);
            __builtin_amdgcn_fence(__ATOMIC_ACQUIRE, "agent");
            asm volatile("s_waitcnt vmcnt(0)" ::: "memory");
        }
    }
    __syncthreads();
}

__device__ __forceinline__ float shx(float v, int mask, int lane) { return __builtin_bit_cast(float, __builtin_amdgcn_ds_bpermute((lane ^ mask) << 2, __builtin_bit_cast(int, v))); }
__device__ __forceinline__ float wave_sum(float v, int lane) {
#pragma unroll
    for (int o = 1; o < 64; o <<= 1) v += shx(v, o, lane);
    return v;
}

__device__ __forceinline__ float wave_sum_dpp(float x) {
    int v = __builtin_bit_cast(int, x);
#define DPP_ADD(ctrl, rmask) v = __builtin_bit_cast(int, __builtin_bit_cast(float, v) + __builtin_bit_cast(float, __builtin_amdgcn_update_dpp(0, v, ctrl, rmask, 0xf, true)))
    DPP_ADD(0x111, 0xf); DPP_ADD(0x112, 0xf); DPP_ADD(0x114, 0xf); DPP_ADD(0x118, 0xf); DPP_ADD(0x142, 0xa); DPP_ADD(0x143, 0xc);
#undef DPP_ADD
    return __builtin_bit_cast(float, __builtin_amdgcn_readlane(v, 63));
}
constexpr int TR_WAVE_LDS = 64 * 68 * 4;
__device__ __forceinline__ void p0_transpose_item(const TJob& J, int item, LAS float* scr, int lane) {
    const int kblks = (J.K + 63) / 64, nblk = (J.N + 63) / 64, per = kblks * nblk;
    const int bi = item / per, r = item % per, kb = r / nblk, nbk = r % nblk, k0 = 64 * kb, n0 = 64 * nbk;
    const float* W = J.src + (size_t)bi * J.sstride; f16* WT = J.dst + (size_t)bi * J.dstride;
    const int c4 = (lane & 15) * 4, kr = lane >> 4;
    f32x4 v[16];
#pragma unroll
    for (int i = 0; i < 16; ++i) { const int k = k0 + 4 * i + kr; v[i] = (f32x4){0.f, 0.f, 0.f, 0.f};
        if (k < J.K && n0 + c4 < J.N) v[i] = *(const f32x4*)(W + (size_t)k * J.N + n0 + c4); }
    if (J.s1) {
#pragma unroll
        for (int i = 0; i < 16; ++i) { const int k = k0 + 4 * i + kr; float s = 1.f;
            if (k < J.K) { s = J.s1[k]; if (J.mode == 1) s *= 1.f - J.s2[k]; else if (J.mode == 2) s *= J.s2[k]; }
            v[i] = v[i] * s; }
    }
#pragma unroll
    for (int i = 0; i < 16; ++i) { const int kk = 4 * i + kr; *(LAS f32x4*)(scr + kk * 68 + (c4 ^ (4 * ((kk >> 3) & 7)))) = v[i]; }
    asm volatile("s_waitcnt lgkmcnt(0)" ::: "memory");
    const int c = lane & 7, nn = lane >> 3;
    if (k0 + 8 * c < J.K) {
#pragma unroll
        for (int jn = 0; jn < 8; ++jn) { const int n = nn + 8 * jn; const LAS float* s = scr + (8 * c) * 68 + (n ^ (4 * c));
            if (n0 + n < J.N) {
                u32x4 o; o.x = pkh(s[0 * 68], s[1 * 68]); o.y = pkh(s[2 * 68], s[3 * 68]); o.z = pkh(s[4 * 68], s[5 * 68]); o.w = pkh(s[6 * 68], s[7 * 68]);
                *(u32x4*)(WT + (size_t)(n0 + n) * J.ldd + k0 + 8 * c) = o; } }
    }
    asm volatile("s_waitcnt lgkmcnt(0)" ::: "memory");
}

__device__ __forceinline__ void p0_prologue(const Params& p, unsigned char* ws, LAS unsigned char* lds, int bid, int wave, int lane) {
    LAS float* scr = (LAS float*)(lds + wave * TR_WAVE_LDS);
    const int G = gridDim.x, gw = bid * NWAVES + wave, NGW = G * NWAVES;
    for (int it = gw; it < p.nitems0; it += NGW) {
        int j = 0;
        while (j + 1 < p.njobs0 && it >= p.jobs[j + 1].item0) ++j;
        p0_transpose_item(p.jobs[j], it - p.jobs[j].item0, scr, lane);
    }
    const float* x = p.in[0]; f16* HN = (f16*)(ws + WS_HN);
    for (int m = gw; m < M; m += NGW) {
        const f32x4* xr = (const f32x4*)(x + (size_t)m * 1024) + lane;
        f32x4 v[4]; float s = 0.f;
#pragma unroll
        for (int j = 0; j < 4; ++j) { v[j] = xr[64 * j]; s += (v[j].x * v[j].x + v[j].y * v[j].y) + (v[j].z * v[j].z + v[j].w * v[j].w); }
        const float r = rsqrtf(wave_sum(s, lane) * (1.f / 1024.f) + 1e-6f);
        u32x2* o8 = (u32x2*)(HN + (size_t)m * 1024) + lane;
#pragma unroll
        for (int j = 0; j < 4; ++j) o8[64 * j] = (u32x2){pkh(v[j].x * r, v[j].y * r), pkh(v[j].z * r, v[j].w * r)};
    }
    const float* pp = p.in[1]; f16* PH = (f16*)(ws + WS_PH);
    const int gt = bid * NTHR + wave * 64 + lane, NGT = G * NTHR;
    for (int i = gt; i < M * 256 / 8; i += NGT) {
        const f32x4 a = *((const f32x4*)pp + 2 * (size_t)i), b = *((const f32x4*)pp + 2 * (size_t)i + 1);
        *((u32x4*)PH + i) = (u32x4){pkh(a.x, a.y), pkh(a.z, a.w), pkh(b.x, b.y), pkh(b.z, b.w)};
    }
    const int* pos = (const int*)p.in[2]; float* rc = (float*)(ws + WS_ROPC); float* rs = (float*)(ws + WS_ROPS);
    for (int i = gt; i < M * 32; i += NGT) {
        const int t = i >> 5, f = i & 31; const float inv = powf(10000.f, -(float)f / 32.f); const float ang = (float)pos[t] * inv;
        rc[i] = cosf(ang); rs[i] = sinf(ang);
    }
    float* RW = (float*)(ws + WS_RW); const float* gm = p.in[28]; const float* wg = p.in[29]; const float* we = p.in[30];
    for (int i = gt; i < 48 * 1024; i += NGT) {
        const int c = i >> 10, k = i & 1023;
        const float w = c < 4 ? wg[k * 4 + c] : (c < 36 ? we[(size_t)((c - 4) >> 3) * 8192 + k * 8 + ((c - 4) & 7)] : 0.f);
        RW[i] = w * gm[k];
    }
}

enum { EPI_QK = 0, EPI_ST16 = 1, EPI_PE = 2, EPI_X1 = 3, EPI_UP = 4, EPI_DOWN = 5, EPI_FINAL = 6 };
enum { PH_P0 = 0, PH_P1, PH_ATTN, PH_P2A, PH_P2B, PH_P2C0, PH_SCAN0, PH_P2C1, PH_SCAN1, PH_MIX, PH_OUT, PH_ROUTE, PH_UP, PH_DOWN, PH_COMB, PH_GATE, PH_END };
struct UniSched {
    const unsigned char* ws; int ph, G, c; const LAS int* tab;
    __device__ __forceinline__ bool next(int i, GU& u) const {
        unsigned char* w = const_cast<unsigned char*>(ws);
        u.aux = 0; u.glist = nullptr; u.elist = nullptr; u.gcnt = 0;
        if (ph == PH_P1) {
            constexpr int nM = M / BM, nN = NIN / BM, nwg = nM * nN, nPE = nM * 4;
            const int rounds = (nwg + G - 1) / G, rem = nwg % G;
            const long L = (long)i * G + c;
            if (L < nwg) {
                int wgid = (int)L; { const int q = nwg / NXCD, r = nwg % NXCD, xcd = wgid % NXCD, off = wgid / NXCD; wgid = (xcd < r ? xcd * (q + 1) : r * (q + 1) + (xcd - r) * q) + off; }
                const int nig = WGM * nN, gid = wgid / nig, fm = gid * WGM, gsz = (nM - fm) < WGM ? (nM - fm) : WGM;
                const int pm = fm + ((wgid % nig) % gsz), pn = (wgid % nig) / gsz;
                u.pm = pm; u.pn = pn; u.nt = 16; u.lda2 = 2048; u.ldb2 = 2048; u.hsa = 128 * 2048;
                u.a = (const char*)(ws + WS_HN) + (size_t)pm * 256 * 2048;
                u.b = (const char*)(ws + WS_WIN) + (size_t)pn * 256 * 2048;
                if (pn < 4) { u.bmode = 2; u.hsb = 32 * 2048; u.epi = EPI_QK; u.o = (char*)(w + (pn < 2 ? WS_Q : WS_K)); u.ldc = 512; u.oc0 = 256 * (pn & 1); u.aux = pn < 2; }
                else { u.bmode = 1; u.hsb = 128 * 2048; u.epi = EPI_ST16;
                    if (pn < 6) { u.o = (char*)(w + WS_V); u.ldc = 512; u.oc0 = 256 * (pn - 4); }
                    else if (pn < 12) { u.o = (char*)(w + WS_ZR); u.ldc = 1536; u.oc0 = 256 * (pn - 6); }
                    else { u.o = (char*)(w + WS_P); u.ldc = 768; u.oc0 = 256 * (pn - 12); } }
                return true;
            }
            int Lp;
            if (rem == 0) Lp = (int)(L - nwg);
            else { if (c < rem) return false; Lp = (i - (rounds - 1)) * (G - rem) + (c - rem); }
            if (Lp >= nPE) return false;
            const int pm = Lp >> 2, pn = Lp & 3;
            u.pm = pm; u.pn = pn; u.nt = 4; u.lda2 = 512; u.ldb2 = 512; u.hsa = 128 * 512; u.hsb = 128 * 512; u.bmode = 1; u.epi = EPI_PE;
            u.a = (const char*)(ws + WS_PH) + (size_t)pm * 256 * 512;
            u.b = (const char*)(ws + WS_WPL) + (size_t)pn * 256 * 512;
            u.o = (char*)(w + WS_PE); u.ldc = 1024; u.oc0 = 256 * pn;
            return true;
        }
        if (ph == PH_P2B) {
            constexpr int nM = M / BM, nwg = nM * 6;
            const int L = i * G + c; if (L >= nwg) return false;
            const int pm = L / 6, pn = L % 6;
            u.pm = pm; u.pn = pn; u.nt = 6; u.lda2 = 768; u.ldb2 = 768; u.hsa = 128 * 768; u.hsb = 128 * 768; u.bmode = 1; u.epi = EPI_ST16;
            u.a = (const char*)(ws + WS_LA) + (size_t)pm * 256 * 768; u.b = (const char*)(ws + WS_WB) + (size_t)pn * 256 * 768;
            u.o = (char*)(w + (pn < 2 ? WS_WL : pn < 4 ? WS_AL : WS_G)); u.ldc = 512; u.oc0 = 256 * (pn & 1);
            return true;
        }
        if (ph == PH_OUT || ph == PH_GATE) {
            constexpr int nM = M / BM, nN = 4, nwg = nM * nN;
            const long L = (long)i * G + c; if (L >= nwg) return false;
            int wgid = (int)L; { const int q = nwg / NXCD, r = nwg % NXCD, xcd = wgid % NXCD, off = wgid / NXCD; wgid = (xcd < r ? xcd * (q + 1) : r * (q + 1) + (xcd - r) * q) + off; }
            const int nig = WGM * nN, gid = wgid / nig, fm = gid * WGM, gsz = (nM - fm) < WGM ? (nM - fm) : WGM;
            const int pm = fm + ((wgid % nig) % gsz), pn = (wgid % nig) / gsz;
            u.pm = pm; u.pn = pn; u.nt = 16; u.lda2 = 2048; u.ldb2 = 2048; u.hsa = 128 * 2048; u.hsb = 128 * 2048; u.bmode = 0;
            u.a = (const char*)(ws + (ph == PH_OUT ? WS_MIX : WS_X2H)) + (size_t)pm * 256 * 2048;
            u.b = (const char*)(ws + (ph == PH_OUT ? WS_WOUT : WS_WPLG)) + (size_t)pn * 256 * 2048;
            u.epi = ph == PH_OUT ? EPI_X1 : EPI_FINAL; u.o = nullptr; u.ldc = 1024; u.oc0 = 256 * pn;
            return true;
        }
        if (ph == PH_UP || ph == PH_DOWN) {
            const int vc = (G % 8 == 0) ? (c % 8) * (G / 8) + c / 8 : c;
            const int L = i * G + vc, T = L >> 2, pn = L & 3;
            int ln_; asm volatile("v_mbcnt_lo_u32_b32 %0, -1, 0\n\tv_mbcnt_hi_u32_b32 %0, -1, %0" : "=v"(ln_));
            const int t0l = tab[ln_ & 31], cnl = tab[32 + (ln_ & 31)], NT = __builtin_amdgcn_readfirstlane(tab[64]);
            if (T >= NT) return false;
            const unsigned long long mk_ = __ballot(ln_ < 32 && T >= t0l);
            const int e = 63 - __builtin_clzll(mk_ | 1ull);
            const int t0 = __builtin_amdgcn_readlane(t0l, e), cn = __builtin_amdgcn_readlane(cnl, e);
            const int rt = T - t0;
            u.pm = T; u.pn = pn; u.aux = e; u.gcnt = cn - rt * 256;
            const int* lst = (const int*)(ws + WS_LIST) + (size_t)e * M + rt * 256;
            if (ph == PH_UP) {
                u.glist = lst; u.a = (const char*)(ws + WS_H2); u.lda2 = 2048; u.hsa = 0; u.nt = 16;
                u.b = (const char*)(ws + WS_WUP) + (size_t)e * 1024 * 2048 + (size_t)pn * 128 * 2048; u.ldb2 = 2048; u.hsb = 512 * 2048; u.bmode = 1;
                u.epi = EPI_UP; u.o = (char*)(w + WS_HID); u.ldc = 512; u.oc0 = 128 * pn;
            } else {
                u.elist = lst; u.a = (const char*)(ws + WS_HID) + (size_t)T * 256 * 1024; u.lda2 = 1024; u.hsa = 128 * 1024; u.nt = 8;
                u.b = (const char*)(ws + WS_WDN) + (size_t)e * 1024 * 1024 + (size_t)pn * 256 * 1024; u.ldb2 = 1024; u.hsb = 128 * 1024; u.bmode = 1;
                u.epi = EPI_DOWN; u.o = (char*)(w + WS_YE); u.ldc = 1024; u.oc0 = 256 * pn;
            }
            return true;
        }
        return false;
    }
};
struct UniEpi {
    unsigned char* ws; const Params& P;
    __device__ __forceinline__ const float* pin(int i) const { asm volatile("" : "+s"(i)); return P.in[i]; }
    __device__ __forceinline__ void operator()(const f32x4 (&acc)[2][2][4][2], const GU& u, int wr, int wc, int fr, int fq) const {
        const int row0 = u.pm * BM + wr * 64 + fr, ln = fq * 16 + fr;
        if (u.epi == EPI_ST16 || u.epi == EPI_PE) {
            f16* O = (f16*)u.o; const int ldc = u.ldc, col0 = u.oc0;
            float* ssq = (float*)(ws + WS_SSQPE);
#pragma unroll
            for (int ai = 0; ai < 2; ++ai)
#pragma unroll
                for (int m = 0; m < 4; ++m) {
                    const int row = row0 + ai * HALF + m * 16; f16* rp = O + (size_t)row * ldc + col0 + wc * 32 + 8 * fq; float s = 0.f;
#pragma unroll
                    for (int bj = 0; bj < 2; ++bj) { const f32x4 v0 = acc[ai][bj][m][0], v1 = acc[ai][bj][m][1];
                        s += (v0[0] * v0[0] + v0[1] * v0[1]) + (v0[2] * v0[2] + v0[3] * v0[3]) + (v1[0] * v1[0] + v1[1] * v1[1]) + (v1[2] * v1[2] + v1[3] * v1[3]);
                        *(u32x4*)(rp + bj * HALF) = (u32x4){pkh(v0[0], v0[1]), pkh(v0[2], v0[3]), pkh(v1[0], v1[1]), pkh(v1[2], v1[3])}; }
                    if (u.epi == EPI_PE) { s += shx(s, 16, ln); s += shx(s, 32, ln); if (fq == 0) ssq[(size_t)row * 16 + u.pn * 4 + wc] = s; }
                }
            return;
        }
        if (u.epi == EPI_X1 || u.epi == EPI_FINAL) {
            const float* xin = u.epi == EPI_X1 ? pin(0) : (const float*)(ws + WS_X1); const float* gpl = pin(35); float* outp = P.out;
            float* O = u.epi == EPI_X1 ? (float*)(ws + WS_X1) : outp;
            const f16* PE = (const f16*)(ws + WS_PE); const float* rspe = (const float*)(ws + WS_RSPE);
#pragma unroll
            for (int ai = 0; ai < 2; ++ai)
#pragma unroll
                for (int m = 0; m < 4; ++m) {
                    const int row = row0 + ai * HALF + m * 16; const size_t ro = (size_t)row * 1024 + u.oc0 + wc * 32 + 4 * fq;
                    float rpe = 0.f; if (u.epi == EPI_FINAL) rpe = rspe[row];
#pragma unroll
                    for (int bj = 0; bj < 2; ++bj)
#pragma unroll
                        for (int n = 0; n < 2; ++n) { const size_t o = ro + bj * HALF + n * 16; const f32x4 xr = *(const f32x4*)(xin + o); f32x4 v = acc[ai][bj][m][n];
                            if (u.epi == EPI_FINAL) { const h4 pe = *(const h4*)(PE + o); const f32x4 gp = *(const f32x4*)(gpl + (o - (size_t)row * 1024));
#pragma unroll
                                for (int j = 0; j < 4; ++j) v[j] = (float)pe[j] * rpe * gp[j] / (1.f + __expf(-v[j])); }
                            *(f32x4*)(O + o) = xr + v; }
                    if (m & 1) asm volatile("" ::: "memory");
                }
            return;
        }
        if (u.epi == EPI_UP) {
            f16* O = (f16*)u.o;
#pragma unroll
            for (int ai = 0; ai < 2; ++ai)
#pragma unroll
                for (int m = 0; m < 4; ++m) {
                    const int row = row0 + ai * HALF + m * 16; unsigned w4[4];
#pragma unroll
                    for (int n = 0; n < 2; ++n) { const f32x4 gt = acc[ai][0][m][n], up = acc[ai][1][m][n]; float h[4];
#pragma unroll
                        for (int j = 0; j < 4; ++j) h[j] = gt[j] / (1.f + __expf(-gt[j])) * up[j];
                        w4[2 * n] = pkh(h[0], h[1]); w4[2 * n + 1] = pkh(h[2], h[3]); }
                    *(u32x4*)(O + (size_t)row * 512 + u.oc0 + wc * 32 + 8 * fq) = (u32x4){w4[0], w4[1], w4[2], w4[3]};
                    asm volatile("" ::: "memory");
                }
            return;
        }
        if (u.epi == EPI_DOWN) {
            f16* O = (f16*)u.o; const float* aw = (const float*)(ws + WS_ASGW);
#pragma unroll
            for (int ai = 0; ai < 2; ++ai)
#pragma unroll
                for (int m = 0; m < 4; ++m) {
                    const int r = wr * 64 + fr + ai * HALF + m * 16;
                    if (r < u.gcnt) { const int slot = u.elist[r]; const float wgt = aw[slot]; f16* rp = O + (size_t)slot * 1024 + u.oc0 + wc * 32 + 8 * fq;
#pragma unroll
                        for (int bj = 0; bj < 2; ++bj) { const f32x4 v0 = acc[ai][bj][m][0] * wgt, v1 = acc[ai][bj][m][1] * wgt;
                            *(u32x4*)(rp + bj * HALF) = (u32x4){pkh(v0[0], v0[1]), pkh(v0[2], v0[3]), pkh(v1[0], v1[1]), pkh(v1[2], v1[3])}; } }
                    asm volatile("" ::: "memory");
                }
            return;
        }
        const bool isq = u.aux != 0; const float* g = isq ? pin(5) : pin(6); const float osc = isq ? C2 : 1.f;
        f16* O = (f16*)u.o; const int colb = u.oc0 + 64 * wc + 8 * fq;
        const float* rc = (const float*)(ws + WS_ROPC); const float* rs = (const float*)(ws + WS_ROPS);
        f32x4 gl[2][2];
#pragma unroll
        for (int bj = 0; bj < 2; ++bj)
#pragma unroll
            for (int n = 0; n < 2; ++n) gl[bj][n] = *(const f32x4*)(g + 32 * bj + 8 * fq + 4 * n);
#pragma unroll
        for (int ai = 0; ai < 2; ++ai)
#pragma unroll
            for (int m = 0; m < 4; ++m) {
                const int row = row0 + ai * HALF + m * 16; float s = 0.f;
#pragma unroll
                for (int bj = 0; bj < 2; ++bj)
#pragma unroll
                    for (int n = 0; n < 2; ++n) { const f32x4 v = acc[ai][bj][m][n]; s += (v[0] * v[0] + v[1] * v[1]) + (v[2] * v[2] + v[3] * v[3]); }
                s += shx(s, 16, ln); s += shx(s, 32, ln);
                const float ri = rsqrtf(s * (1.f / 64.f) + 1e-6f);
                unsigned lo[4], hi[4];
#pragma unroll
                for (int n = 0; n < 2; ++n) {
                    const f32x4 c = *(const f32x4*)(rc + (size_t)row * 32 + 8 * fq + 4 * n), sn = *(const f32x4*)(rs + (size_t)row * 32 + 8 * fq + 4 * n);
                    const f32x4 y0 = acc[ai][0][m][n] * gl[0][n] * ri, y1 = acc[ai][1][m][n] * gl[1][n] * ri;
                    const f32x4 l = (y0 * c - y1 * sn) * osc, h = (y1 * c + y0 * sn) * osc;
                    lo[2 * n] = pkh(l[0], l[1]); lo[2 * n + 1] = pkh(l[2], l[3]); hi[2 * n] = pkh(h[0], h[1]); hi[2 * n + 1] = pkh(h[2], h[3]);
                }
                f16* rp = O + (size_t)row * 512 + colb;
                *(u32x4*)rp = (u32x4){lo[0], lo[1], lo[2], lo[3]};
                *(u32x4*)(rp + 32) = (u32x4){hi[0], hi[1], hi[2], hi[3]};
            }
    }
};

__device__ __forceinline__ void p4_mix(unsigned char* ws, const float* lq1, const float* lk1, const float* lq2, const float* lk2, const float* ogp, int bid, int wave, int lane) {
    const int gw = bid * NWAVES + wave, NGW = gridDim.x * NWAVES;
    const float d1 = wave_sum(lq1[lane] * lk1[lane], lane), d2 = wave_sum(lq2[lane] * lk2[lane], lane);
    const float lam = expf(d1) - expf(d2) + 0.2f;
    const f16* O = (const f16*)(ws + WS_O); f16* MIX = (f16*)(ws + WS_MIX);
    const float* og = ogp + (lane & 15) * 8; float g[8];
#pragma unroll
    for (int j = 0; j < 8; ++j) g[j] = og[j] * 0.8f;
    for (int m = gw; m < M; m += NGW) {
        const h8 a = *(const h8*)(O + (size_t)m * 1024 + lane * 8), b = *(const h8*)(O + (size_t)m * 1024 + 512 + lane * 8);
        float o[8]; float s = 0.f;
#pragma unroll
        for (int j = 0; j < 8; ++j) { o[j] = (float)a[j] - lam * (float)b[j]; s += o[j] * o[j]; }
        s += shx(s, 1, lane); s += shx(s, 2, lane); s += shx(s, 4, lane); s += shx(s, 8, lane);
        const float r = rsqrtf(s * (1.f / 128.f) + 1e-5f);
        *(u32x4*)(MIX + (size_t)m * 1024 + lane * 8) = (u32x4){pkh(o[0] * r * g[0], o[1] * r * g[1]), pkh(o[2] * r * g[2], o[3] * r * g[3]), pkh(o[4] * r * g[4], o[5] * r * g[5]), pkh(o[6] * r * g[6], o[7] * r * g[7])};
    }
}
__device__ __forceinline__ void p4_mix_rwkv(unsigned char* ws, const float* mu_rkv, const float* gn_w, const float* gn_b, int bid, int wave, int lane) {
    const int gw = bid * NWAVES + wave, NGW = gridDim.x * NWAVES;
    const f16* Y = (const f16*)(ws + WS_Y); const float* BON = (const float*)(ws + WS_BON);
    const f16* VS = (const f16*)(ws + WS_VS); const f16* Gg = (const f16*)(ws + WS_G); f16* MIX = (f16*)(ws + WS_MIX);
    (void)mu_rkv;
    const f32x4 w0 = *(const f32x4*)(gn_w + lane * 8), w1 = *(const f32x4*)(gn_w + lane * 8 + 4), b0 = *(const f32x4*)(gn_b + lane * 8), b1 = *(const f32x4*)(gn_b + lane * 8 + 4);
    for (int m = gw; m < M; m += NGW) {
        const h8 yh = *(const h8*)(Y + (size_t)m * 512 + lane * 8), vh = *(const h8*)(VS + (size_t)m * 512 + lane * 8), gh = *(const h8*)(Gg + (size_t)m * 512 + lane * 8);
        const float bon = BON[(size_t)m * 8 + (lane >> 3)];
        float y[8]; float s = 0.f;
#pragma unroll
        for (int j = 0; j < 8; ++j) { y[j] = (float)yh[j]; s += y[j]; }
        s += shx(s, 1, lane); s += shx(s, 2, lane); s += shx(s, 4, lane);
        const float mu = s * (1.f / 64.f); float q = 0.f;
#pragma unroll
        for (int j = 0; j < 8; ++j) { y[j] -= mu; q += y[j] * y[j]; }
        q += shx(q, 1, lane); q += shx(q, 2, lane); q += shx(q, 4, lane);
        const float rs = rsqrtf(q * (1.f / 64.f) + 64e-5f);
        float o[8];
#pragma unroll
        for (int j = 0; j < 8; ++j) { const float gw_ = j < 4 ? w0[j] : w1[j - 4], gb_ = j < 4 ? b0[j] : b1[j - 4]; o[j] = (y[j] * rs * gw_ + gb_ + bon * (float)vh[j]) * (float)gh[j]; }
        *(u32x4*)(MIX + (size_t)m * 1024 + 512 + lane * 8) = (u32x4){pkh(o[0], o[1]), pkh(o[2], o[3]), pkh(o[4], o[5]), pkh(o[6], o[7])};
    }
}
__device__ __forceinline__ void p6_expert_weights(const Params& p, LAS unsigned char* lds, int bid, int wave, int lane) {
    LAS float* scr = (LAS float*)(lds + wave * TR_WAVE_LDS);
    const int gw = bid * NWAVES + wave, NGW = gridDim.x * NWAVES;
    for (int it = p.nitems0 + gw; it < p.nitems; it += NGW) {
        int j = p.njobs0;
        while (j + 1 < p.njobs && it >= p.jobs[j + 1].item0) ++j;
        p0_transpose_item(p.jobs[j], it - p.jobs[j].item0, scr, lane);
    }
}
__device__ __forceinline__ void build_expert_tab(const unsigned char* ws, LAS int* tab, int wave, int lane) {
    if (wave == 0) {
        const int* cnt = (const int*)(ws + WS_CTL) + CW_CNT;
        const int c = lane < 32 ? cnt[lane] : 0, nte = (c + 255) >> 8;
        int v = nte;
#define DPP_IADD(ctrl, rmask) v += __builtin_amdgcn_update_dpp(0, v, ctrl, rmask, 0xf, true)
        DPP_IADD(0x111, 0xf); DPP_IADD(0x112, 0xf); DPP_IADD(0x114, 0xf); DPP_IADD(0x118, 0xf); DPP_IADD(0x142, 0xa); DPP_IADD(0x143, 0xc);
#undef DPP_IADD
        if (lane < 32) { tab[lane] = v - nte; tab[32 + lane] = c; }
        if (lane == 31) tab[64] = v;
    }
    __syncthreads();
}
__device__ __forceinline__ void p6_router(unsigned char* ws, LAS unsigned char* lds, int bid, int wave, int lane) {
    const float* X1 = (const float*)(ws + WS_X1); const float* RW = (const float*)(ws + WS_RW); f16* H2 = (f16*)(ws + WS_H2);
    int* cnt = (int*)(ws + WS_CTL) + CW_CNT; int* LIST = (int*)(ws + WS_LIST); float* ASGW = (float*)(ws + WS_ASGW);
    LAS float* lg = (LAS float*)(lds + wave * 4096);
    const int gw = bid * NWAVES + wave, NGW = gridDim.x * NWAVES, r = lane & 15, kq = lane >> 4;
    for (int task = gw; task < M / 16; task += NGW) {
        const int row0 = task * 16;
        const float* xr = X1 + (size_t)(row0 + r) * 1024 + 4 * kq;
        f32x4 acc[3] = {{0.f, 0.f, 0.f, 0.f}, {0.f, 0.f, 0.f, 0.f}, {0.f, 0.f, 0.f, 0.f}}; float ssq = 0.f;
#pragma unroll 2
        for (int j = 0; j < 64; ++j) {
            const f32x4 xa = *(const f32x4*)(xr + 16 * j);
            ssq += (xa[0] * xa[0] + xa[1] * xa[1]) + (xa[2] * xa[2] + xa[3] * xa[3]);
#pragma unroll
            for (int t = 0; t < 3; ++t) { const f32x4 wb = *(const f32x4*)(RW + (size_t)(16 * t + r) * 1024 + 16 * j + 4 * kq);
#pragma unroll
                for (int e = 0; e < 4; ++e) acc[t] = __builtin_amdgcn_mfma_f32_16x16x4f32(xa[e], wb[e], acc[t], 0, 0, 0); }
        }
        ssq += shx(ssq, 16, lane); ssq += shx(ssq, 32, lane);
        const float rstd = rsqrtf(ssq * (1.f / 1024.f) + 1e-6f);
        if (kq == 0) lg[768 + r] = rstd;
#pragma unroll
        for (int t = 0; t < 3; ++t)
#pragma unroll
            for (int q = 0; q < 4; ++q) lg[(4 * kq + q) * 48 + 16 * t + r] = acc[t][q];
        asm volatile("s_waitcnt lgkmcnt(0)" ::: "memory");
#pragma unroll 4
        for (int j = 0; j < 64; ++j) { const f32x4 xa = *(const f32x4*)(xr + 16 * j);
            *(u32x2*)(H2 + (size_t)(row0 + r) * 1024 + 16 * j + 4 * kq) = (u32x2){pkh(xa[0] * rstd, xa[1] * rstd), pkh(xa[2] * rstd, xa[3] * rstd)}; }
        if (lane < 16) {
            const int t = row0 + lane; const float rs = lg[768 + lane]; const LAS float* l = lg + lane * 48;
            int gs = 0; float gm = l[0] * rs;
#pragma unroll
            for (int i = 1; i < 4; ++i) { const float v = l[i] * rs; if (v > gm) { gm = v; gs = i; } }
            float den = 0.f;
#pragma unroll
            for (int i = 0; i < 4; ++i) den += expf(l[i] * rs - gm);
            const float gwt = 1.f / den;
            float ev[8];
#pragma unroll
            for (int i = 0; i < 8; ++i) { float v = 0.f;
#pragma unroll
                for (int gq = 0; gq < 4; ++gq) if (gq == gs) v = l[4 + 8 * gq + i];
                ev[i] = v * rs; }
            int i0 = 0; float v0 = ev[0];
#pragma unroll
            for (int i = 1; i < 8; ++i) if (ev[i] > v0) { v0 = ev[i]; i0 = i; }
            int i1 = 0; float v1 = -INFINITY;
#pragma unroll
            for (int i = 0; i < 8; ++i) if (i != i0 && ev[i] > v1) { v1 = ev[i]; i1 = i; }
            const float p1 = expf(v1 - v0), w0 = gwt / (1.f + p1), w1 = gwt * p1 / (1.f + p1);
            const int e0 = gs * 8 + i0, e1 = gs * 8 + i1;
            ASGW[2 * t] = w0; ASGW[2 * t + 1] = w1;
            int pos = atomicAdd(cnt + e0, 1); LIST[(size_t)e0 * M + pos] = 2 * t;
            pos = atomicAdd(cnt + e1, 1); LIST[(size_t)e1 * M + pos] = 2 * t + 1;
        }
        asm volatile("s_waitcnt lgkmcnt(0)" ::: "memory");
    }
}
__device__ __forceinline__ void p9_combine(unsigned char* ws, int bid, int wave, int lane) {
    float* X1 = (float*)(ws + WS_X1); const f16* YE = (const f16*)(ws + WS_YE); f16* X2H = (f16*)(ws + WS_X2H);
    const float* ssqp = (const float*)(ws + WS_SSQPE); float* rspe = (float*)(ws + WS_RSPE);
    const int gw = bid * NWAVES + wave, NGW = gridDim.x * NWAVES;
    for (int m = gw; m < M; m += NGW) {
        { const float sp = wave_sum_dpp(lane < 16 ? ssqp[(size_t)m * 16 + lane] : 0.f); if (lane == 0) rspe[m] = rsqrtf(sp * (1.f / 1024.f) + 1e-6f); }
        f32x4 v[4]; float s = 0.f;
#pragma unroll
        for (int j = 0; j < 4; ++j) {
            const size_t c = (size_t)lane * 4 + 256 * j;
            v[j] = *(const f32x4*)(X1 + (size_t)m * 1024 + c);
            const h4 a = *(const h4*)(YE + (size_t)(2 * m) * 1024 + c), b = *(const h4*)(YE + (size_t)(2 * m + 1) * 1024 + c);
#pragma unroll
            for (int q = 0; q < 4; ++q) { v[j][q] += (float)a[q] + (float)b[q]; s += v[j][q] * v[j][q]; }
        }
        const float r = rsqrtf(wave_sum_dpp(s) * (1.f / 1024.f) + 1e-6f);
#pragma unroll
        for (int j = 0; j < 4; ++j) {
            const size_t c = (size_t)lane * 4 + 256 * j;
            *(f32x4*)(X1 + (size_t)m * 1024 + c) = v[j];
            *(u32x2*)(X2H + (size_t)m * 1024 + c) = (u32x2){pkh(v[j][0] * r, v[j][1] * r), pkh(v[j][2] * r, v[j][3] * r)};
        }
    }
}
}
namespace mk {
constexpr int CH = 16, NCH = SEQ / CH;
constexpr int NCHH = NCH / 2, NJOBH = NB * 8 * NCHH;
constexpr int P2C_WAVE_LDS = 19456;
constexpr int RJ_PHI = 0, RJ_RH = 8192, RJ_PSI = 10240, RJ_C2 = 12288, RJ_VB = 12800, RJ_DG = 14848, RJ_BYTES = 15104;

struct RwkvW { const float *mu_rkv, *w0, *a0, *k_k, *k_a, *r_k, *gn_w, *gn_b; };

struct TokVals { float r, k2, v, a, b, lw; };
__device__ __forceinline__ TokVals rwkv_tok(const f16* ZR, const f16* WL, const f16* AL, const RwkvW& W, size_t row, bool hasprev, int c, int lane) {
    const f16* z = ZR + row * 1536; const f16* zp = z - 1536;
    const float zr = (float)z[c], zk = (float)z[512 + c], zv = (float)z[1024 + c];
    const float pr = hasprev ? (float)zp[c] : 0.f, pk = hasprev ? (float)zp[512 + c] : 0.f, pv = hasprev ? (float)zp[1024 + c] : 0.f;
    TokVals o;
    o.r = zr + (pr - zr) * W.mu_rkv[c]; const float k = zk + (pk - zk) * W.mu_rkv[512 + c]; o.v = zv + (pv - zv) * W.mu_rkv[1024 + c];
    o.lw = 0.f;
    const float ag = __builtin_amdgcn_rcpf(1.f + __expf(-(W.a0[c] + (float)AL[row * 512 + c])));
    float kk = k * W.k_k[c];
    const float ss = wave_sum_dpp(kk * kk);
    kk *= rsqrtf(fmaxf(ss, 1e-24f));
    o.k2 = k * (1.f + (ag - 1.f) * W.k_a[c]); o.a = -kk; o.b = kk * ag;
    return o;
}

__device__ __forceinline__ void p2a_la(unsigned char* ws, int bid, int tid) {
    const f16* P = (const f16*)(ws + WS_P); f16* LA = (f16*)(ws + WS_LA);
    const int gt = bid * NTHR + tid, NGT = gridDim.x * NTHR;
    for (int i = gt; i < M * 48; i += NGT) {
        const int t = i / 48, c8 = (i % 48) * 8; u32x4 o = (u32x4){0u, 0u, 0u, 0u};
        if (c8 < 288) {
            const h8 a = *(const h8*)(P + (size_t)t * 768 + c8); h8 b = (h8){0, 0, 0, 0, 0, 0, 0, 0};
            if (t % SEQ) b = *(const h8*)(P + (size_t)(t - 1) * 768 + 288 + c8);
            float v[8];
#pragma unroll
            for (int j = 0; j < 8; ++j) { float x = (float)a[j] + (float)b[j]; v[j] = c8 < 64 ? tanhf(x) : (c8 < 128 ? x : 1.f / (1.f + expf(-x))); }
            o = (u32x4){pkh(v[0], v[1]), pkh(v[2], v[3]), pkh(v[4], v[5]), pkh(v[6], v[7])};
        }
        *(u32x4*)(LA + (size_t)t * 384 + c8) = o;
    }
}

__device__ __forceinline__ h8 lds_h8(LAS const unsigned char* p) { return *(LAS const h8*)p; }
__device__ __forceinline__ void p2c_chunks(unsigned char* ws, const RwkvW& W, LAS unsigned char* lds, int half, int bid, int wave, int lane) {
    LAS unsigned char* L = lds + wave * P2C_WAVE_LDS;
    const f16* ZR = (const f16*)(ws + WS_ZR); const f16* WL = (const f16*)(ws + WS_WL); const f16* AL = (const f16*)(ws + WS_AL); f16* VS = (f16*)(ws + WS_VS);
    unsigned char* RJ = ws + WS_RJ; float* BON = (float*)(ws + WS_BON);
    const int gw = bid * NWAVES + wave, NGW = gridDim.x * NWAVES;
    const int r16 = lane & 15, g = lane >> 4;
    const h8 zero8 = (h8){0, 0, 0, 0, 0, 0, 0, 0};
    for (int job = gw; job < NJOBH; job += NGW) {
        const int bh = job / NCHH, ch = half * NCHH + job % NCHH, b = bh >> 3, hd = bh & 7, c = hd * 64 + lane;
        const size_t row0 = (size_t)b * SEQ + ch * CH;
        unsigned char* rj0 = RJ + (size_t)job * RJ_BYTES;
        {
            float lwv[16]; float GL = 0.f;
#pragma unroll
            for (int i = 0; i < 16; ++i) {
                const float wl = W.w0[c] + (float)WL[(row0 + i) * 512 + c];
                const float nx = -wl; const float sp = nx > 20.f ? nx : __logf(1.f + __expf(nx));
                lwv[i] = -__expf(-sp - 0.5f); GL += lwv[i];
            }
            float G = 0.f, eprev = 1.f; float vq[4];
#pragma unroll
            for (int i = 0; i < 16; ++i) {
                const TokVals tv = rwkv_tok(ZR, WL, AL, W, row0 + i, (ch * CH + i) != 0, c, lane);
                G += lwv[i]; const float ei = __expf(G), einv = __builtin_amdgcn_rcpf(ei), f = __expf(GL - G);
                *(LAS f16*)(L + 0 + i * 144 + lane * 2) = (f16)(tv.a * eprev); *(LAS f16*)(L + 2304 + i * 144 + lane * 2) = (f16)(tv.b * einv);
                *(LAS f16*)(L + 4608 + i * 144 + lane * 2) = (f16)(tv.k2 * einv); *(LAS f16*)(L + 6912 + i * 144 + lane * 2) = (f16)(tv.r * ei);
                *(LAS f16*)(L + 13888 + lane * 80 + i * 2) = (f16)(tv.b * f); *(LAS f16*)(L + 13888 + lane * 80 + 32 + i * 2) = (f16)(tv.k2 * f);
                eprev = ei; vq[i & 3] = tv.v; VS[(row0 + i) * 512 + c] = (f16)tv.v;
                if ((i & 3) == 3) *(u32x2*)(rj0 + RJ_VB + ((lane >> 4) * 64 + (lane & 15) + 16 * (i >> 2)) * 8) = (u32x2){pkh(vq[0], vq[1]), pkh(vq[2], vq[3])};
                const float bon = wave_sum_dpp(tv.r * tv.k2 * W.r_k[c]);
                if (lane == 0) BON[(row0 + i) * 8 + hd] = bon;
            }
            *(float*)(rj0 + RJ_DG + lane * 4) = __expf(GL);
        }
        asm volatile("s_waitcnt lgkmcnt(0)" ::: "memory");
        f32x4 n1 = {0.f, 0.f, 0.f, 0.f}, n2 = n1, n3 = n1, n4 = n1;
#pragma unroll
        for (int s = 0; s < 2; ++s) {
            const int off = r16 * 144 + (8 * g + 32 * s) * 2;
            const h8 xa = lds_h8(L + 0 + off), xb = lds_h8(L + 2304 + off), xk = lds_h8(L + 4608 + off), xr = lds_h8(L + 6912 + off);
            n1 = __builtin_amdgcn_mfma_f32_16x16x32_f16(xa, xb, n1, 0, 0, 0);
            n2 = __builtin_amdgcn_mfma_f32_16x16x32_f16(xa, xk, n2, 0, 0, 0);
            n3 = __builtin_amdgcn_mfma_f32_16x16x32_f16(xb, xr, n3, 0, 0, 0);
            n4 = __builtin_amdgcn_mfma_f32_16x16x32_f16(xk, xr, n4, 0, 0, 0);
        }
#pragma unroll
        for (int q = 0; q < 4; ++q) { const int rr = 4 * g + q;
            if (!(r16 < rr)) { n1[q] = 0.f; n2[q] = 0.f; }
            if (!(rr <= r16)) { n3[q] = 0.f; n4[q] = 0.f; } }
#pragma unroll
        for (int q = 0; q < 4; ++q) { *(LAS float*)(L + 10240 + ((4 * g + q) * 16 + r16) * 4) = n1[q]; *(LAS float*)(L + 11264 + (r16 * 17 + 4 * g + q) * 4) = n2[q]; }
        *(LAS u32x2*)(L + 13120 + r16 * 48 + g * 8) = (u32x2){pkh(n3[0], n3[1]), pkh(n3[2], n3[3])};
        asm volatile("s_waitcnt lgkmcnt(0)" ::: "memory");
        float X[16], X1[16], rt[16];
#pragma unroll
        for (int i = 0; i < 16; ++i) rt[i] = (float)*(LAS const f16*)(L + 6912 + i * 144 + lane * 2);
#pragma unroll
        for (int i = 0; i < 16; ++i) {
            float x = (float)*(LAS const f16*)(L + 0 + i * 144 + lane * 2), x1 = *(LAS const float*)(L + 11264 + (r16 * 17 + i) * 4);
#pragma unroll
            for (int m4 = 0; m4 < (i + 3) / 4; ++m4) {
                const f32x4 cf = *(LAS const f32x4*)(L + 10240 + (i * 16 + m4 * 4) * 4);
#pragma unroll
                for (int q = 0; q < 4; ++q) if (m4 * 4 + q < i) { x = fmaf(X[m4 * 4 + q], cf[q], x); x1 = fmaf(X1[m4 * 4 + q], cf[q], x1); }
            }
            X[i] = x; X1[i] = x1;
        }
#pragma unroll
        for (int q = 0; q < 4; ++q) {
            *(LAS u32x2*)(L + 0 + lane * 80 + q * 8) = (u32x2){pkh(X[4 * q], X[4 * q + 1]), pkh(X[4 * q + 2], X[4 * q + 3])};
            *(LAS u32x2*)(L + 0 + lane * 80 + 32 + q * 8) = (u32x2){pkh(rt[4 * q], rt[4 * q + 1]), pkh(rt[4 * q + 2], rt[4 * q + 3])};
            if (lane < 16) *(LAS u32x2*)(L + 12352 + lane * 48 + q * 8) = (u32x2){pkh(X1[4 * q], X1[4 * q + 1]), pkh(X1[4 * q + 2], X1[4 * q + 3])};
        }
        asm volatile("s_waitcnt lgkmcnt(0)" ::: "memory");
        h8 Af[4], Ap[4], Bf[4];
#pragma unroll
        for (int t = 0; t < 4; ++t) { Af[t] = lds_h8(L + 0 + (16 * t + r16) * 80 + g * 16); Ap[t] = g < 2 ? Af[t] : zero8; Bf[t] = lds_h8(L + 13888 + (16 * t + r16) * 80 + g * 16); }
        h8 idn = zero8;
#pragma unroll
        for (int e8 = 0; e8 < 8; ++e8) if (g >= 2 && 8 * (g - 2) + e8 == r16) idn[e8] = (f16)1.f;
        const h8 c1raw = g < 2 ? lds_h8(L + 12352 + r16 * 48 + g * 16) : zero8;
        const h8 c1id = g < 2 ? c1raw : idn;
        const h8 nbraw = g < 2 ? lds_h8(L + 13120 + r16 * 48 + g * 16) : zero8;
        const h8 nbid = g < 2 ? nbraw : idn;
        unsigned char* rj = rj0;
        const f32x4 z4 = {0.f, 0.f, 0.f, 0.f};
#pragma unroll
        for (int t = 0; t < 4; ++t) {
            f32x4 d[4];
#pragma unroll
            for (int tp = 0; tp < 4; ++tp) d[tp] = __builtin_amdgcn_mfma_f32_16x16x32_f16(Ap[tp], Bf[t], z4, 0, 0, 0);
#pragma unroll
            for (int s = 0; s < 2; ++s)
                *(u32x4*)(rj + RJ_PHI + ((t * 2 + s) * 64 + lane) * 16) = (u32x4){pkh(d[2 * s][0], d[2 * s][1]), pkh(d[2 * s][2], d[2 * s][3]), pkh(d[2 * s + 1][0], d[2 * s + 1][1]), pkh(d[2 * s + 1][2], d[2 * s + 1][3])};
            const f32x4 ps = __builtin_amdgcn_mfma_f32_16x16x32_f16(c1id, Bf[t], z4, 0, 0, 0);
            *(u32x2*)(rj + RJ_PSI + (t * 64 + lane) * 8) = (u32x2){pkh(ps[0], ps[1]), pkh(ps[2], ps[3])};
        }
        {
            f32x4 d[4];
#pragma unroll
            for (int tp = 0; tp < 4; ++tp) d[tp] = __builtin_amdgcn_mfma_f32_16x16x32_f16(Af[tp], nbid, z4, 0, 0, 0);
#pragma unroll
            for (int s = 0; s < 2; ++s)
                *(u32x4*)(rj + RJ_RH + (s * 64 + lane) * 16) = (u32x4){pkh(d[2 * s][0], d[2 * s][1]), pkh(d[2 * s][2], d[2 * s][3]), pkh(d[2 * s + 1][0], d[2 * s + 1][1]), pkh(d[2 * s + 1][2], d[2 * s + 1][3])};
            const f32x4 c2 = __builtin_amdgcn_mfma_f32_16x16x32_f16(c1raw, nbraw, n4, 0, 0, 0);
            *(u32x2*)(rj + RJ_C2 + lane * 8) = (u32x2){pkh(c2[0], c2[1]), pkh(c2[2], c2[3])};
        }
        asm volatile("s_waitcnt lgkmcnt(0)" ::: "memory");
    }
}

struct ScanOps { u32x4 phi[8]; u32x4 rh[2]; u32x2 psi[4]; u32x2 c2, vb; f32x4 dg[4]; };
__device__ __forceinline__ void scan_load(ScanOps& o, const unsigned char* rj, int vt, int lane, int g) {
#pragma unroll
    for (int i = 0; i < 8; ++i) o.phi[i] = *(const u32x4*)(rj + RJ_PHI + (i * 64 + lane) * 16);
#pragma unroll
    for (int s = 0; s < 2; ++s) o.rh[s] = *(const u32x4*)(rj + RJ_RH + (s * 64 + lane) * 16);
#pragma unroll
    for (int t = 0; t < 4; ++t) { o.psi[t] = *(const u32x2*)(rj + RJ_PSI + (t * 64 + lane) * 8); o.dg[t] = *(const f32x4*)(rj + RJ_DG + (16 * t + 4 * g) * 4); }
    o.c2 = *(const u32x2*)(rj + RJ_C2 + lane * 8); o.vb = *(const u32x2*)(rj + RJ_VB + (vt * 64 + lane) * 8);
}
__device__ __forceinline__ void scan_step(f32x4 (&S)[4], const ScanOps& o, f16* yp) {
    h8 SB[2];
#pragma unroll
    for (int s = 0; s < 2; ++s) { const u32x4 w = (u32x4){pkh(S[2 * s][0], S[2 * s][1]), pkh(S[2 * s][2], S[2 * s][3]), pkh(S[2 * s + 1][0], S[2 * s + 1][1]), pkh(S[2 * s + 1][2], S[2 * s + 1][3])}; SB[s] = __builtin_bit_cast(h8, w); }
    const h8 VBo = __builtin_bit_cast(h8, (u32x4){o.vb.x, o.vb.y, 0u, 0u});
    f32x4 y = {0.f, 0.f, 0.f, 0.f};
#pragma unroll
    for (int s = 0; s < 2; ++s) y = __builtin_amdgcn_mfma_f32_16x16x32_f16(__builtin_bit_cast(h8, o.rh[s]), SB[s], y, 0, 0, 0);
    y = __builtin_amdgcn_mfma_f32_16x16x32_f16(__builtin_bit_cast(h8, (u32x4){o.c2.x, o.c2.y, 0u, 0u}), VBo, y, 0, 0, 0);
#pragma unroll
    for (int t = 0; t < 4; ++t) {
        f32x4 acc = S[t] * o.dg[t];
#pragma unroll
        for (int s = 0; s < 2; ++s) acc = __builtin_amdgcn_mfma_f32_16x16x32_f16(__builtin_bit_cast(h8, o.phi[t * 2 + s]), SB[s], acc, 0, 0, 0);
        acc = __builtin_amdgcn_mfma_f32_16x16x32_f16(__builtin_bit_cast(h8, (u32x4){o.psi[t].x, o.psi[t].y, 0u, 0u}), VBo, acc, 0, 0, 0);
        S[t] = acc;
    }
#pragma unroll
    for (int q = 0; q < 4; ++q) yp[(size_t)q * 512] = (f16)y[q];
}
__device__ __forceinline__ void p3s_scan(unsigned char* ws, int half, int bid, int wave, int lane) {
    const int G = gridDim.x;
    const int r16 = lane & 15, g = lane >> 4;
    const unsigned char* RJ = ws + WS_RJ; f16* Y = (f16*)(ws + WS_Y); f32x4* SST = (f32x4*)(ws + WS_SST);
    for (int task = wave * G + bid; task < NB * 32; task += G * NWAVES) {
        const int bh = task >> 2, vt = task & 3, b = bh >> 3, hd = bh & 7;
        f32x4 S[4];
#pragma unroll
        for (int t = 0; t < 4; ++t) S[t] = half ? SST[((size_t)task * 4 + t) * 64 + lane] : (f32x4){0.f, 0.f, 0.f, 0.f};
        const unsigned char* rj = RJ + (size_t)bh * NCHH * RJ_BYTES;
        f16* yp = Y + ((size_t)b * SEQ + half * NCHH * CH + 4 * g) * 512 + hd * 64 + vt * 16 + r16;
        ScanOps A, B;
        scan_load(A, rj, vt, lane, g);
        for (int chl = 0; chl < NCHH; chl += 2) {
            scan_load(B, rj + RJ_BYTES, vt, lane, g);
            scan_step(S, A, yp);
            if (chl + 2 < NCHH) scan_load(A, rj + 2 * RJ_BYTES, vt, lane, g);
            scan_step(S, B, yp + (size_t)CH * 512);
            rj += 2 * RJ_BYTES; yp += (size_t)2 * CH * 512;
        }
        if (half == 0) {
#pragma unroll
            for (int t = 0; t < 4; ++t) SST[((size_t)task * 4 + t) * 64 + lane] = S[t];
        }
    }
}
}
namespace mk {
__global__ void __launch_bounds__(NTHR, 2) mega(Params p0) {
#define PIN(i) ({ int _i = (i); asm volatile("" : "+s"(_i)); p0.in[_i]; })
    extern __shared__ __attribute__((aligned(16))) unsigned char lds_raw[];
    LAS unsigned char* lds = (LAS unsigned char*)lds_raw;
    const int wave_s = __builtin_amdgcn_readfirstlane(threadIdx.x >> 6);
    const int tid = threadIdx.x;
    volatile LAS unsigned* MISC = (volatile LAS unsigned*)(lds + MISC_OFF);
    for (int u = tid; u < (LDS_BYTES - SCR_BYTES) / 4; u += NTHR) ((LAS unsigned*)(lds + SCR_BYTES))[u] = 0u;
    __syncthreads();
    XcdBarrier bar = xcd_barrier_post((unsigned*)(p0.ws + WS_CTL) + CW_BAR, MISC + 8);
#define GRID_BAR() xcd_barrier(bar)

    int rep_left = 1;
    for (int ph = p0.ph_lo; ph < p0.ph_hi; ++ph) {
        int tidv; asm volatile("v_mbcnt_lo_u32_b32 %0, -1, 0\n\tv_mbcnt_hi_u32_b32 %0, -1, %0" : "=v"(tidv)); tidv += wave_s * 64;
        const int lane = tidv & 63, wave = __builtin_amdgcn_readfirstlane(tidv >> 6);
        int bidv = blockIdx.x; asm volatile("" : "+s"(bidv));
        unsigned char* wsv = p0.ws; asm volatile("" : "+s"(wsv));
        if (ph == PH_P0) p0_prologue(p0, wsv, lds, bidv, wave, lane);
        else if (ph == PH_P2A) p2a_la(wsv, bidv, tidv);
        else if (ph == PH_P2C0 || ph == PH_P2C1) { const RwkvW W{PIN(12), PIN(14), PIN(17), PIN(22), PIN(23), PIN(24), nullptr, nullptr}; p2c_chunks(wsv, W, lds, ph == PH_P2C1, bidv, wave, lane); }
        else if (ph == PH_SCAN0 || ph == PH_SCAN1) p3s_scan(wsv, ph == PH_SCAN1, bidv, wave, lane);
        else if (ph == PH_ATTN) {
            const attn_body::AttnTensors AT{(const f16*)(wsv + WS_Q), (const f16*)(wsv + WS_K), (const f16*)(wsv + WS_V), (f16*)(wsv + WS_O)};
            const attn_body::StaticOrder S((int)gridDim.x, bidv);
            attn_body::attn_phase<attn_body::StaticOrder>((char*)lds_raw, AT, S, wave_s);
        }
        else if (ph == PH_ROUTE) { p6_router(wsv, lds, bidv, wave, lane); __syncthreads(); p6_expert_weights(p0, lds, bidv, wave, lane); }
        else if (ph == PH_COMB) p9_combine(wsv, bidv, wave, lane);
        else if (ph == PH_MIX) { p4_mix(wsv, PIN(7), PIN(8), PIN(9), PIN(10), PIN(11), bidv, wave, lane); p4_mix_rwkv(wsv, PIN(12), PIN(25), PIN(26), bidv, wave, lane); }
        else {
            LAS int* tab = (LAS int*)(lds + MISC_OFF + 128);
            if (ph == PH_UP || ph == PH_DOWN) build_expert_tab(wsv, tab, wave, lane);
            UniSched S{wsv, ph, (int)gridDim.x, bidv, tab};
            UniEpi E{wsv, p0};
            gemm_phase<UniSched, UniEpi>(lds, S, E, tidv);
        }
        if (ph == p0.rep_ph && rep_left) { rep_left = 0; --ph; }
        if (ph + 1 < p0.ph_hi) { XcdBarrier bb = bar; asm volatile("" : "+s"(bb.bar), "+s"(bb.x)); xcd_barrier(bb, wave_s); }
    }
#undef GRID_BAR
}

static void add_job(Params& P, const float* src, f16* dst, const float* s1, const float* s2, int K, int N, int ldd, int mode, int nb, long sstride, long dstride) {
    TJob& j = P.jobs[P.njobs++]; j.src = src; j.dst = dst; j.s1 = s1; j.s2 = s2; j.K = K; j.N = N; j.ldd = ldd; j.mode = mode; j.nb = nb; j.sstride = sstride; j.dstride = dstride;
    j.item0 = P.nitems; P.nitems += ((K + 63) / 64) * ((N + 63) / 64) * nb;
}
static void build_params(Params& P, void* const* d_in, void* d_out, void* d_ws, bool experts) {
    for (int i = 0; i < 38; ++i) P.in[i] = (const float*)d_in[i];
    P.out = (float*)d_out; P.ws = (unsigned char*)d_ws;
    unsigned char* ws = P.ws; auto F = [&](int i) { return (const float*)d_in[i]; };
    f16* WinT = (f16*)(ws + WS_WIN);
    add_job(P, F(4), WinT, F(3), nullptr, 1024, 3072, 1024, 0, 1, 0, 0);
    const float* mu = F(13);
    add_job(P, F(15), WinT + (size_t)3072 * 1024, F(3), mu, 1024, 64, 1024, 1, 1, 0, 0);
    add_job(P, F(15), WinT + (size_t)(3072 + 288) * 1024, F(3), mu, 1024, 64, 1024, 2, 1, 0, 0);
    add_job(P, F(18), WinT + (size_t)(3072 + 64) * 1024, F(3), mu + 1024, 1024, 64, 1024, 1, 1, 0, 0);
    add_job(P, F(18), WinT + (size_t)(3072 + 288 + 64) * 1024, F(3), mu + 1024, 1024, 64, 1024, 2, 1, 0, 0);
    add_job(P, F(20), WinT + (size_t)(3072 + 128) * 1024, F(3), mu + 2048, 1024, 160, 1024, 1, 1, 0, 0);
    add_job(P, F(20), WinT + (size_t)(3072 + 288 + 128) * 1024, F(3), mu + 2048, 1024, 160, 1024, 2, 1, 0, 0);
    add_job(P, F(27), (f16*)(ws + WS_WOUT), nullptr, nullptr, 1024, 1024, 1024, 0, 1, 0, 0);
    add_job(P, F(37), (f16*)(ws + WS_WPLG), F(36), nullptr, 1024, 1024, 1024, 0, 1, 0, 0);
    add_job(P, F(34), (f16*)(ws + WS_WPL), nullptr, nullptr, 256, 1024, 256, 0, 1, 0, 0);
    f16* WbT = (f16*)(ws + WS_WB);
    add_job(P, F(16), WbT, nullptr, nullptr, 64, 512, 384, 0, 1, 0, 0);
    add_job(P, F(19), WbT + (size_t)512 * 384 + 64, nullptr, nullptr, 64, 512, 384, 0, 1, 0, 0);
    add_job(P, F(21), WbT + (size_t)1024 * 384 + 128, nullptr, nullptr, 160, 512, 384, 0, 1, 0, 0);
    P.njobs0 = P.njobs; P.nitems0 = P.nitems;
    if (experts) {
        add_job(P, F(31), (f16*)(ws + WS_WUP), F(28), nullptr, 1024, 512, 1024, 0, 32, (long)1024 * 512, (long)1024 * 1024);
        add_job(P, F(32), (f16*)(ws + WS_WUP) + (size_t)512 * 1024, F(28), nullptr, 1024, 512, 1024, 0, 32, (long)1024 * 512, (long)1024 * 1024);
        add_job(P, F(33), (f16*)(ws + WS_WDN), nullptr, nullptr, 512, 1024, 512, 0, 32, (long)512 * 1024, (long)1024 * 512);
    }
}
}
namespace ad {
using mk::f16;
__global__ void __launch_bounds__(256) adapt1(const unsigned char* ws, int b, float* Z, float* L1, float* L2, float* L3, float* PE) {
    const f16* Q = (const f16*)(ws + mk::WS_Q); const f16* K = (const f16*)(ws + mk::WS_K); const f16* V = (const f16*)(ws + mk::WS_V);
    const f16* ZR = (const f16*)(ws + mk::WS_ZR); const f16* P = (const f16*)(ws + mk::WS_P); const f16* PEh = (const f16*)(ws + mk::WS_PE);
    const int t = blockIdx.x; const size_t g = (size_t)b * 2048 + t;
    for (int c = threadIdx.x; c < 3072; c += 256) {
        float v;
        if (c < 512) v = (float)Q[g * 512 + c] * (1.f / mk::C2);
        else if (c < 1024) v = (float)K[g * 512 + c - 512];
        else if (c < 1536) v = (float)V[g * 512 + c - 1024];
        else v = (float)ZR[g * 1536 + c - 1536];
        Z[(size_t)t * 3072 + c] = v;
    }
    for (int c = threadIdx.x; c < 1024; c += 256) PE[(size_t)t * 1024 + c] = (float)PEh[g * 1024 + c];
    for (int j = threadIdx.x; j < 288; j += 256) {
        float v = (float)P[g * 768 + j] + (t > 0 ? (float)P[(g - 1) * 768 + 288 + j] : 0.f);
        if (j < 64) L1[(size_t)t * 64 + j] = tanhf(v);
        else if (j < 128) L2[(size_t)t * 64 + j - 64] = v;
        else L3[(size_t)t * 160 + j - 128] = 1.f / (1.f + expf(-v));
    }
}
__global__ void __launch_bounds__(256) adapt2(const unsigned char* ws, int b, float* MIX) {
    const f16* X = (const f16*)(ws + mk::WS_MIX); const int t = blockIdx.x; const size_t g = (size_t)b * 2048 + t;
    for (int c = threadIdx.x; c < 1024; c += 256) MIX[(size_t)t * 1024 + c] = (float)X[g * 1024 + c];
}
}

extern "C" void kernel_launch(void* const* d_in, const int* in_sizes, int n_in, void* d_out, int out_size, void* d_ws, size_t ws_size, hipStream_t stream) {
    static int grid = 0;
    if (grid == 0) {
        int dev = 0, cus = 0, per_cu = 0;
        (void)hipGetDevice(&dev); (void)hipDeviceGetAttribute(&cus, hipDeviceAttributeMultiprocessorCount, dev);
        (void)hipFuncSetAttribute((const void*)mk::mega, hipFuncAttributeMaxDynamicSharedMemorySize, mk::LDS_BYTES);
        (void)hipOccupancyMaxActiveBlocksPerMultiprocessor(&per_cu, (const void*)mk::mega, mk::NTHR, mk::LDS_BYTES);
        if (per_cu < 1) { fprintf(stderr, "kernel_launch: occupancy query says %d blocks per CU\n", per_cu); per_cu = 1; }
        grid = cus * 1;
        (void)hipGetLastError();
    }
    unsigned char* mws = (unsigned char*)d_ws;
    if (ws_size < mk::WS_END1) { fprintf(stderr, "kernel_launch: workspace too small (%zu)\n", ws_size); return; }
    (void)hipMemsetAsync(mws + mk::WS_CTL, 0, mk::CTL_BYTES, stream);
    (void)hipMemsetAsync(mws + mk::WS_WIN + (size_t)3648 * 2048, 0, (size_t)192 * 2048, stream);
    (void)hipMemsetAsync(mws + mk::WS_WB, 0, (size_t)1536 * 384 * 2, stream);
    mk::Params P{};
    mk::build_params(P, d_in, d_out, mws, true);
    P.ph_lo = 0; P.ph_hi = mk::PH_END; P.rep_ph = MK_REP_PH;
    void* args[] = {&P};
    hipError_t e = hipLaunchCooperativeKernel((const void*)mk::mega, dim3(grid), dim3(mk::NTHR), args, mk::LDS_BYTES, stream);
    if (e != hipSuccess) fprintf(stderr, "cooperative launch failed: %s (grid %d)\n", hipGetErrorString(e), grid);
    for (int b = 0; b < nv::NB; ++b) {
        float* out = (float*)d_out + (size_t)b * nv::S_ * nv::D_;
        if (b >= mk::NB) nv::forward_batch(d_in, b, out, (float*)d_ws, stream, 0, 1);
    }
}
```

```cpp
#define MK_NB 8
#define MK_REP_PH (-1)
#include <hip/hip_runtime.h>
#include <cstdint>
#include <cstdio>
#include <cmath>

namespace nv {
constexpr int S_ = 2048, D_ = 1024, NB = 8;
constexpr int MB = S_;

struct ALPlain { const float* A; int lda; int pad; __device__ __forceinline__ float operator()(int m, int k) const { return A[(size_t)m * lda + k]; } };
struct ALShiftMix { const float* H; const float* mu;
    __device__ __forceinline__ float operator()(int m, int k) const { float h = H[(size_t)m * 1024 + k]; float hp = (m % S_) ? H[(size_t)(m - 1) * 1024 + k] : 0.f; return h + (hp - h) * mu[k]; } };
struct ALGather { const float* A; int lda; const int* rows; int div;
    __device__ __forceinline__ float operator()(int m, int k) const { return A[(size_t)(rows[m] / div) * lda + k]; } };

template <class AL, int ACT>
__global__ void __launch_bounds__(256) sgemm(AL al, const float* __restrict__ B, int ldb, float* C, int ldc, const float* Cadd, int ldadd,
                                            int M, const int* Mptr, int N, int K) {
    __shared__ float As[16][68];
    __shared__ float Bs[16][68];
    if (Mptr) M = *Mptr;
    const int m0 = blockIdx.y * 64, n0 = blockIdx.x * 64;
    if (m0 >= M) return;
    const int tid = threadIdx.x, ty = tid / 16, tx = tid % 16;
    float acc[4][4];
#pragma unroll
    for (int i = 0; i < 4; ++i)
#pragma unroll
        for (int j = 0; j < 4; ++j) acc[i][j] = 0.f;
    for (int k0 = 0; k0 < K; k0 += 16) {
#pragma unroll
        for (int i = 0; i < 4; ++i) {
            int idx = tid + i * 256; int m = idx / 16, k = idx % 16;
            As[k][m] = (m0 + m < M) ? al(m0 + m, k0 + k) : 0.f;
            int kb = idx / 64, n = idx % 64;
            Bs[kb][n] = (n0 + n < N) ? B[(size_t)(k0 + kb) * ldb + n0 + n] : 0.f;
        }
        __syncthreads();
#pragma unroll
        for (int k = 0; k < 16; ++k) {
            float a[4], b[4];
#pragma unroll
            for (int i = 0; i < 4; ++i) { a[i] = As[k][ty * 4 + i]; b[i] = Bs[k][tx * 4 + i]; }
#pragma unroll
            for (int i = 0; i < 4; ++i)
#pragma unroll
                for (int j = 0; j < 4; ++j) acc[i][j] = fmaf(a[i], b[j], acc[i][j]);
        }
        __syncthreads();
    }
#pragma unroll
    for (int i = 0; i < 4; ++i)
#pragma unroll
        for (int j = 0; j < 4; ++j) {
            int m = m0 + ty * 4 + i, n = n0 + tx * 4 + j;
            if (m < M && n < N) {
                float v = acc[i][j];
                if (Cadd) v += Cadd[(size_t)m * ldadd + n];
                if (ACT == 1) v = tanhf(v);
                if (ACT == 2) v = 1.f / (1.f + expf(-v));
                C[(size_t)m * ldc + n] = v;
            }
        }
}

__device__ __forceinline__ float block_sum256(float v, float* red) {
    for (int o = 32; o > 0; o >>= 1) v += __shfl_xor(v, o);
    __syncthreads();
    if ((threadIdx.x & 63) == 0) red[threadIdx.x >> 6] = v;
    __syncthreads();
    return red[0] + red[1] + red[2] + red[3];
}

__global__ void __launch_bounds__(256) rmsnorm1024(const float* x, const float* g, float* out, float eps) {
    __shared__ float red[4];
    const size_t row = blockIdx.x; const int t = threadIdx.x;
    float4 v = *(const float4*)(x + row * 1024 + t * 4);
    float ss = block_sum256(v.x * v.x + v.y * v.y + v.z * v.z + v.w * v.w, red);
    float r = rsqrtf(ss * (1.f / 1024.f) + eps);
    float4 gg = *(const float4*)(g + t * 4);
    float4 o; o.x = v.x * r * gg.x; o.y = v.y * r * gg.y; o.z = v.z * r * gg.z; o.w = v.w * r * gg.w;
    *(float4*)(out + row * 1024 + t * 4) = o;
}

__global__ void __launch_bounds__(256) qk_prep(float* Z, const int* pos, const float* qg, const float* kg) {
    const int gw = blockIdx.x * 4 + (threadIdx.x >> 6), lane = threadIdx.x & 63;
    const int row = gw / 16, grp = gw % 16;
    float* p = Z + (size_t)row * 3072 + grp * 64;
    float v = p[lane];
    float ss = v * v;
    for (int o = 32; o > 0; o >>= 1) ss += __shfl_xor(ss, o);
    const float* g = grp < 8 ? qg : kg;
    float y = v * rsqrtf(ss * (1.f / 64.f) + 1e-6f) * g[lane];
    float other = __shfl_xor(y, 32);
    int i = lane & 31;
    float inv_freq = powf(10000.f, -(float)i / 32.f);
    float ang = (float)pos[row] * inv_freq;
    float c = cosf(ang), s = sinf(ang);
    float r = lane < 32 ? (y * c - other * s) : (y * c + other * s);
    p[lane] = r;
}

__global__ void __launch_bounds__(256) attn_naive(const float* Z, float* MIX, const float* lq1, const float* lk1, const float* lq2, const float* lk2, const float* og) {
    const int h = blockIdx.y, q = blockIdx.x * 32 + threadIdx.x / 8, sub = threadIdx.x % 8;
    float d1 = 0.f, d2 = 0.f;
    for (int i = 0; i < 64; ++i) { d1 += lq1[i] * lk1[i]; d2 += lq2[i] * lk2[i]; }
    const float lam = expf(d1) - expf(d2) + 0.2f;
    const float* qp = Z + (size_t)q * 3072 + h * 128;
    float m0 = -INFINITY, m1 = -INFINITY, l0 = 0.f, l1 = 0.f;
    const float scale = 0.125f;
    for (int j = sub; j <= q; j += 8) {
        const float* kp = Z + (size_t)j * 3072 + 512 + h * 128;
        float s0 = 0.f, s1 = 0.f;
        for (int d = 0; d < 64; d += 4) {
            float4 a = *(const float4*)(qp + d), b = *(const float4*)(kp + d);
            s0 += a.x * b.x + a.y * b.y + a.z * b.z + a.w * b.w;
            float4 a1 = *(const float4*)(qp + 64 + d), b1 = *(const float4*)(kp + 64 + d);
            s1 += a1.x * b1.x + a1.y * b1.y + a1.z * b1.z + a1.w * b1.w;
        }
        s0 *= scale; s1 *= scale;
        float n0 = fmaxf(m0, s0); l0 = l0 * expf(m0 - n0) + expf(s0 - n0); m0 = n0;
        float n1 = fmaxf(m1, s1); l1 = l1 * expf(m1 - n1) + expf(s1 - n1); m1 = n1;
    }
    for (int o = 1; o < 8; o <<= 1) {
        float om0 = __shfl_xor(m0, o), ol0 = __shfl_xor(l0, o), om1 = __shfl_xor(m1, o), ol1 = __shfl_xor(l1, o);
        float n0 = fmaxf(m0, om0); l0 = (m0 == -INFINITY ? 0.f : l0 * expf(m0 - n0)) + (om0 == -INFINITY ? 0.f : ol0 * expf(om0 - n0)); m0 = n0;
        float n1 = fmaxf(m1, om1); l1 = (m1 == -INFINITY ? 0.f : l1 * expf(m1 - n1)) + (om1 == -INFINITY ? 0.f : ol1 * expf(om1 - n1)); m1 = n1;
    }
    float o[16];
    for (int d = 0; d < 16; ++d) o[d] = 0.f;
    const int qmax = blockIdx.x * 32 + 31;
    for (int jb = 0; jb <= qmax; jb += 8) {
        const int j = jb + sub;
        float pj = 0.f;
        if (j <= q) {
            const float* kp = Z + (size_t)j * 3072 + 512 + h * 128;
            float s0 = 0.f, s1 = 0.f;
            for (int d = 0; d < 64; d += 4) {
                float4 a = *(const float4*)(qp + d), b = *(const float4*)(kp + d);
                s0 += a.x * b.x + a.y * b.y + a.z * b.z + a.w * b.w;
                float4 a1 = *(const float4*)(qp + 64 + d), b1 = *(const float4*)(kp + 64 + d);
                s1 += a1.x * b1.x + a1.y * b1.y + a1.z * b1.z + a1.w * b1.w;
            }
            pj = expf(s0 * scale - m0) / l0 - lam * expf(s1 * scale - m1) / l1;
        }
        for (int jj = 0; jj < 8; ++jj) {
            float pp = __shfl(pj, (threadIdx.x & 56) | jj);
            if (jb + jj <= qmax) {
                const float* vp = Z + (size_t)(jb + jj) * 3072 + 1024 + h * 128 + sub * 16;
                for (int d = 0; d < 16; ++d) o[d] += pp * vp[d];
            }
        }
    }
    float ss = 0.f;
    for (int d = 0; d < 16; ++d) ss += o[d] * o[d];
    for (int of = 1; of < 8; of <<= 1) ss += __shfl_xor(ss, of);
    float r = rsqrtf(ss * (1.f / 128.f) + 1e-5f) * 0.8f;
    for (int d = 0; d < 16; ++d) MIX[(size_t)q * 1024 + h * 128 + sub * 16 + d] = o[d] * r * og[sub * 16 + d];
}

__global__ void __launch_bounds__(256) rwkv_prep(const float* Z, const float* WL, const float* AL, const float* mu_rkv, const float* w0, const float* a0,
                                                const float* k_k, const float* k_a, float* R, float* W, float* K2, float* V, float* A2, float* B2) {
    const int gw = blockIdx.x * 4 + (threadIdx.x >> 6), lane = threadIdx.x & 63;
    const int row = gw / 8, hd = gw % 8, c = hd * 64 + lane;
    const float* z = Z + (size_t)row * 3072; const float* zp = z - 3072; const bool hp = (row % S_) != 0;
    float zr = z[1536 + c], zk = z[2048 + c], zv = z[2560 + c];
    float pr = hp ? zp[1536 + c] : 0.f, pk = hp ? zp[2048 + c] : 0.f, pv = hp ? zp[2560 + c] : 0.f;
    float r = zr + (pr - zr) * mu_rkv[c], k = zk + (pk - zk) * mu_rkv[512 + c], v = zv + (pv - zv) * mu_rkv[1024 + c];
    float wl = w0[c] + WL[(size_t)row * 512 + c];
    float nx = -wl; float sp = nx > 20.f ? nx : log1pf(expf(nx));
    float decay = expf(-expf(-sp - 0.5f));
    float a = 1.f / (1.f + expf(-(a0[c] + AL[(size_t)row * 512 + c])));
    float kk = k * k_k[c];
    float ss = kk * kk;
    for (int o = 32; o > 0; o >>= 1) ss += __shfl_xor(ss, o);
    kk = kk * rsqrtf(fmaxf(ss, 1e-24f));
    float k2 = k * (1.f + (a - 1.f) * k_a[c]);
    size_t o = (size_t)row * 512 + c;
    R[o] = r; W[o] = decay; K2[o] = k2; V[o] = v; A2[o] = -kk; B2[o] = kk * a;
}

__global__ void __launch_bounds__(64) rwkv_scan_naive(const float* R, const float* W, const float* K2, const float* V, const float* A2, const float* B2, float* Y) {
    __shared__ float sh[5][16][64];
    const int hd = blockIdx.x, lane = threadIdx.x;
    float st[64];
#pragma unroll
    for (int i = 0; i < 64; ++i) st[i] = 0.f;
    for (int t0 = 0; t0 < S_; t0 += 16) {
        __syncthreads();
        for (int i = 0; i < 16; ++i) {
            size_t o = (size_t)(t0 + i) * 512 + hd * 64 + lane;
            sh[0][i][lane] = R[o]; sh[1][i][lane] = W[o]; sh[2][i][lane] = K2[o]; sh[3][i][lane] = A2[o]; sh[4][i][lane] = B2[o];
        }
        __syncthreads();
        for (int i = 0; i < 16; ++i) {
            float v = V[(size_t)(t0 + i) * 512 + hd * 64 + lane];
            float sa = 0.f;
#pragma unroll
            for (int k = 0; k < 64; ++k) sa = fmaf(st[k], sh[3][i][k], sa);
            float y = 0.f;
#pragma unroll
            for (int k = 0; k < 64; ++k) { st[k] = st[k] * sh[1][i][k] + sa * sh[4][i][k] + v * sh[2][i][k]; y = fmaf(st[k], sh[0][i][k], y); }
            Y[(size_t)(t0 + i) * 512 + hd * 64 + lane] = y;
        }
    }
}

__global__ void __launch_bounds__(256) rwkv_post(const float* Y, const float* R, const float* K2, const float* V, const float* G, const float* r_k, const float* gn_w, const float* gn_b, float* MIX) {
    const int gw = blockIdx.x * 4 + (threadIdx.x >> 6), lane = threadIdx.x & 63;
    const int row = gw / 8, hd = gw % 8, c = hd * 64 + lane; const size_t o = (size_t)row * 512 + c;
    float y = Y[o];
    float s = y; for (int of = 32; of > 0; of >>= 1) s += __shfl_xor(s, of);
    float mu = s * (1.f / 64.f); float d = y - mu; float q = d * d; for (int of = 32; of > 0; of >>= 1) q += __shfl_xor(q, of);
    float yn = d * rsqrtf(q * (1.f / 64.f) + 64e-5f) * gn_w[c] + gn_b[c];
    float b = R[o] * K2[o] * r_k[c]; for (int of = 32; of > 0; of >>= 1) b += __shfl_xor(b, of);
    MIX[(size_t)row * 1024 + 512 + c] = (yn + b * V[o]) * G[o];
}

__global__ void __launch_bounds__(256) route(const float* LOG, int* cnt, int* list, float* wts, int M, int cap) {
    const int t = blockIdx.x * 256 + threadIdx.x; if (t >= M) return;
    const float* l = LOG + (size_t)t * 36;
    int gs = 0; float gm = l[0];
    for (int i = 1; i < 4; ++i) if (l[i] > gm) { gm = l[i]; gs = i; }
    float den = 0.f; for (int i = 0; i < 4; ++i) den += expf(l[i] - gm);
    float gw = 1.f / den;
    const float* e = l + 4 + 8 * gs;
    int i0 = 0; float v0 = e[0];
    for (int i = 1; i < 8; ++i) if (e[i] > v0) { v0 = e[i]; i0 = i; }
    int i1 = -1; float v1 = -INFINITY;
    for (int i = 0; i < 8; ++i) if (i != i0 && e[i] > v1) { v1 = e[i]; i1 = i; }
    float p1 = expf(v1 - v0); float w0 = gw / (1.f + p1), w1 = gw * p1 / (1.f + p1);
    wts[t * 2] = w0; wts[t * 2 + 1] = w1;
    int e0 = gs * 8 + i0, e1 = gs * 8 + i1;
    int p = atomicAdd(&cnt[e0], 1); list[e0 * cap + p] = t * 2;
    p = atomicAdd(&cnt[e1], 1); list[e1 * cap + p] = t * 2 + 1;
}

__global__ void __launch_bounds__(256) expert_up(const float* H2, const float* Wg, const float* Wu, const int* cnt, const int* list, float* HID, int cap) {
    __shared__ float As[16][68];
    __shared__ float Bg[16][68];
    __shared__ float Bu[16][68];
    const int e = blockIdx.z, M = cnt[e], m0 = blockIdx.y * 64, n0 = blockIdx.x * 64;
    if (m0 >= M) return;
    const int* rows = list + e * cap;
    const float* wg = Wg + (size_t)e * 1024 * 512; const float* wu = Wu + (size_t)e * 1024 * 512;
    const int tid = threadIdx.x, ty = tid / 16, tx = tid % 16;
    float ag[4][4], au[4][4];
    for (int i = 0; i < 4; ++i) for (int j = 0; j < 4; ++j) { ag[i][j] = 0.f; au[i][j] = 0.f; }
    for (int k0 = 0; k0 < 1024; k0 += 16) {
        for (int i = 0; i < 4; ++i) {
            int idx = tid + i * 256; int m = idx / 16, k = idx % 16;
            As[k][m] = (m0 + m < M) ? H2[(size_t)(rows[m0 + m] / 2) * 1024 + k0 + k] : 0.f;
            int kb = idx / 64, n = idx % 64;
            Bg[kb][n] = wg[(size_t)(k0 + kb) * 512 + n0 + n]; Bu[kb][n] = wu[(size_t)(k0 + kb) * 512 + n0 + n];
        }
        __syncthreads();
        for (int k = 0; k < 16; ++k) {
            float a[4], b[4], c[4];
            for (int i = 0; i < 4; ++i) { a[i] = As[k][ty * 4 + i]; b[i] = Bg[k][tx * 4 + i]; c[i] = Bu[k][tx * 4 + i]; }
            for (int i = 0; i < 4; ++i) for (int j = 0; j < 4; ++j) { ag[i][j] = fmaf(a[i], b[j], ag[i][j]); au[i][j] = fmaf(a[i], c[j], au[i][j]); }
        }
        __syncthreads();
    }
    for (int i = 0; i < 4; ++i) for (int j = 0; j < 4; ++j) {
        int m = m0 + ty * 4 + i, n = n0 + tx * 4 + j;
        if (m < M) { float g = ag[i][j]; HID[(size_t)rows[m] * 512 + n] = g / (1.f + expf(-g)) * au[i][j]; }
    }
}
__global__ void __launch_bounds__(256) expert_down(const float* HID, const float* Wd, const int* cnt, const int* list, float* YE, int cap) {
    __shared__ float As[16][68];
    __shared__ float Bs[16][68];
    const int e = blockIdx.z, M = cnt[e], m0 = blockIdx.y * 64, n0 = blockIdx.x * 64;
    if (m0 >= M) return;
    const int* rows = list + e * cap;
    const float* wd = Wd + (size_t)e * 512 * 1024;
    const int tid = threadIdx.x, ty = tid / 16, tx = tid % 16;
    float acc[4][4];
    for (int i = 0; i < 4; ++i) for (int j = 0; j < 4; ++j) acc[i][j] = 0.f;
    for (int k0 = 0; k0 < 512; k0 += 16) {
        for (int i = 0; i < 4; ++i) {
            int idx = tid + i * 256; int m = idx / 16, k = idx % 16;
            As[k][m] = (m0 + m < M) ? HID[(size_t)rows[m0 + m] * 512 + k0 + k] : 0.f;
            int kb = idx / 64, n = idx % 64;
            Bs[kb][n] = wd[(size_t)(k0 + kb) * 1024 + n0 + n];
        }
        __syncthreads();
        for (int k = 0; k < 16; ++k) {
            float a[4], b[4];
            for (int i = 0; i < 4; ++i) { a[i] = As[k][ty * 4 + i]; b[i] = Bs[k][tx * 4 + i]; }
            for (int i = 0; i < 4; ++i) for (int j = 0; j < 4; ++j) acc[i][j] = fmaf(a[i], b[j], acc[i][j]);
        }
        __syncthreads();
    }
    for (int i = 0; i < 4; ++i) for (int j = 0; j < 4; ++j) {
        int m = m0 + ty * 4 + i, n = n0 + tx * 4 + j;
        if (m < M) YE[(size_t)rows[m] * 1024 + n] = acc[i][j];
    }
}
__global__ void __launch_bounds__(256) moe_combine(const float* X1, const float* YE, const float* wts, float* X2) {
    const size_t t = blockIdx.x; const int c = threadIdx.x * 4;
    float4 x = *(const float4*)(X1 + t * 1024 + c), a = *(const float4*)(YE + (2 * t) * 1024 + c), b = *(const float4*)(YE + (2 * t + 1) * 1024 + c);
    float w0 = wts[2 * t], w1 = wts[2 * t + 1];
    float4 o; o.x = x.x + w0 * a.x + w1 * b.x; o.y = x.y + w0 * a.y + w1 * b.y; o.z = x.z + w0 * a.z + w1 * b.z; o.w = x.w + w0 * a.w + w1 * b.w;
    *(float4*)(X2 + t * 1024 + c) = o;
}
__global__ void __launch_bounds__(256) final_pl(const float* X2, const float* PE, const float* GATE, const float* g, float* out) {
    __shared__ float red[4];
    const size_t row = blockIdx.x; const int t = threadIdx.x;
    float4 v = *(const float4*)(PE + row * 1024 + t * 4);
    float ss = block_sum256(v.x * v.x + v.y * v.y + v.z * v.z + v.w * v.w, red);
    float r = rsqrtf(ss * (1.f / 1024.f) + 1e-6f);
    float4 gg = *(const float4*)(g + t * 4), x = *(const float4*)(X2 + row * 1024 + t * 4), ga = *(const float4*)(GATE + row * 1024 + t * 4);
    float4 o;
    o.x = x.x + v.x * r * gg.x / (1.f + expf(-ga.x)); o.y = x.y + v.y * r * gg.y / (1.f + expf(-ga.y));
    o.z = x.z + v.z * r * gg.z / (1.f + expf(-ga.z)); o.w = x.w + v.w * r * gg.w / (1.f + expf(-ga.w));
    *(float4*)(out + row * 1024 + t * 4) = o;
}

template <class AL, int ACT>
static void gemm(hipStream_t st, AL al, const float* B, int ldb, float* C, int ldc, const float* Cadd, int ldadd, int M, int N, int K) {
    dim3 grid((N + 63) / 64, (M + 63) / 64);
    sgemm<AL, ACT><<<grid, 256, 0, st>>>(al, B, ldb, C, ldc, Cadd, ldadd, M, nullptr, N, K);
}

struct NBufs { float *Z, *L1, *L2, *L3, *PE, *MIX, *Y, *X1; };
static NBufs forward_batch(void* const* d_in, int b, float* out, float* ws, hipStream_t st, int mode, int part) {
    auto F = [&](int i) { return (const float*)d_in[i]; };
    const float* x = F(0) + (size_t)b * S_ * D_; const float* p = F(1) + (size_t)b * S_ * 256; const int* pos = (const int*)d_in[2] + b * S_;
    size_t o = 0; auto take = [&](size_t n) { float* r = ws + o; o += (n + 63) / 64 * 64; return r; };
    float* HN = take((size_t)MB * 1024); float* Z = take((size_t)MB * 3072); float* MIX = take((size_t)MB * 1024);
    float* L1 = take((size_t)MB * 64); float* L2 = take((size_t)MB * 64); float* L3 = take((size_t)MB * 160);
    float* WL = take((size_t)MB * 512); float* AL = take((size_t)MB * 512); float* G = take((size_t)MB * 512);
    float* R = take((size_t)MB * 512); float* W = take((size_t)MB * 512); float* K2 = take((size_t)MB * 512); float* V = take((size_t)MB * 512);
    float* A2 = take((size_t)MB * 512); float* B2 = take((size_t)MB * 512); float* Y = take((size_t)MB * 512);
    float* X1 = take((size_t)MB * 1024); float* H2 = take((size_t)MB * 1024); float* LOG = take((size_t)MB * 36);
    float* wts = take((size_t)MB * 2); int* cnt = (int*)take(64); int* list = (int*)take((size_t)32 * MB);
    float* HID = take((size_t)MB * 2 * 512); float* YE = take((size_t)MB * 2 * 1024); float* X2 = take((size_t)MB * 1024);
    float* PE = take((size_t)MB * 1024); float* GATE = take((size_t)MB * 1024);

    NBufs nb{Z, L1, L2, L3, PE, MIX, Y, X1};
    if (part == 0) return nb;
    if (mode == 0) {
    rmsnorm1024<<<MB, 256, 0, st>>>(x, F(3), HN, 1e-6f);
    gemm<ALPlain, 0>(st, ALPlain{HN, 1024, 0}, F(4), 3072, Z, 3072, nullptr, 0, MB, 3072, 1024);
    gemm<ALShiftMix, 1>(st, ALShiftMix{HN, F(13)}, F(15), 64, L1, 64, nullptr, 0, MB, 64, 1024);
    gemm<ALShiftMix, 0>(st, ALShiftMix{HN, F(13) + 1024}, F(18), 64, L2, 64, nullptr, 0, MB, 64, 1024);
    gemm<ALShiftMix, 2>(st, ALShiftMix{HN, F(13) + 2048}, F(20), 160, L3, 160, nullptr, 0, MB, 160, 1024);
    }
    if (mode < 3) {
    gemm<ALPlain, 0>(st, ALPlain{L1, 64, 0}, F(16), 512, WL, 512, nullptr, 0, MB, 512, 64);
    gemm<ALPlain, 0>(st, ALPlain{L2, 64, 0}, F(19), 512, AL, 512, nullptr, 0, MB, 512, 64);
    gemm<ALPlain, 0>(st, ALPlain{L3, 160, 0}, F(21), 512, G, 512, nullptr, 0, MB, 512, 160);
    rwkv_prep<<<MB * 8 / 4, 256, 0, st>>>(Z, WL, AL, F(12), F(14), F(17), F(22), F(23), R, W, K2, V, A2, B2);
    rwkv_scan_naive<<<8, 64, 0, st>>>(R, W, K2, V, A2, B2, Y);
    rwkv_post<<<MB * 8 / 4, 256, 0, st>>>(Y, R, K2, V, G, F(24), F(25), F(26), MIX);
    }
    if (mode == 0) qk_prep<<<MB * 16 / 4, 256, 0, st>>>(Z, pos, F(5), F(6));
    if (mode < 2) attn_naive<<<dim3(S_ / 32, 4), 256, 0, st>>>(Z, MIX, F(7), F(8), F(9), F(10), F(11));
    gemm<ALPlain, 0>(st, ALPlain{MIX, 1024, 0}, F(27), 1024, X1, 1024, x, 1024, MB, 1024, 1024);
    rmsnorm1024<<<MB, 256, 0, st>>>(X1, F(28), H2, 1e-6f);
    gemm<ALPlain, 0>(st, ALPlain{H2, 1024, 0}, F(29), 4, LOG, 36, nullptr, 0, MB, 4, 1024);
    for (int g = 0; g < 4; ++g) gemm<ALPlain, 0>(st, ALPlain{H2, 1024, 0}, F(30) + (size_t)g * 1024 * 8, 8, LOG + 4 + 8 * g, 36, nullptr, 0, MB, 8, 1024);
    hipMemsetAsync(cnt, 0, 64 * sizeof(int), st);
    route<<<MB / 256, 256, 0, st>>>(LOG, cnt, list, wts, MB, MB);
    expert_up<<<dim3(512 / 64, MB / 64, 32), 256, 0, st>>>(H2, F(31), F(32), cnt, list, HID, MB);
    expert_down<<<dim3(1024 / 64, MB / 64, 32), 256, 0, st>>>(HID, F(33), cnt, list, YE, MB);
    moe_combine<<<MB, 256, 0, st>>>(X1, YE, wts, X2);
    rmsnorm1024<<<MB, 256, 0, st>>>(X2, F(36), H2, 1e-6f);
    gemm<ALPlain, 0>(st, ALPlain{H2, 1024, 0}, F(37), 1024, GATE, 1024, nullptr, 0, MB, 1024, 1024);
    if (mode == 0) gemm<ALPlain, 0>(st, ALPlain{p, 256, 0}, F(34), 1024, PE, 1024, nullptr, 0, MB, 1024, 256);
    final_pl<<<MB, 256, 0, st>>>(X2, PE, GATE, F(35), out);
    return nb;
}
}

namespace mk {
#define LAS __attribute__((address_space(3)))
#define GAS __attribute__((address_space(1)))
typedef _Float16 f16;
typedef _Float16 h8 __attribute__((ext_vector_type(8)));
typedef _Float16 h4 __attribute__((ext_vector_type(4)));
typedef _Float16 h2 __attribute__((ext_vector_type(2)));
typedef float f32x4 __attribute__((ext_vector_type(4)));
typedef float f32x2 __attribute__((ext_vector_type(2)));
typedef float f32x16 __attribute__((ext_vector_type(16)));
typedef unsigned u32x4 __attribute__((ext_vector_type(4)));
typedef unsigned u32x2 __attribute__((ext_vector_type(2)));

constexpr int NB = MK_NB;
constexpr int SEQ = 2048, DM = 1024;
constexpr int M = NB * SEQ;
constexpr int BM = 256, BK = 64, HALF = 128, HTB = HALF * BK * 2, STAGE_BYTES = 8 * HTB, NXCD = 8, WGM = 8;
constexpr int NWAVES = 8, NTHR = 512;
constexpr float C2 = 0.125f * 1.4426950408889634f;

__device__ __forceinline__ unsigned pkh(float lo, float hi) { h2 v = {(f16)lo, (f16)hi}; return __builtin_bit_cast(unsigned, v); }

__host__ __device__ __forceinline__ int lds_byte(int r, int c) { const int st = (r >> 4) * 2 + (c >> 5), rr = r & 15, cc = c & 31, ob = rr * 64 + cc * 2; return st * 1024 + (ob ^ (((ob >> 9) & 1) << 5)); }
__host__ __device__ __forceinline__ void stage_rc(int b, int& R, int& C) { const int st = b / 1024, sb = b % 1024, swz = sb ^ (((sb >> 9) & 1) << 5); R = (st >> 1) * 16 + swz / 64; C = (st & 1) * 32 + (swz % 64) / 2; }
__host__ __device__ __forceinline__ int perm32(int rho) { const int n = rho >> 4, i = rho & 15; return 8 * (i >> 2) + 4 * n + (i & 3); }

struct GU { const char* a; const char* b; char* o; const int* glist; const int* elist; int nt, lda2, ldb2, hsa, hsb, bmode, epi, pm, pn, aux, ldc, oc0, gcnt; };

template <class Sched, class Epi>
__device__ __forceinline__ void gemm_phase(LAS unsigned char* lds, const Sched& S, const Epi& E, const int tid) {
    const int wid = __builtin_amdgcn_readfirstlane(tid >> 6), lane = tid & 63, wr = wid >> 2, wc = wid & 3, fr = lane & 15, fq = lane >> 4;
    unsigned voffA[2], voffAh[2], voffB[2]; int hsB;
#define MK_SETV(u) do { int ln_; asm volatile("v_mbcnt_lo_u32_b32 %0, -1, 0\n\tv_mbcnt_hi_u32_b32 %0, -1, %0" : "=v"(ln_)); const int t16_ = (wid * 64 + ln_) * 16; \
        int R0, C0, R1, C1; stage_rc(t16_, R0, C0); stage_rc(t16_ + 8192, R1, C1); \
        if ((u).glist) { \
            const int g00 = R0 < (u).gcnt ? (u).glist[R0] >> 1 : 0, g01 = R1 < (u).gcnt ? (u).glist[R1] >> 1 : 0, g10 = R0 + 128 < (u).gcnt ? (u).glist[R0 + 128] >> 1 : 0, g11 = R1 + 128 < (u).gcnt ? (u).glist[R1 + 128] >> 1 : 0; \
            voffA[0] = (unsigned)(g00 * (u).lda2 + C0 * 2); voffA[1] = (unsigned)(g01 * (u).lda2 + C1 * 2); voffAh[0] = (unsigned)(g10 * (u).lda2 + C0 * 2); voffAh[1] = (unsigned)(g11 * (u).lda2 + C1 * 2); \
        } else { voffA[0] = (unsigned)(R0 * (u).lda2 + C0 * 2); voffA[1] = (unsigned)(R1 * (u).lda2 + C1 * 2); voffAh[0] = voffA[0] + (unsigned)(u).hsa; voffAh[1] = voffA[1] + (unsigned)(u).hsa; } \
        const int rb0 = (u).bmode == 0 ? R0 : (u).bmode == 1 ? ((R0 & ~31) + perm32(R0 & 31)) : (64 * ((R0 >> 5) & 3) + perm32(R0 & 31)); \
        const int rb1 = (u).bmode == 0 ? R1 : (u).bmode == 1 ? ((R1 & ~31) + perm32(R1 & 31)) : (64 * ((R1 >> 5) & 3) + perm32(R1 & 31)); \
        voffB[0] = (unsigned)(rb0 * (u).ldb2 + C0 * 2); voffB[1] = (unsigned)(rb1 * (u).ldb2 + C1 * 2); hsB = (u).hsb; } while (0)
    const size_t kstep = (size_t)(BK * 2);
    const unsigned ldsw = (unsigned)wid * 1024u;
    const int aoff = lds_byte(wr * 64 + fr, fq * 8), boff = lds_byte(wc * 32 + fr, fq * 8);
#define MK_SA(b, h) (((b) * 2 + (h)) * HTB)
#define MK_SB(b, h) ((4 + (b) * 2 + (h)) * HTB)
#define MK_STAGE(bufoff, gbase, voff) do { _Pragma("unroll") for (int _i = 0; _i < 2; ++_i) \
        __builtin_amdgcn_global_load_lds((const unsigned*)((const char*)(gbase) + (voff)[_i]), (LAS unsigned*)(lds + (bufoff) + ldsw + _i * 8192), 16, 0, 0); } while (0)
#define MK_LDA(dst, b, h) do { _Pragma("unroll") for (int m = 0; m < 4; ++m) _Pragma("unroll") for (int k = 0; k < 2; ++k) dst[m][k] = *(const LAS h8*)(lds + MK_SA(b, h) + aoff + m * 2048 + k * 1024); } while (0)
#define MK_LDB(dst, b, h) do { _Pragma("unroll") for (int n = 0; n < 2; ++n) _Pragma("unroll") for (int k = 0; k < 2; ++k) dst[n][k] = *(const LAS h8*)(lds + MK_SB(b, h) + boff + n * 2048 + k * 1024); } while (0)
#define MK_MMA(ai, bj, At, Bt) do { __builtin_amdgcn_s_setprio(1); _Pragma("unroll") for (int m = 0; m < 4; ++m) _Pragma("unroll") for (int n = 0; n < 2; ++n) _Pragma("unroll") for (int k = 0; k < 2; ++k) \
        acc[ai][bj][m][n] = __builtin_amdgcn_mfma_f32_16x16x32_f16(Bt[n][k], At[m][k], acc[ai][bj][m][n], 0, 0, 0); __builtin_amdgcn_s_setprio(0); } while (0)
#define MK_WAIT_V(n) asm volatile("s_waitcnt vmcnt(" #n ")" ::: "memory")
#define MK_WAIT_L(n) asm volatile("s_waitcnt lgkmcnt(" #n ")" ::: "memory")
#define MK_BAR __builtin_amdgcn_s_barrier()
#define MK_SCHED __builtin_amdgcn_sched_barrier(0)
    GU cur, nxt; int ui = 0;
    if (!S.next(0, cur)) return;
    f32x4 acc[2][2][4][2];
#pragma unroll
    for (int a = 0; a < 2; ++a)
#pragma unroll
        for (int b = 0; b < 2; ++b)
#pragma unroll
            for (int m = 0; m < 4; ++m)
#pragma unroll
                for (int n = 0; n < 2; ++n) acc[a][b][m][n] = (f32x4){0.f, 0.f, 0.f, 0.f};
    h8 At[4][2], B0[2][2], B1[2][2];
    const char* cA = cur.a; const char* cB = cur.b;
    MK_SETV(cur);
    MK_STAGE(MK_SB(0, 0), cB, voffB); MK_STAGE(MK_SB(0, 1), cB + hsB, voffB); MK_STAGE(MK_SA(0, 0), cA, voffA); MK_STAGE(MK_SA(0, 1), cA, voffAh);
    if (wr == 1) MK_BAR;
    MK_WAIT_V(2); MK_BAR;
    MK_STAGE(MK_SB(1, 0), cB + kstep, voffB); MK_STAGE(MK_SA(1, 0), cA + kstep, voffA); MK_STAGE(MK_SB(1, 1), cB + hsB + kstep, voffB);
    MK_WAIT_V(6); MK_BAR;
    for (;;) {
        bool has_next = false; const char* nA = cA; const char* nB = cB;
        const int nt = cur.nt;
        for (int t = 0; t < nt; t += 2) {
            const bool last = (t == nt - 2);
            if (last) { has_next = S.next(ui + 1, nxt); if (has_next) { nA = nxt.a; nB = nxt.b; } }
            const char* a1 = cA + (size_t)(t + 1) * kstep;
            const char* a2 = last ? nA : cA + (size_t)(t + 2) * kstep; const char* b2 = last ? nB : cB + (size_t)(t + 2) * kstep;
            const char* a3 = a2 + kstep; const char* b3 = b2 + kstep;
            MK_LDB(B0, 0, 0); MK_LDB(B1, 0, 1); MK_SCHED; MK_LDA(At, 0, 0); MK_STAGE(MK_SA(1, 1), a1, voffAh);
            if (last && has_next) { MK_SETV(nxt); }
            MK_WAIT_V(8); MK_WAIT_L(0); MK_BAR; MK_MMA(0, 0, At, B0); MK_MMA(0, 1, At, B1); MK_BAR; MK_SCHED;
            MK_LDA(At, 0, 1); MK_STAGE(MK_SB(0, 0), b2, voffB); MK_STAGE(MK_SB(0, 1), b2 + hsB, voffB); MK_STAGE(MK_SA(0, 0), a2, voffA);
            MK_WAIT_V(8); MK_WAIT_L(0); MK_BAR; MK_MMA(1, 0, At, B0); MK_MMA(1, 1, At, B1); MK_BAR; MK_SCHED;
            MK_LDB(B0, 1, 0); MK_LDB(B1, 1, 1); MK_SCHED; MK_LDA(At, 1, 0); MK_STAGE(MK_SA(0, 1), a2, voffAh);
            MK_WAIT_V(8); MK_WAIT_L(0); MK_BAR; MK_MMA(0, 0, At, B0); MK_MMA(0, 1, At, B1); MK_BAR; MK_SCHED;
            MK_LDA(At, 1, 1); MK_STAGE(MK_SB(1, 0), b3, voffB); MK_STAGE(MK_SB(1, 1), b3 + hsB, voffB); MK_STAGE(MK_SA(1, 0), a3, voffA);
            MK_WAIT_V(8); MK_WAIT_L(0); MK_BAR; MK_MMA(1, 0, At, B0); MK_MMA(1, 1, At, B1); MK_BAR; MK_SCHED;
        }
        if (wr == 0) MK_BAR;
        E(acc, cur, wr, wc, fr, fq);
        if (!has_next) break;
#pragma unroll
        for (int a = 0; a < 2; ++a)
#pragma unroll
            for (int b = 0; b < 2; ++b)
#pragma unroll
                for (int m = 0; m < 4; ++m)
#pragma unroll
                    for (int n = 0; n < 2; ++n) acc[a][b][m][n] = (f32x4){0.f, 0.f, 0.f, 0.f};
        cur = nxt; cA = nA; cB = nB; ++ui;
        if (wr == 1) MK_BAR;
    }
    MK_WAIT_V(0);
    MK_BAR;
#undef MK_SETV
#undef MK_SA
#undef MK_SB
#undef MK_STAGE
#undef MK_LDA
#undef MK_LDB
#undef MK_MMA
#undef MK_WAIT_V
#undef MK_WAIT_L
#undef MK_BAR
#undef MK_SCHED
}
}
namespace attn_body {
using mk::h8; using mk::f16;
using bf16=_Float16;
using bf16x8=mk::h8;
using s16x4=__attribute__((ext_vector_type(4)))short; using s16x8=__attribute__((ext_vector_type(8)))short;
using f32x16=__attribute__((ext_vector_type(16)))float;
using u32x4=__attribute__((ext_vector_type(4)))unsigned;
constexpr int BATCH=MK_NB,NHEAD=16,SEQ=2048,D=64,DM=1024; constexpr int QKP=512,VP=512,OP=1024;
constexpr int NW=8,QBLK=32,QB=QBLK*NW,KVBLK=64,NQB=SEQ/QB;
constexpr int ATTN_PITCH=DM, ATTN_UNIT_ROWS=QB;
__device__ __forceinline__ int crow(int r,int hi){return (r&3)+8*(r>>2)+4*hi;}
#define SBAR() __builtin_amdgcn_sched_barrier(0)
__device__ __forceinline__ void cmask(f32x16&p0,f32x16&p1,int jb,int qrel,int hi){
  const float NEG=-INFINITY; int kb=64*jb+4*hi;
  #pragma unroll
  for(int r=0;r<16;++r){int kv=kb+(r&3)+8*(r>>2); if(kv>qrel)p0[r]=NEG; if(kv+32>qrel)p1[r]=NEG;}
}

constexpr int NSLOT=3, SLOTB=8192;
constexpr int LDS_K=0, LDS_V=NSLOT*SLOTB, LDS_WS=2*NSLOT*SLOTB, LDS_OST=LDS_WS+NW*64*4, LDS_BYTES=LDS_OST+NW*4096;
constexpr float C2=0.125f*1.4426950408889634f;
__device__ __forceinline__ void glds16(const void*gsrc,unsigned lds_dst){unsigned keep;
  asm volatile("s_mov_b32 %0, m0\n\ts_mov_b32 m0, %2\n\ts_nop 0\n\tglobal_load_lds_dwordx4 %1, off\n\ts_mov_b32 m0, %0":"=&s"(keep):"v"(gsrc),"s"(lds_dst):"memory");}
__device__ __forceinline__ float max3f(float a,float b,float c){float r;asm("v_max3_f32 %0, %1, %2, %3":"=v"(r):"v"(a),"v"(b),"v"(c));return r;}
__device__ __forceinline__ float max2f(float a,float b){float r;asm("v_max_f32_e32 %0, %1, %2":"=v"(r):"v"(a),"v"(b));return r;}
__device__ __forceinline__ float fadd_s(float a,float b){float r;asm("v_add_f32_e32 %0, %1, %2":"=v"(r):"v"(a),"v"(b));return r;}
__device__ __forceinline__ float fsub_s(float a,float b){float r;asm("v_sub_f32_e32 %0, %1, %2":"=v"(r):"v"(a),"v"(b));return r;}
typedef float f32x2_t __attribute__((ext_vector_type(2))); typedef _Float16 bf16x2_t __attribute__((ext_vector_type(2)));
__device__ __forceinline__ unsigned cvtpk_s(float lo,float hi){f32x2_t v={lo,hi};bf16x2_t b=__builtin_convertvector(v,bf16x2_t);return __builtin_bit_cast(unsigned,b);}
#define WAIT_BAR(N) asm volatile("s_waitcnt vmcnt(" #N ") lgkmcnt(0)\n\ts_barrier":::"memory")

__device__ __forceinline__ void qkt(f32x16&p0,f32x16&p1,const char*Kslot,const bf16x8*qr,const f32x16&negm,int r32,int hi){
  const char*kb=Kslot+hi*1024+r32*16;
  #pragma unroll
  for(int d0=0;d0<4;++d0){
    const bf16x8 b0=*reinterpret_cast<const bf16x8*>(kb+d0*2048);
    const bf16x8 b1=*reinterpret_cast<const bf16x8*>(kb+d0*2048+512);
    if(d0==0){p0=__builtin_amdgcn_mfma_f32_32x32x16_f16(b0,qr[0],negm,0,0,0);p1=__builtin_amdgcn_mfma_f32_32x32x16_f16(b1,qr[0],negm,0,0,0);}
    else{p0=__builtin_amdgcn_mfma_f32_32x32x16_f16(b0,qr[d0],p0,0,0,0);p1=__builtin_amdgcn_mfma_f32_32x32x16_f16(b1,qr[d0],p1,0,0,0);}}
}
typedef __attribute__((address_space(3))) const char* lds_cptr;
typedef short v4i16_t __attribute__((ext_vector_type(4)));
__device__ __forceinline__ void kload8(bf16x8*kf,lds_cptr kp){
  kf[0]=*(const __attribute__((address_space(3))) bf16x8*)(kp);      kf[1]=*(const __attribute__((address_space(3))) bf16x8*)(kp+512);
  kf[2]=*(const __attribute__((address_space(3))) bf16x8*)(kp+2048); kf[3]=*(const __attribute__((address_space(3))) bf16x8*)(kp+2560);
  kf[4]=*(const __attribute__((address_space(3))) bf16x8*)(kp+4096); kf[5]=*(const __attribute__((address_space(3))) bf16x8*)(kp+4608);
  kf[6]=*(const __attribute__((address_space(3))) bf16x8*)(kp+6144); kf[7]=*(const __attribute__((address_space(3))) bf16x8*)(kp+6656);
}
__device__ __forceinline__ void kload2(bf16x8*kf,lds_cptr kp,int j){ kf[2*j]=*(const __attribute__((address_space(3))) bf16x8*)(kp+j*2048); kf[2*j+1]=*(const __attribute__((address_space(3))) bf16x8*)(kp+j*2048+512); }
__device__ __forceinline__ s16x4 vtr(lds_cptr p){ return __builtin_bit_cast(s16x4,__builtin_amdgcn_ds_read_tr16_b64_v4i16((__attribute__((address_space(3))) v4i16_t*)p)); }
__device__ __forceinline__ float rowmax(const f32x16&p0,const f32x16&p1){
  float a=max3f(p0[0],p0[1],p1[0]),b=max3f(p0[2],p0[3],p1[1]);a=max3f(a,p1[2],p1[3]);
  #pragma unroll
  for(int r=4;r<16;r+=4){a=max3f(a,p0[r],p0[r+1]);b=max3f(b,p0[r+2],p0[r+3]);a=max3f(a,p1[r],p1[r+1]);b=max3f(b,p1[r+2],p1[r+3]);}
  const float m=max2f(a,b);
  auto rr=__builtin_amdgcn_permlane32_swap(__float_as_uint(m),__float_as_uint(m),false,false);
  return max2f(__uint_as_float(rr[0]),__uint_as_float(rr[1]));
}
__device__ __forceinline__ void pv(f32x16*o,int vb,bf16x8 pa0,bf16x8 pa1,bf16x8 pa2,bf16x8 pa3){
  #pragma unroll
  for(int d0=0;d0<2;++d0){s16x4 lo[4],hi[4];
    #pragma unroll
    for(int ks=0;ks<4;++ks){
      asm volatile("ds_read_b64_tr_b16 %0,%1 offset:%c2":"=&v"(lo[ks]):"v"(vb),"i"(d0*4096+ks*1024):"memory");
      asm volatile("ds_read_b64_tr_b16 %0,%1 offset:%c2":"=&v"(hi[ks]):"v"(vb),"i"(d0*4096+ks*1024+512):"memory");}
    asm volatile("s_waitcnt lgkmcnt(0)":::"memory");SBAR();
    #define PK(k) __builtin_bit_cast(bf16x8,(s16x8){lo[k][0],lo[k][1],lo[k][2],lo[k][3],hi[k][0],hi[k][1],hi[k][2],hi[k][3]})
    o[d0]=__builtin_amdgcn_mfma_f32_32x32x16_f16(pa0,PK(0),o[d0],0,0,0);
    o[d0]=__builtin_amdgcn_mfma_f32_32x32x16_f16(pa1,PK(1),o[d0],0,0,0);
    o[d0]=__builtin_amdgcn_mfma_f32_32x32x16_f16(pa2,PK(2),o[d0],0,0,0);
    o[d0]=__builtin_amdgcn_mfma_f32_32x32x16_f16(pa3,PK(3),o[d0],0,0,0);
    #undef PK
  }
}

#ifndef ATTN_STORE16
#define ATTN_STORE16(p,v) (*(u32x4*)(p)=(v))
#endif
template<int THRL> __device__ __forceinline__ void attn_unit(int b,int vh,int qb,const bf16*Q,const bf16*__restrict__ K,const bf16*__restrict__ V,bf16*O,char*shm,const int wave_s){
  int tid; asm volatile("v_mbcnt_lo_u32_b32 %0, -1, 0\n\tv_mbcnt_hi_u32_b32 %0, -1, %0" : "=v"(tid)); tid+=wave_s*64;
  const int hh=vh>>2,mp=(vh>>1)&1,vhf=vh&1; const int qcol=hh*128+mp*64, vcol=hh*128+vhf*64, ocol=mp*512+hh*128+vhf*64;
  const int lane=tid&63,r32=lane&31,hi=lane>>5; const int wid=__builtin_amdgcn_readfirstlane(tid>>6);
  const long rowbase=(long)b*SEQ; const int q0=qb*QB;
  const bf16*Qw=Q+(rowbase+q0+wid*QBLK)*QKP+qcol;
  const bf16*Kh=K+rowbase*QKP+qcol,*Vh=V+rowbase*VP+vcol;
  const unsigned lds0=(unsigned)(uintptr_t)shm;
  float*wsf=(float*)(shm+LDS_WS)+wid*64;
  const bf16*ksrc=Kh+(long)lane*QKP+wid*8;
  const bf16*vsrc=Vh+(long)(16*(wid&3)+(lane>>2))*VP+(wid>>2)*32+(lane&3)*8;
  const unsigned kdst=lds0+LDS_K+wid*1024, vdst=lds0+LDS_V+wid*1024;
  #define DMA_K(t,slot) glds16(ksrc+(long)(t)*KVBLK*QKP,(unsigned)__builtin_amdgcn_readfirstlane(kdst+(slot)))
  #define DMA_V(t,slot) glds16(vsrc+(long)(t)*KVBLK*VP,(unsigned)__builtin_amdgcn_readfirstlane(vdst+(slot)))
  const int vb0=(int)(lds0+LDS_V)+((lane>>4)&1)*32+(lane&3)*8+(4*hi+((lane&15)>>2))*64;
  const char*Kbase=shm+LDS_K; bf16x8 kf[8];
  const lds_cptr shm3=(lds_cptr)shm; const lds_cptr kp0=shm3+LDS_K+hi*1024+r32*16; const lds_cptr vp0=shm3+LDS_V+((lane>>4)&1)*32+(lane&3)*8+(4*hi+((lane&15)>>2))*64;
  const int NT=(q0+QB)/KVBLK;
  DMA_K(0,0);DMA_V(0,0);DMA_K(1,SLOTB);
  bf16x8 qr[4];
  #pragma unroll
  for(int d0=0;d0<4;++d0)qr[d0]=*reinterpret_cast<const bf16x8*>(&Qw[(long)r32*QKP+d0*16+hi*8]);
  float mhat=0.f,l_reg=0.f;f32x16 o[2];o[0]=f32x16{};o[1]=f32x16{};f32x16 negm=f32x16{};asm volatile("":"+v"(negm));
  const int qrel=wid*QBLK+r32;
  #define CMASK(P0,P1,t) do{int jb_=(t)-(NT-4); if(jb_>=0)cmask(P0,P1,jb_,qrel,hi);}while(0)
  bool resc=false;
  #define START(P0,P1) do{ const float rm=rowmax(P0,P1); resc=false; \
    { const float dl=rm; mhat=fadd_s(mhat,dl); \
      _Pragma("unroll") for(int r=0;r<16;++r){P0[r]=fsub_s(P0[r],dl);P1[r]=fsub_s(P1[r],dl);} \
      _Pragma("unroll") for(int r=0;r<16;++r)negm[r]=-mhat; asm volatile("":"+v"(negm)); } \
    _Pragma("unroll") for(int r=0;r<16;++r)P0[r]=__builtin_amdgcn_exp2f(P0[r]); }while(0)
  #define RESC() do{ if(resc){ asm volatile("s_waitcnt lgkmcnt(0)":::"memory"); \
      _Pragma("unroll") for(int d_=0;d_<2;++d_) _Pragma("unroll") for(int r=0;r<16;++r)o[d_][r]*=wsf[crow(r,hi)]; } }while(0)
  f32x16 pA0,pA1,pB0,pB1;
  int sl_prev=0,sl_cur=0,sl_next=SLOTB;
  #define ROT() do{sl_prev=sl_cur;sl_cur=sl_next;sl_next=(sl_next==(NSLOT-1)*SLOTB)?0:sl_next+SLOTB;}while(0)
  DMA_K(2,2*SLOTB);
  WAIT_BAR(3);
  qkt(pA0,pA1,Kbase,qr,negm,r32,hi);asm volatile("s_nop 15\n\ts_nop 7":"+v"(pA0),"+v"(pA1));CMASK(pA0,pA1,0);
  START(pA0,pA1);
  _Pragma("unroll") for(int r=0;r<16;++r)pA1[r]=__builtin_amdgcn_exp2f(pA1[r]);
  WAIT_BAR(0);
  DMA_K(3,0);DMA_V(1,SLOTB);
  ROT();
  kload8(kf,kp0+sl_cur);
  WAIT_BAR(2);
  s16x4 vlo[8],vhi[8]; u32x4 pw0,pw1,pw2,pw3;
  #define PKW(P,B) cvtpk_s(P[B],P[B+1])
  #define PAF(k) __builtin_bit_cast(bf16x8,pw##k)
  #define VFR(i) __builtin_bit_cast(bf16x8,(s16x8){vlo[i][0],vlo[i][1],vlo[i][2],vlo[i][3],vhi[i][0],vhi[i][1],vhi[i][2],vhi[i][3]})
  #define PIN(x) asm volatile("":"+v"(x))
  #define MX3(a,b,c) __builtin_fmaxf(__builtin_fmaxf((a),(b)),(c))
  #define GAPA(MF,A0,A1,A2,A3,W0,W1,PW) do{ MF; sacc+=A0; sacc+=A1; sacc+=A2; sacc+=A3; PIN(sacc); W0; W1; PIN(PW); SBAR(); }while(0)
  #define EX(v) __builtin_amdgcn_exp2f(v)
  #define GAPB(MF,X,B) do{ MF; X[B]=EX(X[B]); X[B+1]=EX(X[B+1]); X[B+2]=EX(X[B+2]); X[B+3]=EX(X[B+3]); PIN(X); SBAR(); }while(0)
  #define VRD(i) do{ vlo[i]=vtr(vp_+(((i)>>2)*4096+((i)&3)*1024)); vhi[i]=vtr(vp_+(((i)>>2)*4096+((i)&3)*1024+512)); }while(0)
  #define KRD(G,j) do{ if(G){ kload2(kf,kp0+sl_next,j); SBAR(); } }while(0)
  #define STEP(C0,C1,P0,P1,t,GK,GV,GL) do{ SBAR(); \
    const lds_cptr vp_=vp0+sl_prev; \
    VRD(0); SBAR(); float sacc=(P0[0]+P0[1]); \
    GAPA(C0=__builtin_amdgcn_mfma_f32_32x32x16_f16(kf[0],qr[0],negm,0,0,0), P0[2],P0[3],P0[4],P0[5],     pw0[0]=PKW(P0,0), pw0[1]=PKW(P0,2), pw0); \
    VRD(4); SBAR(); GAPA(C1=__builtin_amdgcn_mfma_f32_32x32x16_f16(kf[1],qr[0],negm,0,0,0), P0[6],P0[7],P0[8],P0[9],     pw0[2]=PKW(P0,4), pw0[3]=PKW(P0,6), pw0); \
    VRD(1); SBAR(); GAPA(C0=__builtin_amdgcn_mfma_f32_32x32x16_f16(kf[2],qr[1],C0,0,0,0),   P0[10],P0[11],P0[12],P0[13], pw1[0]=PKW(P0,8), pw1[1]=PKW(P0,10), pw1); \
    VRD(5); SBAR(); GAPA(C1=__builtin_amdgcn_mfma_f32_32x32x16_f16(kf[3],qr[1],C1,0,0,0),   P0[14],P0[15],P1[0],P1[1],   pw1[2]=PKW(P0,12),pw1[3]=PKW(P0,14), pw1); \
    VRD(2); SBAR(); GAPA(C0=__builtin_amdgcn_mfma_f32_32x32x16_f16(kf[4],qr[2],C0,0,0,0),   P1[2],P1[3],P1[4],P1[5],     pw2[0]=PKW(P1,0), pw2[1]=PKW(P1,2), pw2); \
    VRD(6); SBAR(); GAPA(C1=__builtin_amdgcn_mfma_f32_32x32x16_f16(kf[5],qr[2],C1,0,0,0),   P1[6],P1[7],P1[8],P1[9],     pw2[2]=PKW(P1,4), pw2[3]=PKW(P1,6), pw2); \
    VRD(3); SBAR(); GAPA(C0=__builtin_amdgcn_mfma_f32_32x32x16_f16(kf[6],qr[3],C0,0,0,0),   P1[10],P1[11],P1[12],P1[13], pw3[0]=PKW(P1,8), pw3[1]=PKW(P1,10), pw3); \
    VRD(7); SBAR(); GAPA(C1=__builtin_amdgcn_mfma_f32_32x32x16_f16(kf[7],qr[3],C1,0,0,0),   P1[14],P1[15],0.f,0.f,       pw3[2]=PKW(P1,12),pw3[3]=PKW(P1,14), pw3); \
    l_reg+=sacc; \
    if(GK){DMA_K((t)+3,sl_cur);} if(GV){DMA_V((t)+1,sl_next);} \
    CMASK(C0,C1,t); \
    { float a=MX3(C0[0],C0[1],C1[0]),b=MX3(C0[2],C0[3],C1[1]); a=MX3(a,C1[2],C1[3]); \
      _Pragma("unroll") for(int r=4;r<16;r+=4){a=MX3(a,C0[r],C0[r+1]);b=MX3(b,C0[r+2],C0[r+3]);a=MX3(a,C1[r],C1[r+1]);b=MX3(b,C1[r+2],C1[r+3]);} \
      float rm=__builtin_fmaxf(a,b); { auto rr=__builtin_amdgcn_permlane32_swap(__float_as_uint(rm),__float_as_uint(rm),false,false); rm=__builtin_fmaxf(__uint_as_float(rr[0]),__uint_as_float(rr[1])); } \
      resc=false; \
      if(__builtin_expect(__any(rm>(float)THRL),0)){ const float dl=__builtin_fmaxf(rm,0.f); mhat+=dl; \
        _Pragma("unroll") for(int r=0;r<16;++r){C0[r]-=dl;C1[r]-=dl;} \
        _Pragma("unroll") for(int r=0;r<16;++r)negm[r]=-mhat; asm volatile("":"+v"(negm)); \
        const float f=__builtin_amdgcn_exp2f(-dl); l_reg*=f; if(hi==0)wsf[r32]=f; resc=true; } } \
    SBAR(); \
    GAPB(o[0]=__builtin_amdgcn_mfma_f32_32x32x16_f16(PAF(0),VFR(0),o[0],0,0,0), C0,0); \
    GAPB(o[1]=__builtin_amdgcn_mfma_f32_32x32x16_f16(PAF(0),VFR(4),o[1],0,0,0), C0,4); \
    KRD(GL,0); GAPB(o[0]=__builtin_amdgcn_mfma_f32_32x32x16_f16(PAF(1),VFR(1),o[0],0,0,0), C0,8); \
    KRD(GL,1); GAPB(o[1]=__builtin_amdgcn_mfma_f32_32x32x16_f16(PAF(1),VFR(5),o[1],0,0,0), C0,12); \
    KRD(GL,2); GAPB(o[0]=__builtin_amdgcn_mfma_f32_32x32x16_f16(PAF(2),VFR(2),o[0],0,0,0), C1,0); \
    KRD(GL,3); GAPB(o[1]=__builtin_amdgcn_mfma_f32_32x32x16_f16(PAF(2),VFR(6),o[1],0,0,0), C1,4); \
    GAPB(o[0]=__builtin_amdgcn_mfma_f32_32x32x16_f16(PAF(3),VFR(3),o[0],0,0,0), C1,8); \
    GAPB(o[1]=__builtin_amdgcn_mfma_f32_32x32x16_f16(PAF(3),VFR(7),o[1],0,0,0), C1,12); \
    }while(0)
  int t=1;
  #undef CMASK
  #define CMASK(P0,P1,t) do{}while(0)
  for(;t+5<NT;t+=2){
    STEP(pB0,pB1,pA0,pA1,t,true,true,true);     WAIT_BAR(2); RESC(); ROT();
    STEP(pA0,pA1,pB0,pB1,t+1,true,true,true);   WAIT_BAR(2); RESC(); ROT();
  }
  #undef CMASK
  #define CMASK(P0,P1,t) do{int jb_=(t)-(NT-4); if(jb_>=0)cmask(P0,P1,jb_,qrel,hi);}while(0)
  #define ENDW(tt) do{ if((tt)+3<NT){WAIT_BAR(2);} else if((tt)+2<NT){WAIT_BAR(1);} else {WAIT_BAR(0);} }while(0)
  for(;t+1<NT;t+=2){
    STEP(pB0,pB1,pA0,pA1,t,(t+3<NT),(t+1<NT),(t+1<NT));       ENDW(t);   RESC(); ROT();
    STEP(pA0,pA1,pB0,pB1,t+1,(t+4<NT),(t+2<NT),(t+2<NT));     ENDW(t+1); RESC(); ROT();
  }
  STEP(pB0,pB1,pA0,pA1,NT-1,false,false,false); RESC();
  { float sacc=pB0[0]+pB0[1]; _Pragma("unroll") for(int r=2;r<16;++r)sacc+=pB0[r]; _Pragma("unroll") for(int r=0;r<16;++r)sacc+=pB1[r]; l_reg+=sacc;
    pw0=(u32x4){PKW(pB0,0),PKW(pB0,2),PKW(pB0,4),PKW(pB0,6)};pw1=(u32x4){PKW(pB0,8),PKW(pB0,10),PKW(pB0,12),PKW(pB0,14)};pw2=(u32x4){PKW(pB1,0),PKW(pB1,2),PKW(pB1,4),PKW(pB1,6)};pw3=(u32x4){PKW(pB1,8),PKW(pB1,10),PKW(pB1,12),PKW(pB1,14)};
    SBAR(); pv(o,vb0+sl_cur,PAF(0),PAF(1),PAF(2),PAF(3)); }
  #undef PKW
  #undef PAF
  #undef VFR
  #undef PIN
  #undef MX3
  #undef GAPA
  #undef GAPB
  #undef EX
  #undef VRD
  #undef KRD
  #undef STEP
  #undef ENDW
  {auto rr=__builtin_amdgcn_permlane32_swap(__float_as_uint(l_reg),__float_as_uint(l_reg),false,false);l_reg=__uint_as_float(rr[0])+__uint_as_float(rr[1]);}
  if(hi==0)wsf[32+r32]=l_reg;asm volatile("s_waitcnt lgkmcnt(0)":::"memory");
  float rli[16];
  #pragma unroll
  for(int r=0;r<16;++r)rli[r]=__builtin_amdgcn_rcpf(wsf[32+crow(r,hi)]);
  bf16*Ow=O+(rowbase+q0+wid*QBLK)*OP+ocol;
  { bf16*stg=(bf16*)(shm+LDS_OST)+wid*2048;
    #pragma unroll
    for(int r=0;r<16;++r){const int orow=crow(r,hi);
      #pragma unroll
      for(int d0=0;d0<2;++d0)stg[orow*64+d0*32+r32]=(bf16)(o[d0][r]*rli[r]);}
    asm volatile("s_waitcnt lgkmcnt(0)":::"memory");
    #pragma unroll
    for(int i=0;i<4;++i){const int row=i*8+(lane>>3),ch=lane&7; const u32x4 v=*(const u32x4*)(stg+row*64+ch*8); ATTN_STORE16(Ow+(long)row*OP+ch*8,v);} }
  asm volatile("s_waitcnt lgkmcnt(0)\n\ts_barrier":::"memory");
  #undef DMA_K
  #undef DMA_V
  #undef CMASK
  #undef START
  #undef RESC
  #undef ROT
}
constexpr int ATTN_LDS_BYTES=LDS_BYTES;
struct AttnTensors { const bf16* Q; const bf16* K; const bf16* V; bf16* O; };
struct AttnUnit { int bh; int qb; };
struct StaticOrder {
  int vcu, G;
  __device__ __forceinline__ explicit StaticOrder(int grid,int block):vcu((grid%8==0)?(block%8)*(grid/8)+block/8:block),G(grid){}
  __device__ __forceinline__ bool next(int i,AttnUnit&u)const{ constexpr int NP=BATCH*64; const int ppc=(NP+G-1)/G; const int pj=i>>1; if(pj>=ppc)return false; const int pi=vcu*ppc+pj; if(pi>=NP)return false;
    const int s=pi&3; u.bh=pi>>2; u.qb=(i&1)?7-s:s; return true; }
  __device__ __forceinline__ void a_ready(const AttnUnit&)const{}
  __device__ __forceinline__ void done(const AttnUnit&)const{}
};
template<class Sched,int THRL=8> __device__ __forceinline__ void attn_phase(char*lds,const AttnTensors&T,const Sched&S,const int wave_s){
  AttnUnit u;
  for(int i=0;S.next(i,u);++i){ S.a_ready(u); attn_unit<THRL>(u.bh/NHEAD,u.bh%NHEAD,u.qb,T.Q,T.K,T.V,T.O,lds,wave_s); S.done(u); }
}
#undef SBAR
#undef WAIT_BAR
}
namespace mk {
constexpr size_t al256(size_t x) { return (x + 255) / 256 * 256; }
constexpr size_t MiB = (size_t)1 << 20;
constexpr size_t WS_CTL = 0, CTL_BYTES = 1u << 20;
constexpr int NIN = 3840;
constexpr size_t WS_WIN  = 1 * MiB;
constexpr size_t WS_WOUT = WS_WIN + (size_t)NIN * 2048;
constexpr size_t WS_WPLG = WS_WOUT + 2 * MiB;
constexpr size_t WS_WPL  = WS_WPLG + 2 * MiB;
constexpr size_t WS_WB   = WS_WPL + MiB / 2;
constexpr size_t WS_RW   = WS_WB + al256((size_t)1536 * 384 * 2);
constexpr size_t WS_SSQPE = WS_RW + (size_t)48 * 4096;
constexpr size_t WS_RSPE = WS_SSQPE + MiB;
constexpr size_t WS_ROPC = WS_RSPE + (size_t)16384 * 4;
constexpr size_t WS_ROPS = WS_ROPC + 2 * MiB;
constexpr size_t WS_BON  = WS_ROPS + 2 * MiB;
constexpr size_t WS_LIST = WS_BON + MiB / 2;
constexpr size_t WS_ASGW = WS_LIST + 2 * MiB;
constexpr size_t WS_SST  = WS_ASGW + MiB / 8;
static_assert(WS_SST + MiB <= 23 * MiB, "small region");
constexpr size_t WS_PE   = 23 * MiB;
constexpr size_t WS_HN   = 55 * MiB;
constexpr size_t WS_PH   = 87 * MiB;
constexpr size_t WS_Q    = 95 * MiB, WS_K = 111 * MiB, WS_V = 127 * MiB;
constexpr size_t WS_P    = 143 * MiB;
constexpr size_t WS_O    = 215 * MiB;
constexpr size_t WS_ZR   = 247 * MiB;
constexpr size_t WS_LA   = 55 * MiB;
constexpr size_t WS_WL   = 67 * MiB, WS_AL = 83 * MiB, WS_G = 99 * MiB;
constexpr size_t WS_RJ   = 115 * MiB;
constexpr size_t WS_VS   = 174 * MiB;
constexpr size_t WS_Y    = 190 * MiB;
constexpr size_t WS_MIX  = 55 * MiB;
constexpr size_t WS_X1   = 95 * MiB;
constexpr size_t WS_H2   = 159 * MiB;
constexpr size_t WS_WDN  = 191 * MiB;
constexpr size_t WS_WUP  = 223 * MiB;
constexpr size_t WS_HID  = 55 * MiB;
constexpr size_t WS_YE   = 223 * MiB;
constexpr size_t WS_X2H  = 55 * MiB;
constexpr size_t WS_X2   = 159 * MiB;
constexpr size_t WS_END1 = 295 * MiB - 65536;
static_assert(WS_ZR + (size_t)16384 * 1536 * 2 <= 295 * MiB && WS_WUP + 64 * MiB <= 287 * MiB && WS_X1 + 64 * MiB <= WS_H2 && WS_H2 + 32 * MiB <= WS_WDN && WS_WDN + 32 * MiB <= WS_WUP && WS_RJ + (size_t)8 * 8 * 64 * 15104 <= WS_VS && WS_HID + (size_t)(32768 + 8192) * 1024 <= WS_X1, "ws map");

constexpr int CW_BAR = 4096, CW_CNT = 8192;

constexpr int RING_BYTES = 131072, SCR_BYTES = 8 * 19456  , MISC_OFF = SCR_BYTES + 320, LDS_BYTES = 160 * 1024;

struct TJob { const float* src; f16* dst; const float* s1; const float* s2; int K, N, ldd, mode, nb, item0; long sstride, dstride; };
constexpr int MAXJOBS = 20;
struct Params {
    const float* in[38]; float* out; unsigned char* ws;
    TJob jobs[MAXJOBS]; int njobs, nitems, ph_lo, ph_hi, njobs0, nitems0, rep_ph, pad_;
};

#define XB_TMO      128
#define XB_XCNT(j)  (256  + 64 * (j))
#define XB_XSUB(j)  (1280 + 64 * (j))
#define XB_XGEN(j)  (2304 + 64 * (j))
#define XB_TOP      3328
#define XB_TOPGEN   3392
#define XCD_BAR_WORDS 3456
#define XB_SPIN_CAP (1u << 18)
__device__ __forceinline__ unsigned xb_ld(unsigned* p)              { return __hip_atomic_load(p, __ATOMIC_RELAXED, __HIP_MEMORY_SCOPE_AGENT); }
__device__ __forceinline__ unsigned xb_add(unsigned* p, unsigned v) { return __hip_atomic_fetch_add(p, v, __ATOMIC_RELAXED, __HIP_MEMORY_SCOPE_AGENT); }
__device__ __forceinline__ unsigned xb_xcc_id() { return (unsigned)__builtin_amdgcn_s_getreg((3 << 11) | 20) & 0xFu; }
#define XB_SPIN(cond, bar) do { unsigned _sp = 0; while (cond) { __builtin_amdgcn_s_sleep(1); \
    if ((++_sp & 255u) == 0u) { if (xb_ld(&(bar)[XB_TMO])) break; if (_sp > XB_SPIN_CAP) { atomicAdd(&(bar)[XB_TMO], 1u); break; } } } } while (0)
struct XcdBarrier { unsigned* bar; unsigned x; volatile LAS unsigned* st; };
__device__ __forceinline__ XcdBarrier xcd_barrier_post(unsigned* bar, volatile LAS unsigned* st) {
    XcdBarrier b; b.bar = bar; b.x = xb_xcc_id(); b.st = st;
    if (threadIdx.x == 0) (void)xb_add(&bar[XB_XCNT(b.x)], 1u);
    return b;
}
__device__ __forceinline__ void xcd_barrier_complete(unsigned* bar, unsigned x, unsigned& nloc, unsigned& nx) {
    const unsigned G = gridDim.x * gridDim.y * gridDim.z;
    unsigned sum, cnt, mine, sp = 0u;
    for (;;) {
        sum = 0u; cnt = 0u; mine = 0u;
#pragma unroll
        for (unsigned j = 0; j < 16; ++j) { const unsigned c = xb_ld(&bar[XB_XCNT(j)]); sum += c; cnt += (c > 0u) ? 1u : 0u; mine = (j == x) ? c : mine; }
        if (sum == G) break;
        __builtin_amdgcn_s_sleep(1);
        if ((++sp & 255u) == 0u) { if (xb_ld(&bar[XB_TMO])) break; if (sp > XB_SPIN_CAP) { atomicAdd(&bar[XB_TMO], 1u); break; } }
    }
    nloc = mine > 0u ? mine : 1u; nx = cnt > 0u ? cnt : 1u;
}
__device__ __forceinline__ void xcd_barrier(const XcdBarrier& b, int wave_s) {
    int ln_; asm volatile("v_mbcnt_lo_u32_b32 %0, -1, 0\n\tv_mbcnt_hi_u32_b32 %0, -1, %0" : "=v"(ln_));
    const bool leader = wave_s == 0 && ln_ == 0;
    asm volatile("s_waitcnt vmcnt(0)" ::: "memory");
    __syncthreads();
    if (leader) {
        unsigned* bar = b.bar;
        __builtin_amdgcn_s_waitcnt(0);
        unsigned nloc = b.st[0], nx = b.st[1];
        if (nloc == 0u) { xcd_barrier_complete(bar, b.x, nloc, nx); b.st[0] = nloc; b.st[1] = nx; }
        const unsigned old = xb_add(&bar[XB_XSUB(b.x)], 1u);
        const unsigned gen = old / nloc;
        if (old + 1u == (gen + 1u) * nloc) {
            __builtin_amdgcn_fence(__ATOMIC_RELEASE, "agent");
            asm volatile("s_waitcnt vmcnt(0)" ::: "memory");
            const unsigned og = xb_add(&bar[XB_TOP], 1u);
            const unsigned tg = og / nx;
            if (og + 1u == (tg + 1u) * nx) xb_add(&bar[XB_TOPGEN], 1u);
            else XB_SPIN(xb_ld(&bar[XB_TOPGEN]) == tg, bar);
            __builtin_amdgcn_fence(__ATOMIC_ACQUIRE, "agent");
            xb_add(&bar[XB_XGEN(b.x)], 1u);
            asm volatile("s_waitcnt vmcnt(0)" ::: "memory");
        } else {
            XB_SPIN(xb_ld(&bar[XB_XGEN(b.x)]) == gen, bar);
            __builtin_amdgcn_fence(__ATOMIC_ACQUIRE, "agent");
            asm volatile("s_waitcnt vmcnt(0)" ::: "memory");
        }
    }
    __syncthreads();
}

__device__ __forceinline__ float shx(float v, int mask, int lane) { return __builtin_bit_cast(float, __builtin_amdgcn_ds_bpermute((lane ^ mask) << 2, __builtin_bit_cast(int, v))); }
__device__ __forceinline__ float wave_sum(float v, int lane) {
#pragma unroll
    for (int o = 1; o < 64; o <<= 1) v += shx(v, o, lane);
    return v;
}

__device__ __forceinline__ float wave_sum_dpp(float x) {
    int v = __builtin_bit_cast(int, x);
#define DPP_ADD(ctrl, rmask) v = __builtin_bit_cast(int, __builtin_bit_cast(float, v) + __builtin_bit_cast(float, __builtin_amdgcn_update_dpp(0, v, ctrl, rmask, 0xf, true)))
    DPP_ADD(0x111, 0xf); DPP_ADD(0x112, 0xf); DPP_ADD(0x114, 0xf); DPP_ADD(0x118, 0xf); DPP_ADD(0x142, 0xa); DPP_ADD(0x143, 0xc);
#undef DPP_ADD
    return __builtin_bit_cast(float, __builtin_amdgcn_readlane(v, 63));
}
constexpr int TR_WAVE_LDS = 64 * 68 * 4;
__device__ __forceinline__ void p0_transpose_item(const TJob& J, int item, LAS float* scr, int lane) {
    const int kblks = (J.K + 63) / 64, nblk = (J.N + 63) / 64, per = kblks * nblk;
    const int bi = item / per, r = item % per, kb = r / nblk, nbk = r % nblk, k0 = 64 * kb, n0 = 64 * nbk;
    const float* W = J.src + (size_t)bi * J.sstride; f16* WT = J.dst + (size_t)bi * J.dstride;
    const int c4 = (lane & 15) * 4, kr = lane >> 4;
    f32x4 v[16];
#pragma unroll
    for (int i = 0; i < 16; ++i) { const int k = k0 + 4 * i + kr; v[i] = (f32x4){0.f, 0.f, 0.f, 0.f};
        if (k < J.K && n0 + c4 < J.N) v[i] = *(const f32x4*)(W + (size_t)k * J.N + n0 + c4); }
    if (J.s1) {
#pragma unroll
        for (int i = 0; i < 16; ++i) { const int k = k0 + 4 * i + kr; float s = 1.f;
            if (k < J.K) { s = J.s1[k]; if (J.mode == 1) s *= 1.f - J.s2[k]; else if (J.mode == 2) s *= J.s2[k]; }
            v[i] = v[i] * s; }
    }
#pragma unroll
    for (int i = 0; i < 16; ++i) { const int kk = 4 * i + kr; *(LAS f32x4*)(scr + kk * 68 + (c4 ^ (4 * ((kk >> 3) & 7)))) = v[i]; }
    asm volatile("s_waitcnt lgkmcnt(0)" ::: "memory");
    const int c = lane & 7, nn = lane >> 3;
    if (k0 + 8 * c < J.K) {
#pragma unroll
        for (int jn = 0; jn < 8; ++jn) { const int n = nn + 8 * jn; const LAS float* s = scr + (8 * c) * 68 + (n ^ (4 * c));
            if (n0 + n < J.N) {
                u32x4 o; o.x = pkh(s[0 * 68], s[1 * 68]); o.y = pkh(s[2 * 68], s[3 * 68]); o.z = pkh(s[4 * 68], s[5 * 68]); o.w = pkh(s[6 * 68], s[7 * 68]);
                *(u32x4*)(WT + (size_t)(n0 + n) * J.ldd + k0 + 8 * c) = o; } }
    }
    asm volatile("s_waitcnt lgkmcnt(0)" ::: "memory");
}

__device__ __forceinline__ void p0_prologue(const Params& p, unsigned char* ws, LAS unsigned char* lds, int bid, int wave, int lane) {
    LAS float* scr = (LAS float*)(lds + wave * TR_WAVE_LDS);
    const int G = gridDim.x, gw = bid * NWAVES + wave, NGW = G * NWAVES;
    for (int it = gw; it < p.nitems0; it += NGW) {
        int j = 0;
        while (j + 1 < p.njobs0 && it >= p.jobs[j + 1].item0) ++j;
        p0_transpose_item(p.jobs[j], it - p.jobs[j].item0, scr, lane);
    }
    const float* x = p.in[0]; f16* HN = (f16*)(ws + WS_HN);
    for (int m = gw; m < M; m += NGW) {
        const f32x4* xr = (const f32x4*)(x + (size_t)m * 1024) + lane;
        f32x4 v[4]; float s = 0.f;
#pragma unroll
        for (int j = 0; j < 4; ++j) { v[j] = xr[64 * j]; s += (v[j].x * v[j].x + v[j].y * v[j].y) + (v[j].z * v[j].z + v[j].w * v[j].w); }
        const float r = rsqrtf(wave_sum(s, lane) * (1.f / 1024.f) + 1e-6f);
        u32x2* o8 = (u32x2*)(HN + (size_t)m * 1024) + lane;
#pragma unroll
        for (int j = 0; j < 4; ++j) o8[64 * j] = (u32x2){pkh(v[j].x * r, v[j].y * r), pkh(v[j].z * r, v[j].w * r)};
    }
    const float* pp = p.in[1]; f16* PH = (f16*)(ws + WS_PH);
    const int gt = bid * NTHR + wave * 64 + lane, NGT = G * NTHR;
    for (int i = gt; i < M * 256 / 8; i += NGT) {
        const f32x4 a = *((const f32x4*)pp + 2 * (size_t)i), b = *((const f32x4*)pp + 2 * (size_t)i + 1);
        *((u32x4*)PH + i) = (u32x4){pkh(a.x, a.y), pkh(a.z, a.w), pkh(b.x, b.y), pkh(b.z, b.w)};
    }
    const int* pos = (const int*)p.in[2]; float* rc = (float*)(ws + WS_ROPC); float* rs = (float*)(ws + WS_ROPS);
    for (int i = gt; i < M * 32; i += NGT) {
        const int t = i >> 5, f = i & 31; const float inv = powf(10000.f, -(float)f / 32.f); const float ang = (float)pos[t] * inv;
        rc[i] = cosf(ang); rs[i] = sinf(ang);
    }
    float* RW = (float*)(ws + WS_RW); const float* gm = p.in[28]; const float* wg = p.in[29]; const float* we = p.in[30];
    for (int i = gt; i < 48 * 1024; i += NGT) {
        const int c = i >> 10, k = i & 1023;
        const float w = c < 4 ? wg[k * 4 + c] : (c < 36 ? we[(size_t)((c - 4) >> 3) * 8192 + k * 8 + ((c - 4) & 7)] : 0.f);
        RW[i] = w * gm[k];
    }
}

enum { EPI_QK = 0, EPI_ST16 = 1, EPI_PE = 2, EPI_X1 = 3, EPI_UP = 4, EPI_DOWN = 5, EPI_FINAL = 6 };
enum { PH_P0 = 0, PH_P1, PH_ATTN, PH_P2A, PH_P2B, PH_P2C0, PH_SCAN0, PH_P2C1, PH_SCAN1, PH_MIX, PH_OUT, PH_ROUTE, PH_UP, PH_DOWN, PH_COMB, PH_GATE, PH_END };
struct UniSched {
    const unsigned char* ws; int ph, G, c; const LAS int* tab;
    __device__ __forceinline__ bool next(int i, GU& u) const {
        unsigned char* w = const_cast<unsigned char*>(ws);
        u.aux = 0; u.glist = nullptr; u.elist = nullptr; u.gcnt = 0;
        if (ph == PH_P1) {
            constexpr int nM = M / BM, nN = NIN / BM, nwg = nM * nN, nPE = nM * 4;
            const int rounds = (nwg + G - 1) / G, rem = nwg % G;
            const long L = (long)i * G + c;
            if (L < nwg) {
                int wgid = (int)L; { const int q = nwg / NXCD, r = nwg % NXCD, xcd = wgid % NXCD, off = wgid / NXCD; wgid = (xcd < r ? xcd * (q + 1) : r * (q + 1) + (xcd - r) * q) + off; }
                const int nig = WGM * nN, gid = wgid / nig, fm = gid * WGM, gsz = (nM - fm) < WGM ? (nM - fm) : WGM;
                const int pm = fm + ((wgid % nig) % gsz), pn = (wgid % nig) / gsz;
                u.pm = pm; u.pn = pn; u.nt = 16; u.lda2 = 2048; u.ldb2 = 2048; u.hsa = 128 * 2048;
                u.a = (const char*)(ws + WS_HN) + (size_t)pm * 256 * 2048;
                u.b = (const char*)(ws + WS_WIN) + (size_t)pn * 256 * 2048;
                if (pn < 4) { u.bmode = 2; u.hsb = 32 * 2048; u.epi = EPI_QK; u.o = (char*)(w + (pn < 2 ? WS_Q : WS_K)); u.ldc = 512; u.oc0 = 256 * (pn & 1); u.aux = pn < 2; }
                else { u.bmode = 1; u.hsb = 128 * 2048; u.epi = EPI_ST16;
                    if (pn < 6) { u.o = (char*)(w + WS_V); u.ldc = 512; u.oc0 = 256 * (pn - 4); }
                    else if (pn < 12) { u.o = (char*)(w + WS_ZR); u.ldc = 1536; u.oc0 = 256 * (pn - 6); }
                    else { u.o = (char*)(w + WS_P); u.ldc = 768; u.oc0 = 256 * (pn - 12); } }
                return true;
            }
            int Lp;
            if (rem == 0) Lp = (int)(L - nwg);
            else { if (c < rem) return false; Lp = (i - (rounds - 1)) * (G - rem) + (c - rem); }
            if (Lp >= nPE) return false;
            const int pm = Lp >> 2, pn = Lp & 3;
            u.pm = pm; u.pn = pn; u.nt = 4; u.lda2 = 512; u.ldb2 = 512; u.hsa = 128 * 512; u.hsb = 128 * 512; u.bmode = 1; u.epi = EPI_PE;
            u.a = (const char*)(ws + WS_PH) + (size_t)pm * 256 * 512;
            u.b = (const char*)(ws + WS_WPL) + (size_t)pn * 256 * 512;
            u.o = (char*)(w + WS_PE); u.ldc = 1024; u.oc0 = 256 * pn;
            return true;
        }
        if (ph == PH_P2B) {
            constexpr int nM = M / BM, nwg = nM * 6;
            const int L = i * G + c; if (L >= nwg) return false;
            const int pm = L / 6, pn = L % 6;
            u.pm = pm; u.pn = pn; u.nt = 6; u.lda2 = 768; u.ldb2 = 768; u.hsa = 128 * 768; u.hsb = 128 * 768; u.bmode = 1; u.epi = EPI_ST16;
            u.a = (const char*)(ws + WS_LA) + (size_t)pm * 256 * 768; u.b = (const char*)(ws + WS_WB) + (size_t)pn * 256 * 768;
            u.o = (char*)(w + (pn < 2 ? WS_WL : pn < 4 ? WS_AL : WS_G)); u.ldc = 512; u.oc0 = 256 * (pn & 1);
            return true;
        }
        if (ph == PH_OUT || ph == PH_GATE) {
            constexpr int nM = M / BM, nN = 4, nwg = nM * nN;
            const long L = (long)i * G + c; if (L >= nwg) return false;
            int wgid = (int)L; { const int q = nwg / NXCD, r = nwg % NXCD, xcd = wgid % NXCD, off = wgid / NXCD; wgid = (xcd < r ? xcd * (q + 1) : r * (q + 1) + (xcd - r) * q) + off; }
            const int nig = WGM * nN, gid = wgid / nig, fm = gid * WGM, gsz = (nM - fm) < WGM ? (nM - fm) : WGM;
            const int pm = fm + ((wgid % nig) % gsz), pn = (wgid % nig) / gsz;
            u.pm = pm; u.pn = pn; u.nt = 16; u.lda2 = 2048; u.ldb2 = 2048; u.hsa = 128 * 2048; u.hsb = 128 * 2048; u.bmode = 0;
            u.a = (const char*)(ws + (ph == PH_OUT ? WS_MIX : WS_X2H)) + (size_t)pm * 256 * 2048;
            u.b = (const char*)(ws + (ph == PH_OUT ? WS_WOUT : WS_WPLG)) + (size_t)pn * 256 * 2048;
            u.epi = ph == PH_OUT ? EPI_X1 : EPI_FINAL; u.o = nullptr; u.ldc = 1024; u.oc0 = 256 * pn;
            return true;
        }
        if (ph == PH_UP || ph == PH_DOWN) {
            const int vc = (G % 8 == 0) ? (c % 8) * (G / 8) + c / 8 : c;
            const int L = i * G + vc, T = L >> 2, pn = L & 3;
            int ln_; asm volatile("v_mbcnt_lo_u32_b32 %0, -1, 0\n\tv_mbcnt_hi_u32_b32 %0, -1, %0" : "=v"(ln_));
            const int t0l = tab[ln_ & 31], cnl = tab[32 + (ln_ & 31)], NT = __builtin_amdgcn_readfirstlane(tab[64]);
            if (T >= NT) return false;
            const unsigned long long mk_ = __ballot(ln_ < 32 && T >= t0l);
            const int e = 63 - __builtin_clzll(mk_ | 1ull);
            const int t0 = __builtin_amdgcn_readlane(t0l, e), cn = __builtin_amdgcn_readlane(cnl, e);
            const int rt = T - t0;
            u.pm = T; u.pn = pn; u.aux = e; u.gcnt = cn - rt * 256;
            const int* lst = (const int*)(ws + WS_LIST) + (size_t)e * M + rt * 256;
            if (ph == PH_UP) {
                u.glist = lst; u.a = (const char*)(ws + WS_H2); u.lda2 = 2048; u.hsa = 0; u.nt = 16;
                u.b = (const char*)(ws + WS_WUP) + (size_t)e * 1024 * 2048 + (size_t)pn * 128 * 2048; u.ldb2 = 2048; u.hsb = 512 * 2048; u.bmode = 1;
                u.epi = EPI_UP; u.o = (char*)(w + WS_HID); u.ldc = 512; u.oc0 = 128 * pn;
            } else {
                u.elist = lst; u.a = (const char*)(ws + WS_HID) + (size_t)T * 256 * 1024; u.lda2 = 1024; u.hsa = 128 * 1024; u.nt = 8;
                u.b = (const char*)(ws + WS_WDN) + (size_t)e * 1024 * 1024 + (size_t)pn * 256 * 1024; u.ldb2 = 1024; u.hsb = 128 * 1024; u.bmode = 1;
                u.epi = EPI_DOWN; u.o = (char*)(w + WS_YE); u.ldc = 1024; u.oc0 = 256 * pn;
            }
            return true;
        }
        return false;
    }
};
struct UniEpi {
    unsigned char* ws; const Params& P;
    __device__ __forceinline__ const float* pin(int i) const { asm volatile("" : "+s"(i)); return P.in[i]; }
    __device__ __forceinline__ void operator()(const f32x4 (&acc)[2][2][4][2], const GU& u, int wr, int wc, int fr, int fq) const {
        const int row0 = u.pm * BM + wr * 64 + fr, ln = fq * 16 + fr;
        if (u.epi == EPI_ST16 || u.epi == EPI_PE) {
            f16* O = (f16*)u.o; const int ldc = u.ldc, col0 = u.oc0;
            float* ssq = (float*)(ws + WS_SSQPE);
#pragma unroll
            for (int ai = 0; ai < 2; ++ai)
#pragma unroll
                for (int m = 0; m < 4; ++m) {
                    const int row = row0 + ai * HALF + m * 16; f16* rp = O + (size_t)row * ldc + col0 + wc * 32 + 8 * fq; float s = 0.f;
#pragma unroll
                    for (int bj = 0; bj < 2; ++bj) { const f32x4 v0 = acc[ai][bj][m][0], v1 = acc[ai][bj][m][1];
                        s += (v0[0] * v0[0] + v0[1] * v0[1]) + (v0[2] * v0[2] + v0[3] * v0[3]) + (v1[0] * v1[0] + v1[1] * v1[1]) + (v1[2] * v1[2] + v1[3] * v1[3]);
                        *(u32x4*)(rp + bj * HALF) = (u32x4){pkh(v0[0], v0[1]), pkh(v0[2], v0[3]), pkh(v1[0], v1[1]), pkh(v1[2], v1[3])}; }
                    if (u.epi == EPI_PE) { s += shx(s, 16, ln); s += shx(s, 32, ln); if (fq == 0) ssq[(size_t)row * 16 + u.pn * 4 + wc] = s; }
                }
            return;
        }
        if (u.epi == EPI_X1 || u.epi == EPI_FINAL) {
            const float* xin = u.epi == EPI_X1 ? pin(0) : (const float*)(ws + WS_X2); const float* gpl = pin(35); float* outp = P.out;
            float* O = u.epi == EPI_X1 ? (float*)(ws + WS_X1) : outp;
            const f16* PE = (const f16*)(ws + WS_PE); const float* rspe = (const float*)(ws + WS_RSPE);
#pragma unroll
            for (int ai = 0; ai < 2; ++ai)
#pragma unroll
                for (int m = 0; m < 4; ++m) {
                    const int row = row0 + ai * HALF + m * 16; const size_t ro = (size_t)row * 1024 + u.oc0 + wc * 32 + 4 * fq;
                    float rpe = 0.f; if (u.epi == EPI_FINAL) rpe = rspe[row];
#pragma unroll
                    for (int bj = 0; bj < 2; ++bj)
#pragma unroll
                        for (int n = 0; n < 2; ++n) { const size_t o = ro + bj * HALF + n * 16; const f32x4 xr = *(const f32x4*)(xin + o); f32x4 v = acc[ai][bj][m][n];
                            if (u.epi == EPI_FINAL) { const h4 pe = *(const h4*)(PE + o); const f32x4 gp = *(const f32x4*)(gpl + (o - (size_t)row * 1024));
#pragma unroll
                                for (int j = 0; j < 4; ++j) v[j] = (float)pe[j] * rpe * gp[j] / (1.f + __expf(-v[j])); }
                            *(f32x4*)(O + o) = xr + v; }
                    if (m & 1) asm volatile("" ::: "memory");
                }
            return;
        }
        if (u.epi == EPI_UP) {
            f16* O = (f16*)u.o;
#pragma unroll
            for (int ai = 0; ai < 2; ++ai)
#pragma unroll
                for (int m = 0; m < 4; ++m) {
                    const int row = row0 + ai * HALF + m * 16; unsigned w4[4];
#pragma unroll
                    for (int n = 0; n < 2; ++n) { const f32x4 gt = acc[ai][0][m][n], up = acc[ai][1][m][n]; float h[4];
#pragma unroll
                        for (int j = 0; j < 4; ++j) h[j] = gt[j] / (1.f + __expf(-gt[j])) * up[j];
                        w4[2 * n] = pkh(h[0], h[1]); w4[2 * n + 1] = pkh(h[2], h[3]); }
                    *(u32x4*)(O + (size_t)row * 512 + u.oc0 + wc * 32 + 8 * fq) = (u32x4){w4[0], w4[1], w4[2], w4[3]};
                    asm volatile("" ::: "memory");
                }
            return;
        }
        if (u.epi == EPI_DOWN) {
            f16* O = (f16*)u.o; const float* aw = (const float*)(ws + WS_ASGW);
#pragma unroll
            for (int ai = 0; ai < 2; ++ai)
#pragma unroll
                for (int m = 0; m < 4; ++m) {
                    const int r = wr * 64 + fr + ai * HALF + m * 16;
                    if (r < u.gcnt) { const int slot = u.elist[r]; const float wgt = aw[slot]; f16* rp = O + (size_t)slot * 1024 + u.oc0 + wc * 32 + 8 * fq;
#pragma unroll
                        for (int bj = 0; bj < 2; ++bj) { const f32x4 v0 = acc[ai][bj][m][0] * wgt, v1 = acc[ai][bj][m][1] * wgt;
                            *(u32x4*)(rp + bj * HALF) = (u32x4){pkh(v0[0], v0[1]), pkh(v0[2], v0[3]), pkh(v1[0], v1[1]), pkh(v1[2], v1[3])}; } }
                    asm volatile("" ::: "memory");
                }
            return;
        }
        const bool isq = u.aux != 0; const float* g = isq ? pin(5) : pin(6); const float osc = isq ? C2 : 1.f;
        f16* O = (f16*)u.o; const int colb = u.oc0 + 64 * wc + 8 * fq;
        const float* rc = (const float*)(ws + WS_ROPC); const float* rs = (const float*)(ws + WS_ROPS);
        f32x4 gl[2][2];
#pragma unroll
        for (int bj = 0; bj < 2; ++bj)
#pragma unroll
            for (int n = 0; n < 2; ++n) gl[bj][n] = *(const f32x4*)(g + 32 * bj + 8 * fq + 4 * n);
#pragma unroll
        for (int ai = 0; ai < 2; ++ai)
#pragma unroll
            for (int m = 0; m < 4; ++m) {
                const int row = row0 + ai * HALF + m * 16; float s = 0.f;
#pragma unroll
                for (int bj = 0; bj < 2; ++bj)
#pragma unroll
                    for (int n = 0; n < 2; ++n) { const f32x4 v = acc[ai][bj][m][n]; s += (v[0] * v[0] + v[1] * v[1]) + (v[2] * v[2] + v[3] * v[3]); }
                s += shx(s, 16, ln); s += shx(s, 32, ln);
                const float ri = rsqrtf(s * (1.f / 64.f) + 1e-6f);
                unsigned lo[4], hi[4];
#pragma unroll
                for (int n = 0; n < 2; ++n) {
                    const f32x4 c = *(const f32x4*)(rc + (size_t)row * 32 + 8 * fq + 4 * n), sn = *(const f32x4*)(rs + (size_t)row * 32 + 8 * fq + 4 * n);
                    const f32x4 y0 = acc[ai][0][m][n] * gl[0][n] * ri, y1 = acc[ai][1][m][n] * gl[1][n] * ri;
                    const f32x4 l = (y0 * c - y1 * sn) * osc, h = (y1 * c + y0 * sn) * osc;
                    lo[2 * n] = pkh(l[0], l[1]); lo[2 * n + 1] = pkh(l[2], l[3]); hi[2 * n] = pkh(h[0], h[1]); hi[2 * n + 1] = pkh(h[2], h[3]);
                }
                f16* rp = O + (size_t)row * 512 + colb;
                *(u32x4*)rp = (u32x4){lo[0], lo[1], lo[2], lo[3]};
                *(u32x4*)(rp + 32) = (u32x4){hi[0], hi[1], hi[2], hi[3]};
            }
    }
};

__device__ __forceinline__ void p4_mix(unsigned char* ws, const float* lq1, const float* lk1, const float* lq2, const float* lk2, const float* ogp, int bid, int wave, int lane) {
    const int gw = bid * NWAVES + wave, NGW = gridDim.x * NWAVES;
    const float d1 = wave_sum(lq1[lane] * lk1[lane], lane), d2 = wave_sum(lq2[lane] * lk2[lane], lane);
    const float lam = expf(d1) - expf(d2) + 0.2f;
    const f16* O = (const f16*)(ws + WS_O); f16* MIX = (f16*)(ws + WS_MIX);
    const float* og = ogp + (lane & 15) * 8; float g[8];
#pragma unroll
    for (int j = 0; j < 8; ++j) g[j] = og[j] * 0.8f;
    for (int m = gw; m < M; m += NGW) {
        const h8 a = *(const h8*)(O + (size_t)m * 1024 + lane * 8), b = *(const h8*)(O + (size_t)m * 1024 + 512 + lane * 8);
        float o[8]; float s = 0.f;
#pragma unroll
        for (int j = 0; j < 8; ++j) { o[j] = (float)a[j] - lam * (float)b[j]; s += o[j] * o[j]; }
        s += shx(s, 1, lane); s += shx(s, 2, lane); s += shx(s, 4, lane); s += shx(s, 8, lane);
        const float r = rsqrtf(s * (1.f / 128.f) + 1e-5f);
        *(u32x4*)(MIX + (size_t)m * 1024 + lane * 8) = (u32x4){pkh(o[0] * r * g[0], o[1] * r * g[1]), pkh(o[2] * r * g[2], o[3] * r * g[3]), pkh(o[4] * r * g[4], o[5] * r * g[5]), pkh(o[6] * r * g[6], o[7] * r * g[7])};
    }
}
__device__ __forceinline__ void p4_mix_rwkv(unsigned char* ws, const float* mu_rkv, const float* gn_w, const float* gn_b, int bid, int wave, int lane) {
    const int gw = bid * NWAVES + wave, NGW = gridDim.x * NWAVES;
    const f16* Y = (const f16*)(ws + WS_Y); const float* BON = (const float*)(ws + WS_BON);
    const f16* VS = (const f16*)(ws + WS_VS); const f16* Gg = (const f16*)(ws + WS_G); f16* MIX = (f16*)(ws + WS_MIX);
    (void)mu_rkv;
    const f32x4 w0 = *(const f32x4*)(gn_w + lane * 8), w1 = *(const f32x4*)(gn_w + lane * 8 + 4), b0 = *(const f32x4*)(gn_b + lane * 8), b1 = *(const f32x4*)(gn_b + lane * 8 + 4);
    for (int m = gw; m < M; m += NGW) {
        const h8 yh = *(const h8*)(Y + (size_t)m * 512 + lane * 8), vh = *(const h8*)(VS + (size_t)m * 512 + lane * 8), gh = *(const h8*)(Gg + (size_t)m * 512 + lane * 8);
        const float bon = BON[(size_t)m * 8 + (lane >> 3)];
        float y[8]; float s = 0.f;
#pragma unroll
        for (int j = 0; j < 8; ++j) { y[j] = (float)yh[j]; s += y[j]; }
        s += shx(s, 1, lane); s += shx(s, 2, lane); s += shx(s, 4, lane);
        const float mu = s * (1.f / 64.f); float q = 0.f;
#pragma unroll
        for (int j = 0; j < 8; ++j) { y[j] -= mu; q += y[j] * y[j]; }
        q += shx(q, 1, lane); q += shx(q, 2, lane); q += shx(q, 4, lane);
        const float rs = rsqrtf(q * (1.f / 64.f) + 64e-5f);
        float o[8];
#pragma unroll
        for (int j = 0; j < 8; ++j) { const float gw_ = j < 4 ? w0[j] : w1[j - 4], gb_ = j < 4 ? b0[j] : b1[j - 4]; o[j] = (y[j] * rs * gw_ + gb_ + bon * (float)vh[j]) * (float)gh[j]; }
        *(u32x4*)(MIX + (size_t)m * 1024 + 512 + lane * 8) = (u32x4){pkh(o[0], o[1]), pkh(o[2], o[3]), pkh(o[4], o[5]), pkh(o[6], o[7])};
    }
}
__device__ __forceinline__ void p6_expert_weights(const Params& p, LAS unsigned char* lds, int bid, int wave, int lane) {
    LAS float* scr = (LAS float*)(lds + wave * TR_WAVE_LDS);
    const int gw = bid * NWAVES + wave, NGW = gridDim.x * NWAVES;
    for (int it = p.nitems0 + gw; it < p.nitems; it += NGW) {
        int j = p.njobs0;
        while (j + 1 < p.njobs && it >= p.jobs[j + 1].item0) ++j;
        p0_transpose_item(p.jobs[j], it - p.jobs[j].item0, scr, lane);
    }
}
__device__ __forceinline__ void build_expert_tab(const unsigned char* ws, LAS int* tab, int wave, int lane) {
    if (wave == 0) {
        const int* cnt = (const int*)(ws + WS_CTL) + CW_CNT;
        const int c = lane < 32 ? cnt[lane] : 0, nte = (c + 255) >> 8;
        int v = nte;
#define DPP_IADD(ctrl, rmask) v += __builtin_amdgcn_update_dpp(0, v, ctrl, rmask, 0xf, true)
        DPP_IADD(0x111, 0xf); DPP_IADD(0x112, 0xf); DPP_IADD(0x114, 0xf); DPP_IADD(0x118, 0xf); DPP_IADD(0x142, 0xa); DPP_IADD(0x143, 0xc);
#undef DPP_IADD
        if (lane < 32) { tab[lane] = v - nte; tab[32 + lane] = c; }
        if (lane == 31) tab[64] = v;
    }
    __syncthreads();
}
__device__ __forceinline__ void p6_router(unsigned char* ws, LAS unsigned char* lds, int bid, int wave, int lane) {
    const float* X1 = (const float*)(ws + WS_X1); const float* RW = (const float*)(ws + WS_RW); f16* H2 = (f16*)(ws + WS_H2);
    int* cnt = (int*)(ws + WS_CTL) + CW_CNT; int* LIST = (int*)(ws + WS_LIST); float* ASGW = (float*)(ws + WS_ASGW);
    LAS float* part = (LAS float*)lds;
    LAS float* pss = (LAS float*)(lds + 24576);
    LAS float* lg = (LAS float*)(lds + 25088);
    const int r = lane & 15, kq = lane >> 4, kb = wave * 128, tid = wave * 64 + lane;
    for (int tile = bid; tile < M / 16; tile += gridDim.x) {
        const int row0 = tile * 16;
        const float* xr = X1 + (size_t)(row0 + r) * 1024 + kb + 4 * kq;
        f32x4 xa[8], wb[3][8];
#pragma unroll
        for (int i = 0; i < 8; ++i) { xa[i] = *(const f32x4*)(xr + 16 * i);
#pragma unroll
            for (int t = 0; t < 3; ++t) wb[t][i] = *(const f32x4*)(RW + (size_t)(16 * t + r) * 1024 + kb + 16 * i + 4 * kq); }
        f32x4 acc[3] = {{0.f, 0.f, 0.f, 0.f}, {0.f, 0.f, 0.f, 0.f}, {0.f, 0.f, 0.f, 0.f}}; float ssq = 0.f;
#pragma unroll
        for (int i = 0; i < 8; ++i) {
            ssq += (xa[i][0] * xa[i][0] + xa[i][1] * xa[i][1]) + (xa[i][2] * xa[i][2] + xa[i][3] * xa[i][3]);
#pragma unroll
            for (int t = 0; t < 3; ++t)
#pragma unroll
                for (int e = 0; e < 4; ++e) acc[t] = __builtin_amdgcn_mfma_f32_16x16x4f32(xa[i][e], wb[t][i][e], acc[t], 0, 0, 0);
        }
        ssq += shx(ssq, 16, lane); ssq += shx(ssq, 32, lane);
        if (kq == 0) pss[wave * 16 + r] = ssq;
#pragma unroll
        for (int t = 0; t < 3; ++t)
#pragma unroll
            for (int q = 0; q < 4; ++q) part[(wave * 16 + 4 * kq + q) * 48 + 16 * t + r] = acc[t][q];
        __syncthreads();
        for (int i = tid; i < 768; i += NTHR) { float s = 0.f;
#pragma unroll
            for (int w = 0; w < 8; ++w) s += part[w * 768 + i];
            lg[i] = s; }
        if (tid < 16) { float s = 0.f;
#pragma unroll
            for (int w = 0; w < 8; ++w) s += pss[w * 16 + tid];
            lg[768 + tid] = rsqrtf(s * (1.f / 1024.f) + 1e-6f); }
        __syncthreads();
#pragma unroll
        for (int rr = 0; rr < 2; ++rr) { const int row = row0 + 2 * wave + rr; const float rstd = lg[768 + 2 * wave + rr];
#pragma unroll
            for (int j = 0; j < 4; ++j) { const f32x4 v = *(const f32x4*)(X1 + (size_t)row * 1024 + j * 256 + lane * 4);
                *(u32x2*)(H2 + (size_t)row * 1024 + j * 256 + lane * 4) = (u32x2){pkh(v[0] * rstd, v[1] * rstd), pkh(v[2] * rstd, v[3] * rstd)}; } }
        if (tid < 16) {
            const int t = row0 + tid; const float rs = lg[768 + tid]; const LAS float* l = lg + tid * 48;
            int gs = 0; float gm = l[0] * rs;
#pragma unroll
            for (int i = 1; i < 4; ++i) { const float v = l[i] * rs; if (v > gm) { gm = v; gs = i; } }
            float den = 0.f;
#pragma unroll
            for (int i = 0; i < 4; ++i) den += expf(l[i] * rs - gm);
            const float gwt = 1.f / den;
            float ev[8];
#pragma unroll
            for (int i = 0; i < 8; ++i) { float v = 0.f;
#pragma unroll
                for (int gq = 0; gq < 4; ++gq) if (gq == gs) v = l[4 + 8 * gq + i];
                ev[i] = v * rs; }
            int i0 = 0; float v0 = ev[0];
#pragma unroll
            for (int i = 1; i < 8; ++i) if (ev[i] > v0) { v0 = ev[i]; i0 = i; }
            int i1 = 0; float v1 = -INFINITY;
#pragma unroll
            for (int i = 0; i < 8; ++i) if (i != i0 && ev[i] > v1) { v1 = ev[i]; i1 = i; }
            const float p1 = expf(v1 - v0), w0 = gwt / (1.f + p1), w1 = gwt * p1 / (1.f + p1);
            const int e0 = gs * 8 + i0, e1 = gs * 8 + i1;
            ASGW[2 * t] = w0; ASGW[2 * t + 1] = w1;
            int pos = atomicAdd(cnt + e0, 1); LIST[(size_t)e0 * M + pos] = 2 * t;
            pos = atomicAdd(cnt + e1, 1); LIST[(size_t)e1 * M + pos] = 2 * t + 1;
        }
        __syncthreads();
    }
}
__device__ __forceinline__ void p9_combine(unsigned char* ws, int bid, int wave, int lane) {
    const float* X1 = (const float*)(ws + WS_X1); float* X2 = (float*)(ws + WS_X2); const f16* YE = (const f16*)(ws + WS_YE); f16* X2H = (f16*)(ws + WS_X2H);
    const float* ssqp = (const float*)(ws + WS_SSQPE); float* rspe = (float*)(ws + WS_RSPE);
    const int gw = bid * NWAVES + wave, NGW = gridDim.x * NWAVES;
    for (int m = gw; m < M; m += NGW) {
        { const float sp = wave_sum_dpp(lane < 16 ? ssqp[(size_t)m * 16 + lane] : 0.f); if (lane == 0) rspe[m] = rsqrtf(sp * (1.f / 1024.f) + 1e-6f); }
        f32x4 v[4]; float s = 0.f;
#pragma unroll
        for (int j = 0; j < 4; ++j) {
            const size_t c = (size_t)lane * 4 + 256 * j;
            v[j] = *(const f32x4*)(X1 + (size_t)m * 1024 + c);
            const h4 a = *(const h4*)(YE + (size_t)(2 * m) * 1024 + c), b = *(const h4*)(YE + (size_t)(2 * m + 1) * 1024 + c);
#pragma unroll
            for (int q = 0; q < 4; ++q) { v[j][q] += (float)a[q] + (float)b[q]; s += v[j][q] * v[j][q]; }
        }
        const float r = rsqrtf(wave_sum_dpp(s) * (1.f / 1024.f) + 1e-6f);
#pragma unroll
        for (int j = 0; j < 4; ++j) {
            const size_t c = (size_t)lane * 4 + 256 * j;
            *(f32x4*)(X2 + (size_t)m * 1024 + c) = v[j];
            *(u32x2*)(X2H + (size_t)m * 1024 + c) = (u32x2){pkh(v[j][0] * r, v[j][1] * r), pkh(v[j][2] * r, v[j][3] * r)};
        }
    }
}
}
namespace mk {
constexpr int CH = 16, NCH = SEQ / CH;
constexpr int NCHH = NCH / 2, NJOBH = NB * 8 * NCHH;
constexpr int P2C_WAVE_LDS = 19456;
constexpr int RJ_PHI = 0, RJ_RH = 8192, RJ_PSI = 10240, RJ_C2 = 12288, RJ_VB = 12800, RJ_DG = 14848, RJ_BYTES = 15104;

struct RwkvW { const float *mu_rkv, *w0, *a0, *k_k, *k_a, *r_k, *gn_w, *gn_b; };

struct TokVals { float r, k2, v, a, b, lw; };
__device__ __forceinline__ TokVals rwkv_tok(const f16* ZR, const f16* WL, const f16* AL, const RwkvW& W, size_t row, bool hasprev, int c, int lane) {
    const f16* z = ZR + row * 1536; const f16* zp = z - 1536;
    const float zr = (float)z[c], zk = (float)z[512 + c], zv = (float)z[1024 + c];
    const float pr = hasprev ? (float)zp[c] : 0.f, pk = hasprev ? (float)zp[512 + c] : 0.f, pv = hasprev ? (float)zp[1024 + c] : 0.f;
    TokVals o;
    o.r = zr + (pr - zr) * W.mu_rkv[c]; const float k = zk + (pk - zk) * W.mu_rkv[512 + c]; o.v = zv + (pv - zv) * W.mu_rkv[1024 + c];
    o.lw = 0.f;
    const float ag = __builtin_amdgcn_rcpf(1.f + __expf(-(W.a0[c] + (float)AL[row * 512 + c])));
    float kk = k * W.k_k[c];
    const float ss = wave_sum_dpp(kk * kk);
    kk *= rsqrtf(fmaxf(ss, 1e-24f));
    o.k2 = k * (1.f + (ag - 1.f) * W.k_a[c]); o.a = -kk; o.b = kk * ag;
    return o;
}

__device__ __forceinline__ void p2a_la(unsigned char* ws, int bid, int tid) {
    const f16* P = (const f16*)(ws + WS_P); f16* LA = (f16*)(ws + WS_LA);
    const int gt = bid * NTHR + tid, NGT = gridDim.x * NTHR;
    for (int i = gt; i < M * 48; i += NGT) {
        const int t = i / 48, c8 = (i % 48) * 8; u32x4 o = (u32x4){0u, 0u, 0u, 0u};
        if (c8 < 288) {
            const h8 a = *(const h8*)(P + (size_t)t * 768 + c8); h8 b = (h8){0, 0, 0, 0, 0, 0, 0, 0};
            if (t % SEQ) b = *(const h8*)(P + (size_t)(t - 1) * 768 + 288 + c8);
            float v[8];
#pragma unroll
            for (int j = 0; j < 8; ++j) { float x = (float)a[j] + (float)b[j]; v[j] = c8 < 64 ? tanhf(x) : (c8 < 128 ? x : 1.f / (1.f + expf(-x))); }
            o = (u32x4){pkh(v[0], v[1]), pkh(v[2], v[3]), pkh(v[4], v[5]), pkh(v[6], v[7])};
        }
        *(u32x4*)(LA + (size_t)t * 384 + c8) = o;
    }
}

__device__ __forceinline__ h8 lds_h8(LAS const unsigned char* p) { return *(LAS const h8*)p; }
__device__ __forceinline__ void p2c_chunks(unsigned char* ws, const RwkvW& W, LAS unsigned char* lds, int half, int bid, int wave, int lane) {
    LAS unsigned char* L = lds + wave * P2C_WAVE_LDS;
    const f16* ZR = (const f16*)(ws + WS_ZR); const f16* WL = (const f16*)(ws + WS_WL); const f16* AL = (const f16*)(ws + WS_AL); f16* VS = (f16*)(ws + WS_VS);
    unsigned char* RJ = ws + WS_RJ; float* BON = (float*)(ws + WS_BON);
    const int gw = bid * NWAVES + wave, NGW = gridDim.x * NWAVES;
    const int r16 = lane & 15, g = lane >> 4;
    const h8 zero8 = (h8){0, 0, 0, 0, 0, 0, 0, 0};
    for (int job = gw; job < NJOBH; job += NGW) {
        const int bh = job / NCHH, ch = half * NCHH + job % NCHH, b = bh >> 3, hd = bh & 7, c = hd * 64 + lane;
        const size_t row0 = (size_t)b * SEQ + ch * CH;
        unsigned char* rj0 = RJ + (size_t)job * RJ_BYTES;
        {
            float lwv[16]; float GL = 0.f;
#pragma unroll
            for (int i = 0; i < 16; ++i) {
                const float wl = W.w0[c] + (float)WL[(row0 + i) * 512 + c];
                const float nx = -wl; const float sp = nx > 20.f ? nx : __logf(1.f + __expf(nx));
                lwv[i] = -__expf(-sp - 0.5f); GL += lwv[i];
            }
            float G = 0.f, eprev = 1.f; float vq[4];
#pragma unroll
            for (int i = 0; i < 16; ++i) {
                const TokVals tv = rwkv_tok(ZR, WL, AL, W, row0 + i, (ch * CH + i) != 0, c, lane);
                G += lwv[i]; const float ei = __expf(G), einv = __builtin_amdgcn_rcpf(ei), f = __expf(GL - G);
                *(LAS f16*)(L + 0 + i * 144 + lane * 2) = (f16)(tv.a * eprev); *(LAS f16*)(L + 2304 + i * 144 + lane * 2) = (f16)(tv.b * einv);
                *(LAS f16*)(L + 4608 + i * 144 + lane * 2) = (f16)(tv.k2 * einv); *(LAS f16*)(L + 6912 + i * 144 + lane * 2) = (f16)(tv.r * ei);
                *(LAS f16*)(L + 13888 + lane * 80 + i * 2) = (f16)(tv.b * f); *(LAS f16*)(L + 13888 + lane * 80 + 32 + i * 2) = (f16)(tv.k2 * f);
                eprev = ei; vq[i & 3] = tv.v; VS[(row0 + i) * 512 + c] = (f16)tv.v;
                if ((i & 3) == 3) *(u32x2*)(rj0 + RJ_VB + ((lane >> 4) * 64 + (lane & 15) + 16 * (i >> 2)) * 8) = (u32x2){pkh(vq[0], vq[1]), pkh(vq[2], vq[3])};
                const float bon = wave_sum_dpp(tv.r * tv.k2 * W.r_k[c]);
                if (lane == 0) BON[(row0 + i) * 8 + hd] = bon;
            }
            *(float*)(rj0 + RJ_DG + lane * 4) = __expf(GL);
        }
        asm volatile("s_waitcnt lgkmcnt(0)" ::: "memory");
        f32x4 n1 = {0.f, 0.f, 0.f, 0.f}, n2 = n1, n3 = n1, n4 = n1;
#pragma unroll
        for (int s = 0; s < 2; ++s) {
            const int off = r16 * 144 + (8 * g + 32 * s) * 2;
            const h8 xa = lds_h8(L + 0 + off), xb = lds_h8(L + 2304 + off), xk = lds_h8(L + 4608 + off), xr = lds_h8(L + 6912 + off);
            n1 = __builtin_amdgcn_mfma_f32_16x16x32_f16(xa, xb, n1, 0, 0, 0);
            n2 = __builtin_amdgcn_mfma_f32_16x16x32_f16(xa, xk, n2, 0, 0, 0);
            n3 = __builtin_amdgcn_mfma_f32_16x16x32_f16(xb, xr, n3, 0, 0, 0);
            n4 = __builtin_amdgcn_mfma_f32_16x16x32_f16(xk, xr, n4, 0, 0, 0);
        }
#pragma unroll
        for (int q = 0; q < 4; ++q) { const int rr = 4 * g + q;
            if (!(r16 < rr)) { n1[q] = 0.f; n2[q] = 0.f; }
            if (!(rr <= r16)) { n3[q] = 0.f; n4[q] = 0.f; } }
#pragma unroll
        for (int q = 0; q < 4; ++q) { *(LAS float*)(L + 10240 + ((4 * g + q) * 16 + r16) * 4) = n1[q]; *(LAS float*)(L + 11264 + (r16 * 17 + 4 * g + q) * 4) = n2[q]; }
        *(LAS u32x2*)(L + 13120 + r16 * 48 + g * 8) = (u32x2){pkh(n3[0], n3[1]), pkh(n3[2], n3[3])};
        asm volatile("s_waitcnt lgkmcnt(0)" ::: "memory");
        float X[16], X1[16], rt[16];
#pragma unroll
        for (int i = 0; i < 16; ++i) rt[i] = (float)*(LAS const f16*)(L + 6912 + i * 144 + lane * 2);
#pragma unroll
        for (int i = 0; i < 16; ++i) {
            float x = (float)*(LAS const f16*)(L + 0 + i * 144 + lane * 2), x1 = *(LAS const float*)(L + 11264 + (r16 * 17 + i) * 4);
#pragma unroll
            for (int m4 = 0; m4 < (i + 3) / 4; ++m4) {
                const f32x4 cf = *(LAS const f32x4*)(L + 10240 + (i * 16 + m4 * 4) * 4);
#pragma unroll
                for (int q = 0; q < 4; ++q) if (m4 * 4 + q < i) { x = fmaf(X[m4 * 4 + q], cf[q], x); x1 = fmaf(X1[m4 * 4 + q], cf[q], x1); }
            }
            X[i] = x; X1[i] = x1;
        }
#pragma unroll
        for (int q = 0; q < 4; ++q) {
            *(LAS u32x2*)(L + 0 + lane * 80 + q * 8) = (u32x2){pkh(X[4 * q], X[4 * q + 1]), pkh(X[4 * q + 2], X[4 * q + 3])};
            *(LAS u32x2*)(L + 0 + lane * 80 + 32 + q * 8) = (u32x2){pkh(rt[4 * q], rt[4 * q + 1]), pkh(rt[4 * q + 2], rt[4 * q + 3])};
            if (lane < 16) *(LAS u32x2*)(L + 12352 + lane * 48 + q * 8) = (u32x2){pkh(X1[4 * q], X1[4 * q + 1]), pkh(X1[4 * q + 2], X1[4 * q + 3])};
        }
        asm volatile("s_waitcnt lgkmcnt(0)" ::: "memory");
        h8 Af[4], Ap[4], Bf[4];
#pragma unroll
        for (int t = 0; t < 4; ++t) { Af[t] = lds_h8(L + 0 + (16 * t + r16) * 80 + g * 16); Ap[t] = g < 2 ? Af[t] : zero8; Bf[t] = lds_h8(L + 13888 + (16 * t + r16) * 80 + g * 16); }
        h8 idn = zero8;
#pragma unroll
        for (int e8 = 0; e8 < 8; ++e8) if (g >= 2 && 8 * (g - 2) + e8 == r16) idn[e8] = (f16)1.f;
        const h8 c1raw = g < 2 ? lds_h8(L + 12352 + r16 * 48 + g * 16) : zero8;
        const h8 c1id = g < 2 ? c1raw : idn;
        const h8 nbraw = g < 2 ? lds_h8(L + 13120 + r16 * 48 + g * 16) : zero8;
        const h8 nbid = g < 2 ? nbraw : idn;
        unsigned char* rj = rj0;
        const f32x4 z4 = {0.f, 0.f, 0.f, 0.f};
#pragma unroll
        for (int t = 0; t < 4; ++t) {
            f32x4 d[4];
#pragma unroll
            for (int tp = 0; tp < 4; ++tp) d[tp] = __builtin_amdgcn_mfma_f32_16x16x32_f16(Ap[tp], Bf[t], z4, 0, 0, 0);
#pragma unroll
            for (int s = 0; s < 2; ++s)
                *(u32x4*)(rj + RJ_PHI + ((t * 2 + s) * 64 + lane) * 16) = (u32x4){pkh(d[2 * s][0], d[2 * s][1]), pkh(d[2 * s][2], d[2 * s][3]), pkh(d[2 * s + 1][0], d[2 * s + 1][1]), pkh(d[2 * s + 1][2], d[2 * s + 1][3])};
            const f32x4 ps = __builtin_amdgcn_mfma_f32_16x16x32_f16(c1id, Bf[t], z4, 0, 0, 0);
            *(u32x2*)(rj + RJ_PSI + (t * 64 + lane) * 8) = (u32x2){pkh(ps[0], ps[1]), pkh(ps[2], ps[3])};
        }
        {
            f32x4 d[4];
#pragma unroll
            for (int tp = 0; tp < 4; ++tp) d[tp] = __builtin_amdgcn_mfma_f32_16x16x32_f16(Af[tp], nbid, z4, 0, 0, 0);
#pragma unroll
            for (int s = 0; s < 2; ++s)
                *(u32x4*)(rj + RJ_RH + (s * 64 + lane) * 16) = (u32x4){pkh(d[2 * s][0], d[2 * s][1]), pkh(d[2 * s][2], d[2 * s][3]), pkh(d[2 * s + 1][0], d[2 * s + 1][1]), pkh(d[2 * s + 1][2], d[2 * s + 1][3])};
            const f32x4 c2 = __builtin_amdgcn_mfma_f32_16x16x32_f16(c1raw, nbraw, n4, 0, 0, 0);
            *(u32x2*)(rj + RJ_C2 + lane * 8) = (u32x2){pkh(c2[0], c2[1]), pkh(c2[2], c2[3])};
        }
        asm volatile("s_waitcnt lgkmcnt(0)" ::: "memory");
    }
}

struct ScanOps { u32x4 phi[8]; u32x4 rh[2]; u32x2 psi[4]; u32x2 c2, vb; f32x4 dg[4]; };
__device__ __forceinline__ void scan_load(ScanOps& o, const unsigned char* rj, int vt, int lane, int g) {
#pragma unroll
    for (int i = 0; i < 8; ++i) o.phi[i] = *(const u32x4*)(rj + RJ_PHI + (i * 64 + lane) * 16);
#pragma unroll
    for (int s = 0; s < 2; ++s) o.rh[s] = *(const u32x4*)(rj + RJ_RH + (s * 64 + lane) * 16);
#pragma unroll
    for (int t = 0; t < 4; ++t) { o.psi[t] = *(const u32x2*)(rj + RJ_PSI + (t * 64 + lane) * 8); o.dg[t] = *(const f32x4*)(rj + RJ_DG + (16 * t + 4 * g) * 4); }
    o.c2 = *(const u32x2*)(rj + RJ_C2 + lane * 8); o.vb = *(const u32x2*)(rj + RJ_VB + (vt * 64 + lane) * 8);
}
__device__ __forceinline__ void scan_step(f32x4 (&S)[4], const ScanOps& o, f16* yp) {
    h8 SB[2];
#pragma unroll
    for (int s = 0; s < 2; ++s) { const u32x4 w = (u32x4){pkh(S[2 * s][0], S[2 * s][1]), pkh(S[2 * s][2], S[2 * s][3]), pkh(S[2 * s + 1][0], S[2 * s + 1][1]), pkh(S[2 * s + 1][2], S[2 * s + 1][3])}; SB[s] = __builtin_bit_cast(h8, w); }
    const h8 VBo = __builtin_bit_cast(h8, (u32x4){o.vb.x, o.vb.y, 0u, 0u});
    f32x4 y = {0.f, 0.f, 0.f, 0.f};
#pragma unroll
    for (int s = 0; s < 2; ++s) y = __builtin_amdgcn_mfma_f32_16x16x32_f16(__builtin_bit_cast(h8, o.rh[s]), SB[s], y, 0, 0, 0);
    y = __builtin_amdgcn_mfma_f32_16x16x32_f16(__builtin_bit_cast(h8, (u32x4){o.c2.x, o.c2.y, 0u, 0u}), VBo, y, 0, 0, 0);
#pragma unroll
    for (int t = 0; t < 4; ++t) {
        f32x4 acc = S[t] * o.dg[t];
#pragma unroll
        for (int s = 0; s < 2; ++s) acc = __builtin_amdgcn_mfma_f32_16x16x32_f16(__builtin_bit_cast(h8, o.phi[t * 2 + s]), SB[s], acc, 0, 0, 0);
        acc = __builtin_amdgcn_mfma_f32_16x16x32_f16(__builtin_bit_cast(h8, (u32x4){o.psi[t].x, o.psi[t].y, 0u, 0u}), VBo, acc, 0, 0, 0);
        S[t] = acc;
    }
#pragma unroll
    for (int q = 0; q < 4; ++q) yp[(size_t)q * 512] = (f16)y[q];
}
__device__ __forceinline__ void p3s_scan(unsigned char* ws, int half, int bid, int wave, int lane) {
    const int G = gridDim.x;
    const int r16 = lane & 15, g = lane >> 4;
    const unsigned char* RJ = ws + WS_RJ; f16* Y = (f16*)(ws + WS_Y); f32x4* SST = (f32x4*)(ws + WS_SST);
    for (int task = wave * G + bid; task < NB * 32; task += G * NWAVES) {
        const int bh = task >> 2, vt = task & 3, b = bh >> 3, hd = bh & 7;
        f32x4 S[4];
#pragma unroll
        for (int t = 0; t < 4; ++t) S[t] = half ? SST[((size_t)task * 4 + t) * 64 + lane] : (f32x4){0.f, 0.f, 0.f, 0.f};
        const unsigned char* rj = RJ + (size_t)bh * NCHH * RJ_BYTES;
        f16* yp = Y + ((size_t)b * SEQ + half * NCHH * CH + 4 * g) * 512 + hd * 64 + vt * 16 + r16;
        ScanOps A, B;
        scan_load(A, rj, vt, lane, g);
        for (int chl = 0; chl < NCHH; chl += 2) {
            scan_load(B, rj + RJ_BYTES, vt, lane, g);
            scan_step(S, A, yp);
            if (chl + 2 < NCHH) scan_load(A, rj + 2 * RJ_BYTES, vt, lane, g);
            scan_step(S, B, yp + (size_t)CH * 512);
            rj += 2 * RJ_BYTES; yp += (size_t)2 * CH * 512;
        }
        if (half == 0) {
#pragma unroll
            for (int t = 0; t < 4; ++t) SST[((size_t)task * 4 + t) * 64 + lane] = S[t];
        }
    }
}
}
namespace mk {
__global__ void __launch_bounds__(NTHR, 2) mega(Params p0) {
#define PIN(i) ({ int _i = (i); asm volatile("" : "+s"(_i)); p0.in[_i]; })
    extern __shared__ __attribute__((aligned(16))) unsigned char lds_raw[];
    LAS unsigned char* lds = (LAS unsigned char*)lds_raw;
    const int wave_s = __builtin_amdgcn_readfirstlane(threadIdx.x >> 6);
    const int tid = threadIdx.x;
    volatile LAS unsigned* MISC = (volatile LAS unsigned*)(lds + MISC_OFF);
    for (int u = tid; u < (LDS_BYTES - SCR_BYTES) / 4; u += NTHR) ((LAS unsigned*)(lds + SCR_BYTES))[u] = 0u;
    __syncthreads();
    XcdBarrier bar = xcd_barrier_post((unsigned*)(p0.ws + WS_CTL) + CW_BAR, MISC + 8);
#define GRID_BAR() xcd_barrier(bar)

    int rep_left = 1;
    for (int ph = p0.ph_lo; ph < p0.ph_hi; ++ph) {
        int tidv; asm volatile("v_mbcnt_lo_u32_b32 %0, -1, 0\n\tv_mbcnt_hi_u32_b32 %0, -1, %0" : "=v"(tidv)); tidv += wave_s * 64;
        const int lane = tidv & 63, wave = __builtin_amdgcn_readfirstlane(tidv >> 6);
        int bidv = blockIdx.x; asm volatile("" : "+s"(bidv));
        unsigned char* wsv = p0.ws; asm volatile("" : "+s"(wsv));
        if (ph == PH_P0) p0_prologue(p0, wsv, lds, bidv, wave, lane);
        else if (ph == PH_P2A) p2a_la(wsv, bidv, tidv);
        else if (ph == PH_P2C0 || ph == PH_P2C1) { const RwkvW W{PIN(12), PIN(14), PIN(17), PIN(22), PIN(23), PIN(24), nullptr, nullptr}; p2c_chunks(wsv, W, lds, ph == PH_P2C1, bidv, wave, lane); }
        else if (ph == PH_SCAN0 || ph == PH_SCAN1) p3s_scan(wsv, ph == PH_SCAN1, bidv, wave, lane);
        else if (ph == PH_ATTN) {
            const attn_body::AttnTensors AT{(const f16*)(wsv + WS_Q), (const f16*)(wsv + WS_K), (const f16*)(wsv + WS_V), (f16*)(wsv + WS_O)};
            const attn_body::StaticOrder S((int)gridDim.x, bidv);
            attn_body::attn_phase<attn_body::StaticOrder>((char*)lds_raw, AT, S, wave_s);
        }
        else if (ph == PH_ROUTE) { p6_router(wsv, lds, bidv, wave, lane); __syncthreads(); p6_expert_weights(p0, lds, bidv, wave, lane); if (p0.rep_ph == 100) p6_expert_weights(p0, lds, bidv, wave, lane); }
        else if (ph == PH_COMB) p9_combine(wsv, bidv, wave, lane);
        else if (ph == PH_MIX) { p4_mix(wsv, PIN(7), PIN(8), PIN(9), PIN(10), PIN(11), bidv, wave, lane); p4_mix_rwkv(wsv, PIN(12), PIN(25), PIN(26), bidv, wave, lane); }
        else {
            LAS int* tab = (LAS int*)(lds + MISC_OFF + 128);
            if (ph == PH_UP || ph == PH_DOWN) build_expert_tab(wsv, tab, wave, lane);
            UniSched S{wsv, ph, (int)gridDim.x, bidv, tab};
            UniEpi E{wsv, p0};
            gemm_phase<UniSched, UniEpi>(lds, S, E, tidv);
        }
        if (ph == p0.rep_ph && rep_left) { rep_left = 0; --ph; }
        if (ph + 1 < p0.ph_hi) { XcdBarrier bb = bar; asm volatile("" : "+s"(bb.bar), "+s"(bb.x)); xcd_barrier(bb, wave_s); }
    }
#undef GRID_BAR
}

static void add_job(Params& P, const float* src, f16* dst, const float* s1, const float* s2, int K, int N, int ldd, int mode, int nb, long sstride, long dstride) {
    TJob& j = P.jobs[P.njobs++]; j.src = src; j.dst = dst; j.s1 = s1; j.s2 = s2; j.K = K; j.N = N; j.ldd = ldd; j.mode = mode; j.nb = nb; j.sstride = sstride; j.dstride = dstride;
    j.item0 = P.nitems; P.nitems += ((K + 63) / 64) * ((N + 63) / 64) * nb;
}
static void build_params(Params& P, void* const* d_in, void* d_out, void* d_ws, bool experts) {
    for (int i = 0; i < 38; ++i) P.in[i] = (const float*)d_in[i];
    P.out = (float*)d_out; P.ws = (unsigned char*)d_ws;
    unsigned char* ws = P.ws; auto F = [&](int i) { return (const float*)d_in[i]; };
    f16* WinT = (f16*)(ws + WS_WIN);
    add_job(P, F(4), WinT, F(3), nullptr, 1024, 3072, 1024, 0, 1, 0, 0);
    const float* mu = F(13);
    add_job(P, F(15), WinT + (size_t)3072 * 1024, F(3), mu, 1024, 64, 1024, 1, 1, 0, 0);
    add_job(P, F(15), WinT + (size_t)(3072 + 288) * 1024, F(3), mu, 1024, 64, 1024, 2, 1, 0, 0);
    add_job(P, F(18), WinT + (size_t)(3072 + 64) * 1024, F(3), mu + 1024, 1024, 64, 1024, 1, 1, 0, 0);
    add_job(P, F(18), WinT + (size_t)(3072 + 288 + 64) * 1024, F(3), mu + 1024, 1024, 64, 1024, 2, 1, 0, 0);
    add_job(P, F(20), WinT + (size_t)(3072 + 128) * 1024, F(3), mu + 2048, 1024, 160, 1024, 1, 1, 0, 0);
    add_job(P, F(20), WinT + (size_t)(3072 + 288 + 128) * 1024, F(3), mu + 2048, 1024, 160, 1024, 2, 1, 0, 0);
    add_job(P, F(27), (f16*)(ws + WS_WOUT), nullptr, nullptr, 1024, 1024, 1024, 0, 1, 0, 0);
    add_job(P, F(37), (f16*)(ws + WS_WPLG), F(36), nullptr, 1024, 1024, 1024, 0, 1, 0, 0);
    add_job(P, F(34), (f16*)(ws + WS_WPL), nullptr, nullptr, 256, 1024, 256, 0, 1, 0, 0);
    f16* WbT = (f16*)(ws + WS_WB);
    add_job(P, F(16), WbT, nullptr, nullptr, 64, 512, 384, 0, 1, 0, 0);
    add_job(P, F(19), WbT + (size_t)512 * 384 + 64, nullptr, nullptr, 64, 512, 384, 0, 1, 0, 0);
    add_job(P, F(21), WbT + (size_t)1024 * 384 + 128, nullptr, nullptr, 160, 512, 384, 0, 1, 0, 0);
    P.njobs0 = P.njobs; P.nitems0 = P.nitems;
    if (experts) {
        add_job(P, F(31), (f16*)(ws + WS_WUP), F(28), nullptr, 1024, 512, 1024, 0, 32, (long)1024 * 512, (long)1024 * 1024);
        add_job(P, F(32), (f16*)(ws + WS_WUP) + (size_t)512 * 1024, F(28), nullptr, 1024, 512, 1024, 0, 32, (long)1024 * 512, (long)1024 * 1024);
        add_job(P, F(33), (f16*)(ws + WS_WDN), nullptr, nullptr, 512, 1024, 512, 0, 32, (long)512 * 1024, (long)1024 * 512);
    }
}
}
namespace ad {
using mk::f16;
__global__ void __launch_bounds__(256) adapt1(const unsigned char* ws, int b, float* Z, float* L1, float* L2, float* L3, float* PE) {
    const f16* Q = (const f16*)(ws + mk::WS_Q); const f16* K = (const f16*)(ws + mk::WS_K); const f16* V = (const f16*)(ws + mk::WS_V);
    const f16* ZR = (const f16*)(ws + mk::WS_ZR); const f16* P = (const f16*)(ws + mk::WS_P); const f16* PEh = (const f16*)(ws + mk::WS_PE);
    const int t = blockIdx.x; const size_t g = (size_t)b * 2048 + t;
    for (int c = threadIdx.x; c < 3072; c += 256) {
        float v;
        if (c < 512) v = (float)Q[g * 512 + c] * (1.f / mk::C2);
        else if (c < 1024) v = (float)K[g * 512 + c - 512];
        else if (c < 1536) v = (float)V[g * 512 + c - 1024];
        else v = (float)ZR[g * 1536 + c - 1536];
        Z[(size_t)t * 3072 + c] = v;
    }
    for (int c = threadIdx.x; c < 1024; c += 256) PE[(size_t)t * 1024 + c] = (float)PEh[g * 1024 + c];
    for (int j = threadIdx.x; j < 288; j += 256) {
        float v = (float)P[g * 768 + j] + (t > 0 ? (float)P[(g - 1) * 768 + 288 + j] : 0.f);
        if (j < 64) L1[(size_t)t * 64 + j] = tanhf(v);
        else if (j < 128) L2[(size_t)t * 64 + j - 64] = v;
        else L3[(size_t)t * 160 + j - 128] = 1.f / (1.f + expf(-v));
    }
}
__global__ void __launch_bounds__(256) adapt2(const unsigned char* ws, int b, float* MIX) {
    const f16* X = (const f16*)(ws + mk::WS_MIX); const int t = blockIdx.x; const size_t g = (size_t)b * 2048 + t;
    for (int c = threadIdx.x; c < 1024; c += 256) MIX[(size_t)t * 1024 + c] = (float)X[g * 1024 + c];
}
}

extern "C" void kernel_launch(void* const* d_in, const int* in_sizes, int n_in, void* d_out, int out_size, void* d_ws, size_t ws_size, hipStream_t stream) {
    static int grid = 0;
    if (grid == 0) {
        int dev = 0, cus = 0, per_cu = 0;
        (void)hipGetDevice(&dev); (void)hipDeviceGetAttribute(&cus, hipDeviceAttributeMultiprocessorCount, dev);
        (void)hipFuncSetAttribute((const void*)mk::mega, hipFuncAttributeMaxDynamicSharedMemorySize, mk::LDS_BYTES);
        (void)hipOccupancyMaxActiveBlocksPerMultiprocessor(&per_cu, (const void*)mk::mega, mk::NTHR, mk::LDS_BYTES);
        if (per_cu < 1) { fprintf(stderr, "kernel_launch: occupancy query says %d blocks per CU\n", per_cu); per_cu = 1; }
        grid = cus * 1;
        (void)hipGetLastError();
    }
    unsigned char* mws = (unsigned char*)d_ws;
    if (ws_size < mk::WS_END1) { fprintf(stderr, "kernel_launch: workspace too small (%zu)\n", ws_size); return; }
    (void)hipMemsetAsync(mws + mk::WS_CTL, 0, mk::CTL_BYTES, stream);
    (void)hipMemsetAsync(mws + mk::WS_WIN + (size_t)3648 * 2048, 0, (size_t)192 * 2048, stream);
    (void)hipMemsetAsync(mws + mk::WS_WB, 0, (size_t)1536 * 384 * 2, stream);
    mk::Params P{};
    mk::build_params(P, d_in, d_out, mws, true);
    P.ph_lo = 0; P.ph_hi = mk::PH_END; P.rep_ph = MK_REP_PH;
    void* args[] = {&P};
    hipError_t e = hipLaunchCooperativeKernel((const void*)mk::mega, dim3(grid), dim3(mk::NTHR), args, mk::LDS_BYTES, stream);
    if (e != hipSuccess) fprintf(stderr, "cooperative launch failed: %s (grid %d)\n", hipGetErrorString(e), grid);
    for (int b = 0; b < nv::NB; ++b) {
        float* out = (float*)d_out + (size_t)b * nv::S_ * nv::D_;
        if (b >= mk::NB) nv::forward_batch(d_in, b, out, (float*)d_ws, stream, 0, 1);
    }
}
```
